# Optimizing an MI355X kernel written in HIP

```python
import jax, jax.numpy as jnp
from jax import lax
import numpy as np

D_MODEL = 1024
BATCH = 2
SEQ = 8192
DEPTH = 2

CHUNK = 64
EPS = 1e-6
F_MIN = 1e-6
DKA = 128
HA = D_MODEL // DKA
WA = HA * DKA
HB = 8
DKB = D_MODEL // HB
DVB = 2 * DKB
WB_QK = HB * DKB
WB_V = HB * DVB
ROPE_BASE = 10000.0
RET_GN_EPS = 1e-5
NC = 64
HC = D_MODEL // NC
WC = HC * NC
W_LORA = 64
A_LORA = 64
RWKV_GN_EPS = 64e-5
C_SHIFT = 3 * WC + 2 * W_LORA + 2 * A_LORA

IN_SIZES = (WA, WA, WA, WA, WA,
            WB_QK, WB_QK, WB_V, WB_V,
            C_SHIFT, WC,
            3 * D_MODEL)
IN_OFFSETS = tuple(int(v) for v in np.cumsum(IN_SIZES)[:-1])
N_IN = int(sum(IN_SIZES))

kernel_name = "hybrid_hgrn2_retention_rwkv7_bidir"


def rmsnorm(x, g, eps=EPS):
    xf = x.astype(jnp.float32)
    y = xf * lax.rsqrt(jnp.mean(xf * xf, axis=-1, keepdims=True) + eps)
    return y * g


def head_groupnorm(o, g, b, eps):
    of = o.astype(jnp.float32)
    mu = jnp.mean(of, axis=-1, keepdims=True)
    var = jnp.mean(jnp.square(of - mu), axis=-1, keepdims=True)
    return (of - mu) * lax.rsqrt(var + eps) * g + b


def heads(z, h):
    b, t, w = z.shape
    return z.reshape(b, t, h, w // h).transpose(0, 2, 1, 3)


def chunk_gla(q, k, v, log_f, strict):
    b, h, t, dk = q.shape
    dv = v.shape[-1]
    n = t // CHUNK

    def chunks(a):
        return a.reshape(b, h, n, CHUNK, a.shape[-1]).transpose(2, 0, 1, 3, 4)

    qc, kc, vc = chunks(q), chunks(k), chunks(v)
    bc = jnp.cumsum(chunks(log_f.astype(jnp.float32)), axis=3)
    mask = jnp.tril(jnp.ones((CHUNK, CHUNK), dtype=bool), -1 if strict else 0)[:, :, None]

    def step(state, inp):
        qi, ki, vi, bi = inp
        diff = bi[:, :, :, None, :] - bi[:, :, None, :, :]
        decay = jnp.where(mask, jnp.exp(jnp.where(mask, diff, 0.0)), 0.0)
        scores = jnp.sum(qi[:, :, :, None, :] * ki[:, :, None, :, :] * decay, axis=-1)
        o = (jnp.einsum("bhij,bhjv->bhiv", scores, vi)
             + jnp.einsum("bhik,bhkv->bhiv", qi * jnp.exp(bi), state))
        b_last = bi[:, :, -1:, :]
        state = (jnp.exp(b_last[:, :, 0, :])[..., None] * state
                 + jnp.einsum("bhjk,bhjv->bhkv", ki * jnp.exp(b_last - bi), vi))
        return state, o

    s0 = jnp.zeros((b, h, dk, dv), jnp.float32)
    _, o = lax.scan(step, s0, (qc, kc, vc, bc))
    return o.transpose(1, 2, 0, 3, 4).reshape(b, h, t, dv)


def hgrn2_mixer(q, f_fwd, f_bwd, i, lb, norm_g):
    b, t, _ = q.shape
    qh = heads(jax.nn.silu(q), HA)
    ih = heads(i, HA)
    o = 0.0
    for d, f_raw in enumerate((f_fwd, f_bwd)):
        f_raw = f_raw.astype(jnp.float32)
        f = lb[d] + (1.0 - lb[d]) * jax.nn.sigmoid(f_raw)
        log_f = jnp.log(jnp.maximum(f, F_MIN))
        k = (1.0 - lb[d]) * jax.nn.sigmoid(-f_raw)
        args = (qh, heads(k, HA), ih, heads(log_f, HA))
        if d == 0:
            o = o + chunk_gla(*args, strict=False)
        else:
            o = o + jnp.flip(chunk_gla(*[jnp.flip(z, 2) for z in args], strict=False), 2)
    o = rmsnorm(o.transpose(0, 2, 1, 3), norm_g)
    return o.reshape(b, t, WA).astype(q.dtype)


def rotary(z):
    t, dh = z.shape[2], z.shape[3]
    inv = ROPE_BASE ** (-jnp.arange(0, dh, 2, dtype=jnp.float32) / dh)
    ang = jnp.arange(t, dtype=jnp.float32)[:, None] * inv
    cos, sin = jnp.cos(ang), jnp.sin(ang)
    z1, z2 = z[..., : dh // 2], z[..., dh // 2:]
    return jnp.concatenate([z1 * cos - z2 * sin, z2 * cos + z1 * sin], axis=-1).astype(z.dtype)


def retention_mixer(q, k, v, gn_g, gn_b):
    b, t, _ = q.shape
    qh = rotary(heads(q, HB))
    kh = rotary(heads(k, HB)) * (DKB ** -0.5)
    vh = heads(v, HB)
    log_gamma = jnp.log1p(-jnp.exp2(-5.0 - jnp.arange(HB, dtype=jnp.float32)))
    log_f = jnp.broadcast_to(log_gamma[None, :, None, None], (b, HB, t, 1))
    fwd = chunk_gla(qh, kh, vh, log_f, strict=False)
    bwd = jnp.flip(chunk_gla(jnp.flip(qh, 2), jnp.flip(kh, 2), jnp.flip(vh, 2), log_f, strict=True), 2)
    o = head_groupnorm((fwd + bwd).transpose(0, 2, 1, 3), gn_g, gn_b, RET_GN_EPS)
    return o.reshape(b, t, WB_V).astype(q.dtype)


def centred_shift(p, mu):
    prev = jnp.pad(p[:, :-1], ((0, 0), (1, 0), (0, 0)))
    nxt = jnp.pad(p[:, 1:], ((0, 0), (0, 1), (0, 0)))
    return p + mu[0] * (prev - p) + mu[1] * (nxt - p)


def rwkv7_scan(r, decay, k, v, kk, a, reverse):
    def tm(z):
        return jnp.moveaxis(z.astype(jnp.float32), 1, 0)

    def step(S, inp):
        r_t, w_t, k_t, v_t, kk_t, a_t = inp
        sa = jnp.einsum("bhvk,bhk->bhv", S, -kk_t)
        S = (S * w_t[:, :, None, :]
             + sa[..., None] * (kk_t * a_t)[:, :, None, :]
             + v_t[..., None] * k_t[:, :, None, :])
        return S, jnp.einsum("bhvk,bhk->bhv", S, r_t)

    s0 = jnp.zeros((r.shape[0], HC, NC, NC), jnp.float32)
    _, o = lax.scan(step, s0, tuple(tm(z) for z in (r, decay, k, v, kk, a)), reverse=reverse)
    return jnp.moveaxis(o, 0, 1)


def rwkv7_mixer(c_s, mu, w0, w_lora_b, a0, a_lora_b, k_k, k_a, r_k, ln_g, ln_b):
    b, t, _ = c_s.shape
    s = centred_shift(c_s, mu)
    r, k, v, codes = jnp.split(s, (WC, 2 * WC, 3 * WC), axis=-1)
    w_code = codes[..., : 2 * W_LORA].reshape(b, t, 2, W_LORA)
    a_code = codes[..., 2 * W_LORA:].reshape(b, t, 2, A_LORA)

    def hd(z):
        return z.reshape(b, t, HC, NC)

    kk = hd(k * k_k).astype(jnp.float32)
    kk = kk * lax.rsqrt(jnp.sum(kk * kk, axis=-1, keepdims=True) + 1e-12)
    o = 0.0
    bonus = 0.0
    for d in range(2):
        w = (w0[d] + jnp.tanh(w_code[:, :, d]) @ w_lora_b[d]).astype(jnp.float32)
        decay = jnp.exp(-jnp.exp(-jax.nn.softplus(-w) - 0.5))
        a = jax.nn.sigmoid((a0[d] + a_code[:, :, d] @ a_lora_b[d]).astype(jnp.float32))
        k_d = k * (1.0 + (a - 1.0) * k_a)
        o = o + rwkv7_scan(hd(r), hd(decay), hd(k_d), hd(v), kk, hd(a), reverse=(d == 1))
        bonus = bonus + jnp.sum(hd(r * k_d * r_k), axis=-1, keepdims=True) * hd(v)
    y = head_groupnorm(o, ln_g, ln_b, RWKV_GN_EPS) + bonus
    return y.reshape(b, t, WC).astype(c_s.dtype)


def setup_inputs(seed: int = 0) -> dict:
    key = jax.random.key(seed)
    ks = jax.random.split(key, 24)
    f32 = jnp.float32

    def nrm(k, shape, scale):
        return scale * jax.random.normal(k, shape, f32)

    def gain(k, shape):
        return 1.0 + nrm(k, shape, 0.02)

    return {
        "x": nrm(ks[0], (BATCH, SEQ, D_MODEL), 1.0),
        "norm_g": gain(ks[1], (DEPTH, D_MODEL)),
        "w_in": nrm(ks[2], (DEPTH, D_MODEL, N_IN), D_MODEL ** -0.5),
        "hgrn_lb_logits": nrm(ks[3], (DEPTH, 2, WA), 0.1),
        "hgrn_norm_g": gain(ks[4], (DEPTH, HA, DKA)),
        "ret_norm_g": gain(ks[5], (DEPTH, HB, DVB)),
        "ret_norm_b": nrm(ks[6], (DEPTH, HB, DVB), 0.02),
        "rwkv_mu": jax.random.uniform(ks[7], (DEPTH, 2, C_SHIFT), f32, 0.0, 0.5),
        "rwkv_w0": jax.random.uniform(ks[8], (DEPTH, 2, WC), f32, -6.0, 1.0),
        "rwkv_w_lora_b": nrm(ks[9], (DEPTH, 2, W_LORA, WC), 0.5 * W_LORA ** -0.5),
        "rwkv_a0": nrm(ks[10], (DEPTH, 2, WC), 0.1),
        "rwkv_a_lora_b": nrm(ks[11], (DEPTH, 2, A_LORA, WC), 0.5 * A_LORA ** -0.5),
        "rwkv_k_k": 0.85 + nrm(ks[12], (DEPTH, WC), 0.02),
        "rwkv_k_a": 1.0 + nrm(ks[13], (DEPTH, WC), 0.02),
        "rwkv_r_k": nrm(ks[14], (DEPTH, WC), 0.1),
        "rwkv_ln_g": gain(ks[15], (DEPTH, HC, NC)),
        "rwkv_ln_b": nrm(ks[16], (DEPTH, HC, NC), 0.02),
        "w_branch_a": nrm(ks[17], (DEPTH, WA, D_MODEL), WA ** -0.5),
        "w_branch_b": nrm(ks[18], (DEPTH, WB_V, D_MODEL), WB_V ** -0.5),
        "w_branch_c": nrm(ks[19], (DEPTH, WC, D_MODEL), WC ** -0.5),
        "w_out": nrm(ks[20], (DEPTH, D_MODEL, D_MODEL), D_MODEL ** -0.5),
        "final_norm_g": gain(ks[21], (D_MODEL,)),
    }


def reference(x, norm_g, w_in, hgrn_lb_logits, hgrn_norm_g, ret_norm_g, ret_norm_b,
              rwkv_mu, rwkv_w0, rwkv_w_lora_b, rwkv_a0, rwkv_a_lora_b, rwkv_k_k, rwkv_k_a,
              rwkv_r_k, rwkv_ln_g, rwkv_ln_b, w_branch_a, w_branch_b, w_branch_c, w_out,
              final_norm_g):
    b, t, _ = x.shape
    p_lb = jax.nn.softmax(hgrn_lb_logits.astype(jnp.float32), axis=0)
    lbs = jnp.cumsum(p_lb, axis=0) - p_lb[0:1]
    for l in range(DEPTH):
        h = rmsnorm(x, norm_g[l]).astype(x.dtype)
        proj = h @ w_in[l]
        (a_q, a_ff, a_fb, a_i, a_g, b_q, b_k, b_v, b_g, c_s, c_g, merge) = jnp.split(
            proj, IN_OFFSETS, axis=-1)
        y_a = hgrn2_mixer(a_q, a_ff, a_fb, a_i, lbs[l], hgrn_norm_g[l]) * jax.nn.silu(a_g)
        y_b = retention_mixer(b_q, b_k, b_v, ret_norm_g[l], ret_norm_b[l]) * jax.nn.silu(b_g)
        y_c = rwkv7_mixer(c_s, rwkv_mu[l], rwkv_w0[l], rwkv_w_lora_b[l], rwkv_a0[l],
                          rwkv_a_lora_b[l], rwkv_k_k[l], rwkv_k_a[l], rwkv_r_k[l],
                          rwkv_ln_g[l], rwkv_ln_b[l]) * jax.nn.silu(c_g)
        gates = jax.nn.sigmoid(merge.reshape(b, t, 3, D_MODEL))
        mixed = (gates[:, :, 0] * (y_a @ w_branch_a[l])
                 + gates[:, :, 1] * (y_b @ w_branch_b[l])
                 + gates[:, :, 2] * (y_c @ w_branch_c[l]))
        x = x + (mixed @ w_out[l]).astype(x.dtype)
    return rmsnorm(x, final_norm_g).astype(x.dtype)
```

```cpp
#include <hip/hip_runtime.h>
#include <hip/hip_cooperative_groups.h>
#include <cstdio>
#include <cstdint>
namespace cg = cooperative_groups;

#define LAS __attribute__((address_space(3)))
#define GAS __attribute__((address_space(1)))
typedef unsigned short bf16_t;
typedef short bf16x8 __attribute__((ext_vector_type(8)));
typedef float f32x4 __attribute__((ext_vector_type(4)));
typedef float f32x2 __attribute__((ext_vector_type(2)));
typedef unsigned u32x4 __attribute__((ext_vector_type(4)));
typedef unsigned u32x2 __attribute__((ext_vector_type(2)));

constexpr int DM = 1024, NB = 2, SEQ = 8192, MTOK = NB * SEQ, DEPTH = 2;
constexpr int NIN = 18688;
constexpr int LDE = 11520, LDL = 6144, LDLX = 1024;
constexpr int LDEAB = 8192, LDEC = 3328;
constexpr int E_AQ = 0, E_AFF = 1024, E_AFB = 2048, E_AI = 3072, E_BQ = 4096, E_BK = 5120, E_BV = 6144, E_CS = 8192;
constexpr int L_AG = 0, L_BG = 1024, L_CG = 3072, L_MG = 4096;
constexpr int CSHIFT = 3328;
constexpr int YW = 4096;

__device__ __forceinline__ float bf2f(bf16_t h) { return __uint_as_float((unsigned)h << 16); }
typedef __bf16 bf16x2_t __attribute__((ext_vector_type(2)));
__device__ __forceinline__ unsigned pk2(float lo, float hi) { const f32x2 v = {lo, hi}; return __builtin_bit_cast(unsigned, __builtin_convertvector(v, bf16x2_t)); }
__device__ __forceinline__ unsigned f2bf(float f) { return pk2(f, 0.f) & 0xffffu; }
__device__ __forceinline__ float sigmoidf_(float x) { return __builtin_amdgcn_rcpf(1.0f + __builtin_amdgcn_exp2f(-1.4426950408889634f * x)); }
__device__ __forceinline__ float siluf_(float x) { return x * sigmoidf_(x); }
__device__ __forceinline__ float row_sum16(float v) {
    v += __int_as_float(__builtin_amdgcn_update_dpp(0, __float_as_int(v), 0xB1, 0xf, 0xf, false));
    v += __int_as_float(__builtin_amdgcn_update_dpp(0, __float_as_int(v), 0x4E, 0xf, 0xf, false));
    v += __int_as_float(__builtin_amdgcn_update_dpp(0, __float_as_int(v), 0x141, 0xf, 0xf, false));
    v += __int_as_float(__builtin_amdgcn_update_dpp(0, __float_as_int(v), 0x140, 0xf, 0xf, false));
    return v;
}
__device__ __forceinline__ float row_sum8(float v) {
    v += __int_as_float(__builtin_amdgcn_update_dpp(0, __float_as_int(v), 0xB1, 0xf, 0xf, false));
    v += __int_as_float(__builtin_amdgcn_update_dpp(0, __float_as_int(v), 0x4E, 0xf, 0xf, false));
    v += __int_as_float(__builtin_amdgcn_update_dpp(0, __float_as_int(v), 0x141, 0xf, 0xf, false));
    return v;
}
__device__ __forceinline__ float wave_sum(float v) {
    v = row_sum16(v);
    return __uint_as_float((unsigned)__builtin_amdgcn_readlane((int)__float_as_uint(v), 0)) + __uint_as_float((unsigned)__builtin_amdgcn_readlane((int)__float_as_uint(v), 16))
         + __uint_as_float((unsigned)__builtin_amdgcn_readlane((int)__float_as_uint(v), 32)) + __uint_as_float((unsigned)__builtin_amdgcn_readlane((int)__float_as_uint(v), 48));
}
__device__ __forceinline__ float multi_sum8(const float (&v)[8], int lane) {
    const bool sA = ((lane ^ (lane >> 2)) & 1) != 0, sB = (((lane >> 1) ^ (lane >> 2)) & 1) != 0, sC = (lane & 4) != 0;
    float w[4], x[2];
#pragma unroll
    for (int i = 0; i < 4; ++i) { const float keep = sA ? v[2 * i + 1] : v[2 * i], give = sA ? v[2 * i] : v[2 * i + 1];
        w[i] = keep + __int_as_float(__builtin_amdgcn_update_dpp(0, __float_as_int(give), 0xB1, 0xf, 0xf, false)); }
#pragma unroll
    for (int i = 0; i < 2; ++i) { const float keep = sB ? w[2 * i + 1] : w[2 * i], give = sB ? w[2 * i] : w[2 * i + 1];
        x[i] = keep + __int_as_float(__builtin_amdgcn_update_dpp(0, __float_as_int(give), 0x4E, 0xf, 0xf, false)); }
    float y;
    { const float keep = sC ? x[1] : x[0], give = sC ? x[0] : x[1]; y = keep + __int_as_float(__builtin_amdgcn_update_dpp(0, __float_as_int(give), 0x141, 0xf, 0xf, false)); }
    y += __int_as_float(__builtin_amdgcn_update_dpp(0, __float_as_int(y), 0x128, 0xf, 0xf, false));
    { const auto r = __builtin_amdgcn_permlane16_swap(__float_as_uint(y), __float_as_uint(y), false, false); y = __uint_as_float(r[0]) + __uint_as_float(r[1]); }
    { const auto r = __builtin_amdgcn_permlane32_swap(__float_as_uint(y), __float_as_uint(y), false, false); y = __uint_as_float(r[0]) + __uint_as_float(r[1]); }
    return y;
}
__device__ __forceinline__ constexpr int ms8_lane(int i) { return i < 4 ? i : 11 - i; }
__device__ __forceinline__ int ms8_index(int lane) { return (lane & 4) ? 11 - (lane & 7) : (lane & 7); }
__device__ __forceinline__ float rlf(float x, int k) { return __uint_as_float((unsigned)__builtin_amdgcn_readlane((int)__float_as_uint(x), k)); }
__device__ __forceinline__ f32x4 mfma16(bf16x8 a, bf16x8 b, f32x4 c) { return __builtin_amdgcn_mfma_f32_16x16x32_bf16(a, b, c, 0, 0, 0); }
#define LDS_BARRIER() do { asm volatile("s_waitcnt lgkmcnt(0)" ::: "memory"); __builtin_amdgcn_s_barrier(); asm volatile("" ::: "memory"); } while (0)
namespace pg8 {
constexpr int BM = 256, BK = 64, HALF = 128, HTB = HALF * BK * 2  , STAGE_BYTES = 8 * HTB, NXCD = 8, WGM = 8;

__host__ __device__ __forceinline__ int lds_byte(int r, int c) { const int st = (r >> 4) * 2 + (c >> 5), rr = r & 15, cc = c & 31, ob = rr * 64 + cc * 2; return st * 1024 + (ob ^ (((ob >> 9) & 1) << 5)); }
__host__ __device__ __forceinline__ void stage_rc(int b, int& R, int& C) { const int st = b / 1024, sb = b % 1024, swz = sb ^ (((sb >> 9) & 1) << 5); R = (st >> 1) * 16 + swz / 64; C = (st & 1) * 32 + (swz % 64) / 2; }
__host__ __device__ __forceinline__ int perm32(int rho) { const int n = rho >> 4, i = rho & 15; return 8 * (i >> 2) + 4 * n + (i & 3); }

struct Unit { int pm, pn; };
struct Gemm { const bf16_t* A; const bf16_t* Bt; int lda, ldb, K; };

struct StaticOrder {
    int nM, nN, nwg, G, c;
    __host__ __device__ void init(int M, int N, int G_, int c_) { nM = M / BM; nN = N / BM; nwg = nM * nN; G = G_; c = c_; }
    __host__ __device__ bool next(int i, Unit& u) const {
        const long L = (long)i * G + c; if (L >= nwg) return false;
        int wgid = (int)L; { const int q = nwg / NXCD, r = nwg % NXCD, xcd = wgid % NXCD, off = wgid / NXCD; wgid = (xcd < r ? xcd * (q + 1) : r * (q + 1) + (xcd - r) * q) + off; }
        const int nig = WGM * nN, gid = wgid / nig, fm = gid * WGM, gsz = (nM - fm) < WGM ? (nM - fm) : WGM;
        u.pm = fm + ((wgid % nig) % gsz); u.pn = (wgid % nig) / gsz; return true;
    }
};

__device__ __forceinline__ unsigned cvt_pk_bf16(float lo, float hi) { unsigned r; asm volatile("v_cvt_pk_bf16_f32 %0, %1, %2" : "=v"(r) : "v"(lo), "v"(hi)); return r; }

template <class Epi, class Sched>
__device__ __forceinline__ void gemm_phase(LAS unsigned char* lds, const Gemm g, const Sched& S, const Epi& E) {
    int tid = threadIdx.x; asm volatile("" : "+v"(tid));
    const int wid = __builtin_amdgcn_readfirstlane(tid >> 6), lane = tid & 63, wr = wid >> 2, wc = wid & 3, fr = lane & 15, fq = lane >> 4;
    const int nt = g.K / BK;
    unsigned voffA[2], voffB[2];
#pragma unroll
    for (int i = 0; i < 2; ++i) { int R, C; stage_rc(tid * 16 + i * 8192, R, C); const int Rb = (R & ~31) + perm32(R & 31);
        voffA[i] = (unsigned)(R * g.lda + C) * 2u; voffB[i] = (unsigned)(Rb * g.ldb + C) * 2u; }
    const size_t kstep = (size_t)(BK * 2);
    const size_t hsA = (size_t)HALF * g.lda * 2, hsB = (size_t)HALF * g.ldb * 2;
    const size_t tsA = 2 * hsA, tsB = 2 * hsB;
    const unsigned ldsw = (unsigned)wid * 1024u;
    const int aoff = lds_byte(wr * 64 + fr, fq * 8), boff = lds_byte(wc * 32 + fr, fq * 8);
#define PG8_SA(b, h) (((b) * 2 + (h)) * HTB)
#define PG8_SB(b, h) ((4 + (b) * 2 + (h)) * HTB)
#define PG8_STAGE(bufoff, gbase, voff) do { _Pragma("unroll") for (int _i = 0; _i < 2; ++_i) \
        __builtin_amdgcn_global_load_lds((const unsigned*)((const char*)(gbase) + (voff)[_i]), (LAS unsigned*)(lds + (bufoff) + ldsw + _i * 8192), 16, 0, 0); } while (0)
#define PG8_LDA(dst, b, h) do { _Pragma("unroll") for (int m = 0; m < 4; ++m) _Pragma("unroll") for (int k = 0; k < 2; ++k) dst[m][k] = *(const LAS bf16x8*)(lds + PG8_SA(b, h) + aoff + m * 2048 + k * 1024); } while (0)
#define PG8_LDB(dst, b, h) do { _Pragma("unroll") for (int n = 0; n < 2; ++n) _Pragma("unroll") for (int k = 0; k < 2; ++k) dst[n][k] = *(const LAS bf16x8*)(lds + PG8_SB(b, h) + boff + n * 2048 + k * 1024); } while (0)
#define PG8_MMA(ai, bj, At, Bt) do { __builtin_amdgcn_s_setprio(1); _Pragma("unroll") for (int m = 0; m < 4; ++m) _Pragma("unroll") for (int n = 0; n < 2; ++n) _Pragma("unroll") for (int k = 0; k < 2; ++k) \
        acc[ai][bj][m][n] = __builtin_amdgcn_mfma_f32_16x16x32_bf16(Bt[n][k], At[m][k], acc[ai][bj][m][n], 0, 0, 0); __builtin_amdgcn_s_setprio(0); } while (0)
#define PG8_WAIT_V(n) asm volatile("s_waitcnt vmcnt(" #n ")" ::: "memory")
#define PG8_WAIT_L(n) asm volatile("s_waitcnt lgkmcnt(" #n ")" ::: "memory")
#define PG8_BAR __builtin_amdgcn_s_barrier()
#define PG8_SCHED __builtin_amdgcn_sched_barrier(0)
    Unit cur, nxt; int ui = 0;
    if (!S.next(0, cur)) return;
    f32x4 acc[2][2][4][2];
#pragma unroll
    for (int a = 0; a < 2; ++a)
#pragma unroll
        for (int b = 0; b < 2; ++b)
#pragma unroll
            for (int m = 0; m < 4; ++m)
#pragma unroll
                for (int n = 0; n < 2; ++n) acc[a][b][m][n] = (f32x4){0.f, 0.f, 0.f, 0.f};
    bf16x8 At[4][2], B0[2][2], B1[2][2];
    const char* cA = (const char*)g.A + (size_t)cur.pm * tsA; const char* cB = (const char*)g.Bt + (size_t)cur.pn * tsB;
    PG8_STAGE(PG8_SB(0, 0), cB, voffB); PG8_STAGE(PG8_SB(0, 1), cB + hsB, voffB); PG8_STAGE(PG8_SA(0, 0), cA, voffA); PG8_STAGE(PG8_SA(0, 1), cA + hsA, voffA);
    if (wr == 1) PG8_BAR;
    PG8_WAIT_V(2); PG8_BAR;
    PG8_STAGE(PG8_SB(1, 0), cB + kstep, voffB); PG8_STAGE(PG8_SA(1, 0), cA + kstep, voffA); PG8_STAGE(PG8_SB(1, 1), cB + hsB + kstep, voffB);
    PG8_WAIT_V(6); PG8_BAR;
    for (;;) {
        const bool has_next = S.next(ui + 1, nxt);
        const char* nA = has_next ? (const char*)g.A + (size_t)nxt.pm * tsA : cA; const char* nB = has_next ? (const char*)g.Bt + (size_t)nxt.pn * tsB : cB;
        for (int t = 0; t < nt; t += 2) {
            const bool last = (t == nt - 2);
            const char* a1 = cA + (size_t)(t + 1) * kstep;
            const char* a2 = last ? nA : cA + (size_t)(t + 2) * kstep; const char* b2 = last ? nB : cB + (size_t)(t + 2) * kstep;
            const char* a3 = a2 + kstep; const char* b3 = b2 + kstep;
            PG8_LDB(B0, 0, 0); PG8_LDB(B1, 0, 1); PG8_SCHED; PG8_LDA(At, 0, 0); PG8_STAGE(PG8_SA(1, 1), a1 + hsA, voffA);
            PG8_WAIT_V(8); PG8_WAIT_L(0); PG8_BAR; PG8_MMA(0, 0, At, B0); PG8_MMA(0, 1, At, B1); PG8_BAR; PG8_SCHED;
            PG8_LDA(At, 0, 1); PG8_STAGE(PG8_SB(0, 0), b2, voffB); PG8_STAGE(PG8_SB(0, 1), b2 + hsB, voffB); PG8_STAGE(PG8_SA(0, 0), a2, voffA);
            PG8_WAIT_V(8); PG8_WAIT_L(0); PG8_BAR; PG8_MMA(1, 0, At, B0); PG8_MMA(1, 1, At, B1); PG8_BAR; PG8_SCHED;
            PG8_LDB(B0, 1, 0); PG8_LDB(B1, 1, 1); PG8_SCHED; PG8_LDA(At, 1, 0); PG8_STAGE(PG8_SA(0, 1), a2 + hsA, voffA);
            PG8_WAIT_V(8); PG8_WAIT_L(0); PG8_BAR; PG8_MMA(0, 0, At, B0); PG8_MMA(0, 1, At, B1); PG8_BAR; PG8_SCHED;
            PG8_LDA(At, 1, 1); PG8_STAGE(PG8_SB(1, 0), b3, voffB); PG8_STAGE(PG8_SB(1, 1), b3 + hsB, voffB); PG8_STAGE(PG8_SA(1, 0), a3, voffA);
            PG8_WAIT_V(8); PG8_WAIT_L(0); PG8_BAR; PG8_MMA(1, 0, At, B0); PG8_MMA(1, 1, At, B1); PG8_BAR; PG8_SCHED;
        }
        if (wr == 0) PG8_BAR;
        E(acc, cur, wr, wc, fr, fq);
        if (!has_next) break;
#pragma unroll
        for (int a = 0; a < 2; ++a)
#pragma unroll
            for (int b = 0; b < 2; ++b)
#pragma unroll
                for (int m = 0; m < 4; ++m)
#pragma unroll
                    for (int n = 0; n < 2; ++n) acc[a][b][m][n] = (f32x4){0.f, 0.f, 0.f, 0.f};
        cur = nxt; cA = nA; cB = nB; ++ui;
        if (wr == 1) PG8_BAR;
    }
    PG8_WAIT_V(0);
    PG8_BAR;
#undef PG8_SA
#undef PG8_SB
#undef PG8_STAGE
#undef PG8_LDA
#undef PG8_LDB
#undef PG8_MMA
#undef PG8_WAIT_V
#undef PG8_WAIT_L
#undef PG8_BAR
#undef PG8_SCHED
}
}
struct EpiProj {
    bf16_t* O; int ldc; int silu_lo, silu_hi, sig_lo;
    __device__ __forceinline__ void operator()(const f32x4 (&acc)[2][2][4][2], const pg8::Unit& u, int wr, int wc, int fr, int fq) const {
        const int pn = u.pn;
        const int act = (pn >= silu_lo && pn < silu_hi) ? 1 : (pn >= sig_lo ? 2 : 0);
        const int row0 = u.pm * 256 + wr * 64 + fr, col0 = pn * 256 + wc * 32 + 8 * fq;
#pragma unroll
        for (int ai = 0; ai < 2; ++ai)
#pragma unroll
            for (int m = 0; m < 4; ++m) {
                const int row = row0 + ai * 128 + m * 16; bf16_t* rowp = O + (size_t)row * ldc + col0;
#pragma unroll
                for (int bj = 0; bj < 2; ++bj) {
                    float v[8];
#pragma unroll
                    for (int j = 0; j < 4; ++j) { v[j] = acc[ai][bj][m][0][j]; v[4 + j] = acc[ai][bj][m][1][j]; }
                    if (act == 1) {
#pragma unroll
                        for (int j = 0; j < 8; ++j) v[j] = siluf_(v[j]);
                    } else if (act == 2) {
#pragma unroll
                        for (int j = 0; j < 8; ++j) v[j] = sigmoidf_(v[j]);
                    }
                    u32x4 w; w.x = pg8::cvt_pk_bf16(v[0], v[1]); w.y = pg8::cvt_pk_bf16(v[2], v[3]); w.z = pg8::cvt_pk_bf16(v[4], v[5]); w.w = pg8::cvt_pk_bf16(v[6], v[7]);
                    *(u32x4*)(rowp + bj * 128) = w;
                }
            }
    }
};
template <int KIND> struct EpiMix {
    const bf16_t* gate; int ldg; float* part; bf16_t* outbf;
    __device__ __forceinline__ void operator()(const f32x4 (&acc)[2][2][4][2], const pg8::Unit& u, int wr, int wc, int fr, int fq) const {
        const int row0 = u.pm * 256 + wr * 64 + fr, col0 = u.pn * 256 + wc * 32 + 8 * fq;
#pragma unroll
        for (int ai = 0; ai < 2; ++ai)
#pragma unroll
            for (int m = 0; m < 4; ++m) {
                const int row = row0 + ai * 128 + m * 16;
#pragma unroll
                for (int bj = 0; bj < 2; ++bj) {
                    const int col = col0 + bj * 128;
                    const u32x4 gw = *(const u32x4*)(gate + (size_t)row * ldg + col);
                    float gv[8]; gv[0] = __uint_as_float(gw.x << 16); gv[1] = __uint_as_float(gw.x & 0xffff0000u); gv[2] = __uint_as_float(gw.y << 16); gv[3] = __uint_as_float(gw.y & 0xffff0000u);
                    gv[4] = __uint_as_float(gw.z << 16); gv[5] = __uint_as_float(gw.z & 0xffff0000u); gv[6] = __uint_as_float(gw.w << 16); gv[7] = __uint_as_float(gw.w & 0xffff0000u);
                    float* pp = part + (size_t)row * 1024 + col;
                    f32x4 p0 = (f32x4){0.f, 0.f, 0.f, 0.f}, p1 = p0;
                    if (KIND != 0) { p0 = *(const f32x4*)pp; p1 = *(const f32x4*)(pp + 4); }
#pragma unroll
                    for (int j = 0; j < 4; ++j) { p0[j] += gv[j] * acc[ai][bj][m][0][j]; p1[j] += gv[4 + j] * acc[ai][bj][m][1][j]; }
                    if (KIND != 2) { *(f32x4*)pp = p0; *(f32x4*)(pp + 4) = p1; }
                    else { u32x4 w; w.x = pg8::cvt_pk_bf16(p0[0], p0[1]); w.y = pg8::cvt_pk_bf16(p0[2], p0[3]); w.z = pg8::cvt_pk_bf16(p1[0], p1[1]); w.w = pg8::cvt_pk_bf16(p1[2], p1[3]);
                        *(u32x4*)(outbf + (size_t)row * 1024 + col) = w; }
                }
            }
    }
};
struct EpiOut {
    const float* base; float* out;
    __device__ __forceinline__ void operator()(const f32x4 (&acc)[2][2][4][2], const pg8::Unit& u, int wr, int wc, int fr, int fq) const {
        const int row0 = u.pm * 256 + wr * 64 + fr, col0 = u.pn * 256 + wc * 32 + 8 * fq;
#pragma unroll
        for (int ai = 0; ai < 2; ++ai)
#pragma unroll
            for (int mp = 0; mp < 2; ++mp) {
                f32x4 bv[2][2][2];
#pragma unroll
                for (int mi = 0; mi < 2; ++mi)
#pragma unroll
                    for (int bj = 0; bj < 2; ++bj) { const size_t off = (size_t)(row0 + ai * 128 + (2 * mp + mi) * 16) * 1024 + col0 + bj * 128;
                        bv[mi][bj][0] = *(const f32x4*)(base + off); bv[mi][bj][1] = *(const f32x4*)(base + off + 4); }
#pragma unroll
                for (int mi = 0; mi < 2; ++mi)
#pragma unroll
                    for (int bj = 0; bj < 2; ++bj) { const int m = 2 * mp + mi; const size_t off = (size_t)(row0 + ai * 128 + m * 16) * 1024 + col0 + bj * 128;
                        *(f32x4*)(out + off) = bv[mi][bj][0] + acc[ai][bj][m][0]; *(f32x4*)(out + off + 4) = bv[mi][bj][1] + acc[ai][bj][m][1]; }
            }
    }
};

constexpr size_t MiB = 1u << 20;
constexpr size_t WS_CTL = 0, WS_ROPE = 1 * MiB, WS_RSTD = 5 * MiB, WS_LWT = 5 * MiB + 128 * 1024  , WS_WIN = 6 * MiB, WS_WCAT = 43 * MiB, WS_WOUT = 51 * MiB, WS_XG = 53 * MiB, WS_MIXBF = 85 * MiB,
                 WS_EAB = 117 * MiB, WS_EC = 245 * MiB, WS_L = 117 * MiB  , WS_OBUF = 297 * MiB,
                 WS_QTA = 361 * MiB, WS_KTA = 393 * MiB, WS_VTA = 425 * MiB, WS_DA = 441 * MiB, WS_QTB = 442 * MiB, WS_KTB = 474 * MiB, WS_VTB = 506 * MiB, WS_SLOC = 538 * MiB, WS_DSEG = 562 * MiB, WS_CSEG = 563 * MiB, WS_CMSEG = 571 * MiB, WS_END = 583 * MiB,
                 WS_RH = 117 * MiB, WS_MI = 149 * MiB, WS_NI = 181 * MiB  ,
                 WS_SV = 458 * MiB, WS_BONS = 490 * MiB  , WS_LX = 213 * MiB  , WS_CODE = 213 * MiB  , WS_PIA = 491 * MiB, WS_PIB = 575 * MiB  , WS_PART = 361 * MiB;
static_assert(WS_WIN + (size_t)NIN * DM * 2 <= WS_WCAT && WS_EAB + (size_t)SEQ * LDEAB * 2 <= WS_EC && WS_EC + (size_t)SEQ * LDEC * 2 <= WS_OBUF && WS_NI + 32 * MiB <= WS_EC && WS_END <= 584 * MiB, "d_ws map");
constexpr size_t WS_BAR = 4096, CTL_ZERO_BYTES = 65536;
constexpr int LDS_BYTES = 147456;
constexpr int NWAVES = 8;

struct Args {
    const float* in[22]; float* out; unsigned char* ws; int ph_lo, ph_hi;
};
typedef const __attribute__((address_space(4))) Args KArgs;
struct Ctx {
    LAS unsigned char* lds; int tid, lane, wave, G; KArgs* ap;
    __device__ __forceinline__ const float* in(int i) const { return ap->in[i]; }
    __device__ __forceinline__ float* out() const { return ap->out; }
    __device__ __forceinline__ unsigned char* ws() const { return ap->ws; }
    __device__ __forceinline__ f32x2* rope() const { return (f32x2*)(ap->ws + WS_ROPE); }
    __device__ __forceinline__ bf16_t* lwt() const { return (bf16_t*)(ap->ws + WS_LWT); }
    __device__ __forceinline__ float* rstd() const { return (float*)(ap->ws + WS_RSTD); }
    __device__ __forceinline__ float* part() const { return (float*)(ap->ws + WS_PART); }
    __device__ __forceinline__ bf16_t* WinT() const { return (bf16_t*)(ap->ws + WS_WIN); }
    __device__ __forceinline__ bf16_t* WcatT() const { return (bf16_t*)(ap->ws + WS_WCAT); }
    __device__ __forceinline__ bf16_t* WoutT() const { return (bf16_t*)(ap->ws + WS_WOUT); }
    __device__ __forceinline__ bf16_t* xg() const { return (bf16_t*)(ap->ws + WS_XG); }
    __device__ __forceinline__ bf16_t* mixbf() const { return (bf16_t*)(ap->ws + WS_MIXBF); }
    __device__ __forceinline__ bf16_t* eab() const { return (bf16_t*)(ap->ws + WS_EAB); }
    __device__ __forceinline__ bf16_t* ecb() const { return (bf16_t*)(ap->ws + WS_EC); }
    __device__ __forceinline__ bf16_t* lbuf() const { return (bf16_t*)(ap->ws + WS_L); }
    __device__ __forceinline__ bf16_t* lxbuf() const { return (bf16_t*)(ap->ws + WS_LX); }
    __device__ __forceinline__ bf16_t* qta() const { return (bf16_t*)(ap->ws + WS_QTA); }
    __device__ __forceinline__ bf16_t* kta() const { return (bf16_t*)(ap->ws + WS_KTA); }
    __device__ __forceinline__ bf16_t* vta() const { return (bf16_t*)(ap->ws + WS_VTA); }
    __device__ __forceinline__ float* da() const { return (float*)(ap->ws + WS_DA); }
    __device__ __forceinline__ bf16_t* qtb() const { return (bf16_t*)(ap->ws + WS_QTB); }
    __device__ __forceinline__ bf16_t* ktb() const { return (bf16_t*)(ap->ws + WS_KTB); }
    __device__ __forceinline__ bf16_t* vtb() const { return (bf16_t*)(ap->ws + WS_VTB); }
    __device__ __forceinline__ bf16_t* obuf() const { return (bf16_t*)(ap->ws + WS_OBUF); }
    __device__ __forceinline__ float* sloc() const { return (float*)(ap->ws + WS_SLOC); }
    __device__ __forceinline__ float* dseg() const { return (float*)(ap->ws + WS_DSEG); }
    __device__ __forceinline__ float* cseg() const { return (float*)(ap->ws + WS_CSEG); }
    __device__ __forceinline__ bf16_t* cmseg() const { return (bf16_t*)(ap->ws + WS_CMSEG); }
    __device__ __forceinline__ bf16_t* codeb() const { return (bf16_t*)(ap->ws + WS_CODE); }
    __device__ __forceinline__ bf16_t* pia() const { return (bf16_t*)(ap->ws + WS_PIA); }
    __device__ __forceinline__ bf16_t* pib() const { return (bf16_t*)(ap->ws + WS_PIB); }
    __device__ __forceinline__ bf16_t* rhi() const { return (bf16_t*)(ap->ws + WS_RH); }
    __device__ __forceinline__ bf16_t* mi() const { return (bf16_t*)(ap->ws + WS_MI); }
    __device__ __forceinline__ bf16_t* ni() const { return (bf16_t*)(ap->ws + WS_NI); }
    __device__ __forceinline__ bf16_t* svb() const { return (bf16_t*)(ap->ws + WS_SV); }
    __device__ __forceinline__ float* bons() const { return (float*)(ap->ws + WS_BONS); }
};
#define LDS_WAIT() asm volatile("s_waitcnt lgkmcnt(0)" ::: "memory")

__device__ __forceinline__ int win_row(int n) { return n < 4096 ? n : n < 5120 ? 11520 + (n - 4096) : n < 9216 ? 4096 + (n - 5120) : n < 11264 ? 11520 + 1024 + (n - 9216) : n < 14592 ? 8192 + (n - 11264) : n < 15616 ? 11520 + 3072 + (n - 14592) : 11520 + 4096 + (n - 15616); }
__device__ __forceinline__ void transpose_item(const float* W, int N, bf16_t* WT, int ldt, int koff, LAS float* scr, int item, int lane, bool permin = false) {
    const int nblk = N / 64, kb = item / nblk, nb = item % nblk, k0 = 64 * kb, n0 = 64 * nb; const int r0 = permin ? win_row(n0) : n0;
#pragma unroll
    for (int ih = 0; ih < 2; ++ih) {
        float wv[32];
#pragma unroll
        for (int i = 0; i < 32; ++i) wv[i] = W[(size_t)(k0 + 32 * ih + i) * N + n0 + lane];
#pragma unroll
        for (int i = 0; i < 32; ++i) scr[(32 * ih + i) * 65 + lane] = wv[i];
    }
    LDS_WAIT(); asm volatile("" ::: "memory");
    const int c = lane & 7;
#pragma unroll
    for (int j = 0; j < 8; ++j) { const int n = (lane >> 3) + 8 * j; const LAS float* s = scr + (8 * c) * 65 + n;
        u32x4 o; o.x = pk2(s[0 * 65], s[1 * 65]); o.y = pk2(s[2 * 65], s[3 * 65]); o.z = pk2(s[4 * 65], s[5 * 65]); o.w = pk2(s[6 * 65], s[7 * 65]);
        *(u32x4*)(WT + (size_t)(r0 + n) * ldt + koff + k0 + 8 * c) = o; }
    LDS_WAIT(); asm volatile("" ::: "memory");
}

__device__ __forceinline__ void prep_phase(const Ctx& F, int l) {
    const int gw = blockIdx.x * NWAVES + F.wave, NGW = F.G * NWAVES;
    if (l < 2) {
        LAS float* scr = (LAS float*)(F.lds + F.wave * 16640);
        const float* Win = F.in(2) + (size_t)l * DM * NIN;
        const float* Wa = F.in(17) + (size_t)l * 1024 * 1024; const float* Wb = F.in(18) + (size_t)l * 2048 * 1024; const float* Wc = F.in(19) + (size_t)l * 1024 * 1024; const float* Wo = F.in(20) + (size_t)l * 1024 * 1024;
        constexpr int I_IN = 16 * (NIN / 64), I_A = 16 * 16, I_B = 32 * 16, I_C = 16 * 16, I_O = 16 * 16, I_L = 4 * 16;
        for (int it = gw; it < I_IN + I_A + I_B + I_C + I_O + I_L; it += NGW) {
            int r = it;
            if (r < I_L) { const int gi = r >> 4, kind = gi >> 1, d = gi & 1;
                transpose_item((kind == 0 ? F.in(9) : F.in(11)) + (size_t)(l * 2 + d) * 65536, 1024, F.lwt() + (size_t)gi * 65536, 64, 0, scr, r & 15, F.lane); continue; } r -= I_L;
            if (r < I_IN) { transpose_item(Win, NIN, F.WinT(), 1024, 0, scr, r, F.lane, true); continue; } r -= I_IN;
            if (r < I_A) { transpose_item(Wa, 1024, F.WcatT(), 4096, 0, scr, r, F.lane); continue; } r -= I_A;
            if (r < I_B) { transpose_item(Wb, 1024, F.WcatT(), 4096, 1024, scr, r, F.lane); continue; } r -= I_B;
            if (r < I_C) { transpose_item(Wc, 1024, F.WcatT(), 4096, 3072, scr, r, F.lane); continue; } r -= I_C;
            transpose_item(Wo, 1024, F.WoutT(), 1024, 0, scr, r, F.lane);
        }
    }
    const float* xsrc = (l == 0) ? F.in(0) : F.out();
    const float* gsrc = (l < 2) ? F.in(1) + l * DM : F.in(21);
    f32x4 g4[4];
#pragma unroll
    for (int j = 0; j < 4; ++j) g4[j] = *((const f32x4*)gsrc + F.lane + 64 * j);
    f32x4 v[4];
#pragma unroll
    for (int j = 0; j < 4; ++j) v[j] = *((const f32x4*)(xsrc + (size_t)gw * DM) + F.lane + 64 * j);
    for (int m = gw; m < MTOK; m += NGW) {
        const int mn = m + NGW < MTOK ? m + NGW : m;
        f32x4 nv[4];
#pragma unroll
        for (int j = 0; j < 4; ++j) nv[j] = *((const f32x4*)(xsrc + (size_t)mn * DM) + F.lane + 64 * j);
        float s = 0.f;
#pragma unroll
        for (int j = 0; j < 4; ++j) s += (v[j].x * v[j].x + v[j].y * v[j].y) + (v[j].z * v[j].z + v[j].w * v[j].w);
        float eps_ = 1e-6f; asm volatile("" : "+s"(eps_));
        const float rs = rsqrtf(wave_sum(s) * (1.f / DM) + eps_);
        if (l < 2) {
            unsigned long long* o8 = (unsigned long long*)(F.xg() + (size_t)m * DM) + F.lane;
#pragma unroll
            for (int j = 0; j < 4; ++j) { const f32x4 gg = g4[j] * rs;
                o8[64 * j] = (unsigned long long)pk2(v[j].x * gg.x, v[j].y * gg.y) | ((unsigned long long)pk2(v[j].z * gg.z, v[j].w * gg.w) << 32); }
        } else {
            f32x4* orow = (f32x4*)(F.out() + (size_t)m * DM) + F.lane;
#pragma unroll
            for (int j = 0; j < 4; ++j) orow[64 * j] = v[j] * rs * g4[j];
        }
#pragma unroll
        for (int j = 0; j < 4; ++j) v[j] = nv[j];
    }
}

__device__ __forceinline__ void rope_table(const Ctx& F) {
    for (int idx = blockIdx.x * 512 + F.tid; idx < SEQ * 64; idx += F.G * 512) {
        const int t = idx >> 6, j = idx & 63;
        const float inv = (float)exp2(-(double)(2 * j) * (13.287712379549449 / 128.0));
        const float ang = (float)t * inv;
        const double rev = (double)ang * 0.15915494309189535; const double fr = rev - rint(rev);
        const float x = (float)(fr * 6.283185307179586);
        F.rope()[idx] = (f32x2){cosf(x), sinf(x)};
    }
}
constexpr size_t WS_MIXCNT = 32768;
struct EpiAny {
    int kind, l, b, s, gcol;
    __device__ __forceinline__ bool stores16() const { return kind <= 1; }
    __device__ __forceinline__ void operator()(const f32x4 (&acc)[2][2][4][2], const pg8::Unit& u, int wr, int wc, int fr, int fq) const {
        Ctx F; { KArgs* ap = (KArgs*)__builtin_amdgcn_kernarg_segment_ptr(); asm volatile("" : "+s"(ap)); F.ap = ap; }
        if (kind == 0) {
            if (u.pn < 32) { EpiProj e{F.eab(), LDEAB, 0, 4, 1 << 30}; e(acc, u, wr, wc, fr, fq); }
            else { EpiProj e{F.ecb() - 32 * 256, LDEC, 0, 0, 1 << 30}; e(acc, u, wr, wc, fr, fq); }
        }
        else if (kind == 1) { EpiProj e{F.lbuf(), LDL, 0, 0, 16};     e(acc, u, wr, wc, fr, fq); }
        else if (kind == 6) { EpiProj e{F.lxbuf(), LDLX, 0, 0, 0}; e(acc, u, wr, wc, fr, fq); }
        else if (kind == 5) { EpiOut e{l == 0 ? F.in(0) : F.out(), F.out()}; e(acc, u, wr, wc, fr, fq); }
        else {
            const bool gx = gcol >= LDL;
            const bf16_t* gate = gx ? F.lxbuf() : F.lbuf() + gcol; const int ldg = gx ? LDLX : LDL; bf16_t* mine = (bf16_t*)F.part() + (size_t)s * SEQ * DM;
            const int row0 = u.pm * 256 + wr * 64 + fr, col0 = u.pn * 256 + wc * 32 + 8 * fq;
#pragma unroll
            for (int ai = 0; ai < 2; ++ai)
#pragma unroll
                for (int mp = 0; mp < 2; ++mp) {
                    u32x4 gwv[2][2], pwv[2][2];
#pragma unroll
                    for (int mi = 0; mi < 2; ++mi)
#pragma unroll
                        for (int bj = 0; bj < 2; ++bj) { const int row = row0 + ai * 128 + (2 * mp + mi) * 16, col = col0 + bj * 128;
                            gwv[mi][bj] = *(const u32x4*)(gate + (size_t)row * ldg + col);
                            if (kind == 3) pwv[mi][bj] = *(const u32x4*)(mine + (size_t)row * 1024 + col); else pwv[mi][bj] = (u32x4){0u, 0u, 0u, 0u}; }
#pragma unroll
                    for (int mi = 0; mi < 2; ++mi)
#pragma unroll
                        for (int bj = 0; bj < 2; ++bj) { const int m = 2 * mp + mi; const int row = row0 + ai * 128 + m * 16, col = col0 + bj * 128;
                            const u32x4 gw = gwv[mi][bj], pw = pwv[mi][bj];
                            const f32x4 g0 = (f32x4){__uint_as_float(gw.x << 16), __uint_as_float(gw.x & 0xffff0000u), __uint_as_float(gw.y << 16), __uint_as_float(gw.y & 0xffff0000u)};
                            const f32x4 g1 = (f32x4){__uint_as_float(gw.z << 16), __uint_as_float(gw.z & 0xffff0000u), __uint_as_float(gw.w << 16), __uint_as_float(gw.w & 0xffff0000u)};
                            f32x4 p0 = g0 * acc[ai][bj][m][0], p1 = g1 * acc[ai][bj][m][1];
                            p0 += (f32x4){__uint_as_float(pw.x << 16), __uint_as_float(pw.x & 0xffff0000u), __uint_as_float(pw.y << 16), __uint_as_float(pw.y & 0xffff0000u)};
                            p1 += (f32x4){__uint_as_float(pw.z << 16), __uint_as_float(pw.z & 0xffff0000u), __uint_as_float(pw.w << 16), __uint_as_float(pw.w & 0xffff0000u)};
                            u32x4 w; w.x = pg8::cvt_pk_bf16(p0[0], p0[1]); w.y = pg8::cvt_pk_bf16(p0[2], p0[3]); w.z = pg8::cvt_pk_bf16(p1[0], p1[1]); w.w = pg8::cvt_pk_bf16(p1[2], p1[3]);
                            *(u32x4*)(mine + (size_t)row * 1024 + col) = w; }
                }
            if (kind == 3) {
                extern __shared__ __attribute__((aligned(16))) unsigned char lds_dyn[];
                volatile LAS unsigned* flag = (volatile LAS unsigned*)((LAS unsigned char*)lds_dyn + LDS_BYTES - 32);
                asm volatile("s_waitcnt vmcnt(0)" ::: "memory");
                __syncthreads();
                if (threadIdx.x == 0) {
                    unsigned* cnt = (unsigned*)(F.ws() + WS_MIXCNT) + 64 * (u.pm * 4 + u.pn);
                    __builtin_amdgcn_fence(__ATOMIC_RELEASE, "agent");
                    asm volatile("s_waitcnt vmcnt(0)" ::: "memory");
                    const unsigned old = __hip_atomic_fetch_add(cnt, 1u, __ATOMIC_RELAXED, __HIP_MEMORY_SCOPE_AGENT);
                    if (old & 1u) { __builtin_amdgcn_fence(__ATOMIC_ACQUIRE, "agent"); asm volatile("s_waitcnt vmcnt(0)" ::: "memory"); }
                    flag[0] = old & 1u;
                }
                __syncthreads();
                if (flag[0]) {
                    const bf16_t* other = (const bf16_t*)F.part() + (size_t)(1 - s) * SEQ * DM; bf16_t* outbf = F.mixbf() + (size_t)b * SEQ * DM;
#pragma unroll
                    for (int ai = 0; ai < 2; ++ai)
#pragma unroll
                        for (int mp = 0; mp < 2; ++mp) {
                            u32x4 pwv[2][2], qwv[2][2];
#pragma unroll
                            for (int mi = 0; mi < 2; ++mi)
#pragma unroll
                                for (int bj = 0; bj < 2; ++bj) { const size_t off = (size_t)(row0 + ai * 128 + (2 * mp + mi) * 16) * 1024 + col0 + bj * 128; pwv[mi][bj] = *(const u32x4*)(other + off); qwv[mi][bj] = *(const u32x4*)(mine + off); }
#pragma unroll
                            for (int mi = 0; mi < 2; ++mi)
#pragma unroll
                                for (int bj = 0; bj < 2; ++bj) { const size_t off = (size_t)(row0 + ai * 128 + (2 * mp + mi) * 16) * 1024 + col0 + bj * 128; const u32x4 pw = pwv[mi][bj], qw = qwv[mi][bj];
                                    const f32x4 a0 = (f32x4){__uint_as_float(qw.x << 16), __uint_as_float(qw.x & 0xffff0000u), __uint_as_float(qw.y << 16), __uint_as_float(qw.y & 0xffff0000u)} + (f32x4){__uint_as_float(pw.x << 16), __uint_as_float(pw.x & 0xffff0000u), __uint_as_float(pw.y << 16), __uint_as_float(pw.y & 0xffff0000u)};
                                    const f32x4 a1 = (f32x4){__uint_as_float(qw.z << 16), __uint_as_float(qw.z & 0xffff0000u), __uint_as_float(qw.w << 16), __uint_as_float(qw.w & 0xffff0000u)} + (f32x4){__uint_as_float(pw.z << 16), __uint_as_float(pw.z & 0xffff0000u), __uint_as_float(pw.w << 16), __uint_as_float(pw.w & 0xffff0000u)};
                                    u32x4 w; w.x = pg8::cvt_pk_bf16(a0[0], a0[1]); w.y = pg8::cvt_pk_bf16(a0[2], a0[3]); w.z = pg8::cvt_pk_bf16(a1[0], a1[1]); w.w = pg8::cvt_pk_bf16(a1[2], a1[3]);
                                    *(u32x4*)(outbf + off) = w; }
                        }
                }
                __syncthreads();
            }
        }
    }
};
#define XB_TMO      128
#define XB_XCNT(j)  (256  + 64 * (j))
#define XB_XSUB(j)  (1280 + 64 * (j))
#define XB_XGEN(j)  (2304 + 64 * (j))
#define XB_TOP      3328
#define XB_TOPGEN   3392
#define XCD_BAR_WORDS 3456
#define XB_SPIN_CAP (1u << 18)

__device__ __forceinline__ unsigned xb_ld(unsigned* p)              { return __hip_atomic_load(p, __ATOMIC_RELAXED, __HIP_MEMORY_SCOPE_AGENT); }
__device__ __forceinline__ unsigned xb_add(unsigned* p, unsigned v) { return __hip_atomic_fetch_add(p, v, __ATOMIC_RELAXED, __HIP_MEMORY_SCOPE_AGENT); }
__device__ __forceinline__ unsigned xb_xcc_id() { return (unsigned)__builtin_amdgcn_s_getreg((3 << 11) | 20) & 0xFu; }
#define XB_SPIN(cond, bar) do { unsigned _sp = 0; while (cond) { __builtin_amdgcn_s_sleep(1); \
    if ((++_sp & 255u) == 0u) { if (xb_ld(&(bar)[XB_TMO])) break; if (_sp > XB_SPIN_CAP) { atomicAdd(&(bar)[XB_TMO], 1u); break; } } } } while (0)

struct XcdBarrier {
    unsigned* bar; unsigned x;
    volatile LAS unsigned* st;
};

__device__ __forceinline__ XcdBarrier xcd_barrier_post(unsigned* bar, volatile LAS unsigned* st) {
    XcdBarrier b; b.bar = bar; b.x = xb_xcc_id(); b.st = st;
    if (threadIdx.x == 0) (void)xb_add(&bar[XB_XCNT(b.x)], 1u);
    return b;
}
__device__ __forceinline__ void xcd_barrier_complete(unsigned* bar, unsigned x, unsigned& nloc, unsigned& nx) {
    const unsigned G = gridDim.x * gridDim.y * gridDim.z;
    unsigned sum, cnt, mine, sp = 0u;
    for (;;) {
        sum = 0u; cnt = 0u; mine = 0u;
#pragma unroll
        for (unsigned j = 0; j < 16; ++j) { const unsigned c = xb_ld(&bar[XB_XCNT(j)]); sum += c; cnt += (c > 0u) ? 1u : 0u; mine = (j == x) ? c : mine; }
        if (sum == G) break;
        __builtin_amdgcn_s_sleep(1);
        if ((++sp & 255u) == 0u) { if (xb_ld(&bar[XB_TMO])) break; if (sp > XB_SPIN_CAP) { atomicAdd(&bar[XB_TMO], 1u); break; } }
    }
    nloc = mine > 0u ? mine : 1u; nx = cnt > 0u ? cnt : 1u;
}

__device__ __forceinline__ void xcd_barrier(const XcdBarrier& b) {
    asm volatile("s_waitcnt vmcnt(0)" ::: "memory");
    __syncthreads();
    if (threadIdx.x == 0) {
        unsigned* bar = b.bar;
        __builtin_amdgcn_s_waitcnt(0);
        unsigned nloc = b.st[0], nx = b.st[1];
        if (nloc == 0u) { xcd_barrier_complete(bar, b.x, nloc, nx); b.st[0] = nloc; b.st[1] = nx; }
        const unsigned old = xb_add(&bar[XB_XSUB(b.x)], 1u);
        const unsigned gen = old / nloc;
        if (old + 1u == (gen + 1u) * nloc) {
            __builtin_amdgcn_fence(__ATOMIC_RELEASE, "agent");
            asm volatile("s_waitcnt vmcnt(0)" ::: "memory");
            const unsigned og = xb_add(&bar[XB_TOP], 1u);
            const unsigned tg = og / nx;
            if (og + 1u == (tg + 1u) * nx) xb_add(&bar[XB_TOPGEN], 1u);
            else XB_SPIN(xb_ld(&bar[XB_TOPGEN]) == tg, bar);
            __builtin_amdgcn_fence(__ATOMIC_ACQUIRE, "agent");
            xb_add(&bar[XB_XGEN(b.x)], 1u);
            asm volatile("s_waitcnt vmcnt(0)" ::: "memory");
        } else {
            XB_SPIN(xb_ld(&bar[XB_XGEN(b.x)]) == gen, bar);
            __builtin_amdgcn_fence(__ATOMIC_ACQUIRE, "agent");
            asm volatile("s_waitcnt vmcnt(0)" ::: "memory");
        }
    }
    __syncthreads();
}


constexpr int LQ = 136, LT = 72;
constexpr int NCH = SEQ / 64;
constexpr float LOG2E = 1.4426950408889634f;

__device__ __forceinline__ void hgrn_gate(float x, float lb, float& lf2, float& kv) {
    x = fminf(fmaxf(x, -30.f), 30.f);
    const float e = __builtin_amdgcn_exp2f(-LOG2E * x), r = __builtin_amdgcn_rcpf(1.f + e);
    const float f = fmaxf(lb + (1.f - lb) * r, 1e-6f);
    kv = (1.f - lb) * (e * r); lf2 = __builtin_amdgcn_logf(f);
}
__device__ __forceinline__ float ex2c(float x) { return __builtin_amdgcn_exp2f(fminf(x, 115.f)); }
__device__ __forceinline__ void hgrn_local_item(const Ctx& F, int l, int c, int h) {
    LAS bf16_t* QHF = (LAS bf16_t*)F.lds; LAS bf16_t* KHF = QHF + 64 * LQ; LAS bf16_t* QHB = KHF + 64 * LQ; LAS bf16_t* KHB = QHB + 64 * LQ;
    LAS bf16_t* VTL = KHB + 64 * LQ; LAS bf16_t* PL = VTL + 128 * LT; LAS float* TOT = (LAS float*)(PL + 64 * LT);
    const int lane = F.lane, g = F.wave, ch0 = 2 * lane, t0 = c * 64;
    const bf16_t* rp = F.eab() + (size_t)(t0 + 8 * g) * LDEAB + h * 128 + ch0;
    unsigned qw[8], iw[8]; float lff[8][2], lfb[8][2], kf[8][2], kb[8][2];
    float lbf[2] = {0.f, 0.f}, lbb[2] = {0.f, 0.f};
    {
        unsigned fw[8], bw[8];
#pragma unroll
        for (int jj = 0; jj < 8; ++jj) { const bf16_t* r = rp + (size_t)jj * LDEAB; qw[jj] = *(const unsigned*)(r); fw[jj] = *(const unsigned*)(r + 1024); bw[jj] = *(const unsigned*)(r + 2048); iw[jj] = *(const unsigned*)(r + 3072); }
        { const float* lg = F.in(3); const int c0 = h * 128 + ch0;
          const f32x2 g0 = *(const f32x2*)(lg + c0), g1 = *(const f32x2*)(lg + 1024 + c0), g2 = *(const f32x2*)(lg + 2048 + c0), g3 = *(const f32x2*)(lg + 3072 + c0);
          if (l == 1) { lbf[0] = sigmoidf_(g2.x - g0.x); lbf[1] = sigmoidf_(g2.y - g0.y); lbb[0] = sigmoidf_(g3.x - g1.x); lbb[1] = sigmoidf_(g3.y - g1.y); } }
#pragma unroll
        for (int jj = 0; jj < 8; ++jj) {
            hgrn_gate(__uint_as_float(fw[jj] << 16), lbf[0], lff[jj][0], kf[jj][0]); hgrn_gate(__uint_as_float(fw[jj] & 0xffff0000u), lbf[1], lff[jj][1], kf[jj][1]);
            hgrn_gate(__uint_as_float(bw[jj] << 16), lbb[0], lfb[jj][0], kb[jj][0]); hgrn_gate(__uint_as_float(bw[jj] & 0xffff0000u), lbb[1], lfb[jj][1], kb[jj][1]);
        }
    }
    {
        float sf0 = 0.f, sf1 = 0.f, sb0 = 0.f, sb1 = 0.f;
#pragma unroll
        for (int jj = 0; jj < 8; ++jj) { sf0 += lff[jj][0]; sf1 += lff[jj][1]; sb0 += lfb[jj][0]; sb1 += lfb[jj][1]; }
        *(LAS f32x2*)(TOT + g * 128 + ch0) = (f32x2){sf0, sf1}; *(LAS f32x2*)(TOT + 1024 + g * 128 + ch0) = (f32x2){sb0, sb1};
    }
    LDS_BARRIER();
    float offf[2] = {0.f, 0.f}, b31[2] = {0.f, 0.f}, b63[2] = {0.f, 0.f}, offb[2] = {0.f, 0.f}, pb32[2] = {0.f, 0.f}, totb[2] = {0.f, 0.f};
#pragma unroll
    for (int gg = 0; gg < 8; ++gg) {
        const f32x2 tf = *(const LAS f32x2*)(TOT + gg * 128 + ch0), tb = *(const LAS f32x2*)(TOT + 1024 + gg * 128 + ch0);
#pragma unroll
        for (int e = 0; e < 2; ++e) { const float a = e ? tf.y : tf.x, b = e ? tb.y : tb.x;
            offf[e] += gg < g ? a : 0.f; offb[e] += gg < g ? b : 0.f; if (gg < 4) { b31[e] += a; pb32[e] += b; } b63[e] += a; totb[e] += b; }
    }
    const size_t imgF = ((size_t)(0 * NCH + c) * 8 + h) * 8192, imgB = ((size_t)(1 * NCH + c) * 8 + h) * 8192;
    bf16_t* QTg = F.qta(); bf16_t* KTg = F.kta();
    float runf[2] = {offf[0], offf[1]}, runb[2] = {offb[0], offb[1]};
    unsigned ktf[2][4], ktb[2][4], vtw[2][4];
#pragma unroll
    for (int jj = 0; jj < 8; ++jj) {
        const int t = 8 * g + jj;
        const float q[2] = {__uint_as_float(qw[jj] << 16), __uint_as_float(qw[jj] & 0xffff0000u)};
        float qhf[2], khf[2], qtf[2], ktfv[2], qhb[2], khb[2], qtb[2], ktbv[2];
#pragma unroll
        for (int e = 0; e < 2; ++e) {
            runf[e] += lff[jj][e];
            const float bf = runf[e], xf = bf - b31[e];
            qhf[e] = q[e] * ex2c(xf); khf[e] = kf[jj][e] * ex2c(-xf); qtf[e] = q[e] * __builtin_amdgcn_exp2f(bf); ktfv[e] = kf[jj][e] * __builtin_amdgcn_exp2f(b63[e] - bf);
            const float sb = totb[e] - runb[e];
            runb[e] += lfb[jj][e];
            const float xb = sb - (totb[e] - pb32[e]);
            qhb[e] = q[e] * ex2c(xb); khb[e] = kb[jj][e] * ex2c(-xb); qtb[e] = q[e] * __builtin_amdgcn_exp2f(sb); ktbv[e] = kb[jj][e] * __builtin_amdgcn_exp2f(totb[e] - sb);
        }
        *(LAS unsigned*)(QHF + t * LQ + ch0) = pk2(qhf[0], qhf[1]); *(LAS unsigned*)(KHF + t * LQ + ch0) = pk2(khf[0], khf[1]);
        *(LAS unsigned*)(QHB + t * LQ + ch0) = pk2(qhb[0], qhb[1]); *(LAS unsigned*)(KHB + t * LQ + ch0) = pk2(khb[0], khb[1]);
        *(unsigned*)(QTg + imgF + t * 128 + ch0) = pk2(qtf[0], qtf[1]); *(unsigned*)(QTg + imgB + t * 128 + ch0) = pk2(qtb[0], qtb[1]);
#pragma unroll
        for (int e = 0; e < 2; ++e) {
            const unsigned kfb = f2bf(ktfv[e]), kbb = f2bf(ktbv[e]), vb = e ? (iw[jj] >> 16) : (iw[jj] & 0xffffu);
            if (jj & 1) { ktf[e][jj >> 1] |= kfb << 16; ktb[e][jj >> 1] |= kbb << 16; vtw[e][jj >> 1] |= vb << 16; }
            else { ktf[e][jj >> 1] = kfb; ktb[e][jj >> 1] = kbb; vtw[e][jj >> 1] = vb; }
        }
    }
#pragma unroll
    for (int e = 0; e < 2; ++e) {
        const int ch = ch0 + e;
        *(u32x4*)(KTg + imgF + ch * 64 + 8 * g) = (u32x4){ktf[e][0], ktf[e][1], ktf[e][2], ktf[e][3]};
        *(u32x4*)(KTg + imgB + ch * 64 + 8 * g) = (u32x4){ktb[e][0], ktb[e][1], ktb[e][2], ktb[e][3]};
        const u32x4 vv = (u32x4){vtw[e][0], vtw[e][1], vtw[e][2], vtw[e][3]};
        *(u32x4*)(F.vta() + ((size_t)(c * 8 + h) * 128 + ch) * 64 + 8 * g) = vv;
    }
    if (g == 0) {
        *(f32x2*)(F.da() + ((size_t)(0 * NCH + c) * 8 + h) * 128 + ch0) = (f32x2){__builtin_amdgcn_exp2f(b63[0]), __builtin_amdgcn_exp2f(b63[1])};
        *(f32x2*)(F.da() + ((size_t)(1 * NCH + c) * 8 + h) * 128 + ch0) = (f32x2){__builtin_amdgcn_exp2f(totb[0]), __builtin_amdgcn_exp2f(totb[1])};
    }
    LDS_BARRIER();
    {
        const int fr = lane & 15, fq = lane >> 4, jt = g >> 1, n0 = 2 * (g & 1), t = 16 * jt + fr;
        f32x4 af[2] = {(f32x4){0.f, 0.f, 0.f, 0.f}, (f32x4){0.f, 0.f, 0.f, 0.f}}, ab[2] = {af[0], af[0]};
#pragma unroll
        for (int kk = 0; kk < 4; ++kk) {
            const bf16x8 a_f = *(const LAS bf16x8*)(QHF + t * LQ + 32 * kk + 8 * fq), a_b = *(const LAS bf16x8*)(QHB + t * LQ + 32 * kk + 8 * fq);
#pragma unroll
            for (int n = 0; n < 2; ++n) {
                const bf16x8 b_f = *(const LAS bf16x8*)(KHF + (16 * (n0 + n) + fr) * LQ + 32 * kk + 8 * fq), b_b = *(const LAS bf16x8*)(KHB + (16 * (n0 + n) + fr) * LQ + 32 * kk + 8 * fq);
                af[n] = mfma16(b_f, a_f, af[n]); ab[n] = mfma16(b_b, a_b, ab[n]);
            }
        }
#pragma unroll
        for (int n = 0; n < 2; ++n) { const int t2b = 16 * (n0 + n) + 4 * fq; float p[4];
#pragma unroll
            for (int r = 0; r < 4; ++r) p[r] = (t2b + r <= t ? af[n][r] : 0.f) + (t2b + r >= t ? ab[n][r] : 0.f);
            u32x2 ow; ow.x = pk2(p[0], p[1]); ow.y = pk2(p[2], p[3]);
            *(LAS u32x2*)(PL + t * LT + t2b) = ow; }
    }
    LDS_BARRIER();
    *(u32x4*)(F.pia() + ((size_t)(c * 8 + h) * 64 + (F.tid >> 3)) * 64 + (F.tid & 7) * 8) = *(const LAS u32x4*)(PL + (F.tid >> 3) * LT + (F.tid & 7) * 8);
    LDS_BARRIER();
}

__device__ __forceinline__ void ret_local_item(const Ctx& F, int c, int h) {
    LAS bf16_t* QH = (LAS bf16_t*)F.lds; LAS bf16_t* KH = QH + 64 * LQ; LAS bf16_t* VTL = KH + 64 * LQ; LAS bf16_t* PL = VTL + 256 * LT;
    const int lane = F.lane, w = F.wave, t0 = c * 64;
    const float lg2 = __builtin_amdgcn_logf(1.f - __builtin_amdgcn_exp2f((float)(-5 - h)));
    const float scale = 0.08838834764831845f;
    const size_t imgF = ((size_t)(0 * NCH + c) * 8 + h) * 8192, imgB = ((size_t)(1 * NCH + c) * 8 + h) * 8192;
    u32x2 vw_[8];
    {
        const int cq = lane & 31, tg = w * 2 + (lane >> 5), c1 = 2 * cq;
        unsigned kf[4][2];
        unsigned qa_[4], qb_[4], ka_[4], kb_[4]; f32x4 cs_[4];
#pragma unroll
        for (int jj = 0; jj < 4; ++jj) { const int t = 4 * tg + jj; const bf16_t* row = F.eab() + (size_t)(t0 + t) * LDEAB + h * 128 + c1;
            qa_[jj] = *(const unsigned*)(row + E_BQ); qb_[jj] = *(const unsigned*)(row + E_BQ + 64); ka_[jj] = *(const unsigned*)(row + E_BK); kb_[jj] = *(const unsigned*)(row + E_BK + 64);
            cs_[jj] = *(const f32x4*)(F.rope() + (size_t)(t0 + t) * 64 + c1); }
#pragma unroll
        for (int jj = 0; jj < 8; ++jj) vw_[jj] = *(const u32x2*)(F.eab() + (size_t)(t0 + 8 * w + jj) * LDEAB + E_BV + h * 256 + 4 * lane);
#pragma unroll
        for (int jj = 0; jj < 4; ++jj) {
            const int t = 4 * tg + jj;
            const unsigned qa = qa_[jj], qb = qb_[jj], ka = ka_[jj], kbw = kb_[jj];
            const f32x4 cs = cs_[jj];
            const float q1[2] = {__uint_as_float(qa << 16), __uint_as_float(qa & 0xffff0000u)}, q2[2] = {__uint_as_float(qb << 16), __uint_as_float(qb & 0xffff0000u)};
            const float k1[2] = {__uint_as_float(ka << 16), __uint_as_float(ka & 0xffff0000u)}, k2[2] = {__uint_as_float(kbw << 16), __uint_as_float(kbw & 0xffff0000u)};
            const float co[2] = {cs.x, cs.z}, si[2] = {cs.y, cs.w};
            float qh[4], kh[4];
#pragma unroll
            for (int e = 0; e < 2; ++e) { qh[e] = q1[e] * co[e] - q2[e] * si[e]; qh[2 + e] = q2[e] * co[e] + q1[e] * si[e];
                kh[e] = (k1[e] * co[e] - k2[e] * si[e]) * scale; kh[2 + e] = (k2[e] * co[e] + k1[e] * si[e]) * scale; }
            *(LAS unsigned*)(QH + t * LQ + c1) = pk2(qh[0], qh[1]); *(LAS unsigned*)(QH + t * LQ + 64 + c1) = pk2(qh[2], qh[3]);
            *(LAS unsigned*)(KH + t * LQ + c1) = pk2(kh[0], kh[1]); *(LAS unsigned*)(KH + t * LQ + 64 + c1) = pk2(kh[2], kh[3]);
            bf16_t* qf = F.qtb() + imgF + t * 128 + c1;
            *(unsigned*)qf = pk2(qh[0], qh[1]); *(unsigned*)(qf + 64) = pk2(qh[2], qh[3]);
#pragma unroll
            for (int e = 0; e < 4; ++e) { const unsigned a = f2bf(kh[e]);
                if (jj & 1) kf[e][jj >> 1] |= a << 16; else kf[e][jj >> 1] = a; }
        }
#pragma unroll
        for (int e = 0; e < 4; ++e) { const int ch = c1 + (e & 1) + 64 * (e >> 1);
            *(u32x2*)(F.ktb() + imgF + ch * 64 + 4 * tg) = (u32x2){kf[e][0], kf[e][1]}; }
    }
    {
        const int g = w; unsigned vt[4][4];
#pragma unroll
        for (int jj = 0; jj < 8; ++jj) {
            const u32x2 vw = vw_[jj];
            const unsigned v4[4] = {vw.x & 0xffffu, vw.x >> 16, vw.y & 0xffffu, vw.y >> 16};
#pragma unroll
            for (int e = 0; e < 4; ++e) { if (jj & 1) vt[e][jj >> 1] |= v4[e] << 16; else vt[e][jj >> 1] = v4[e]; }
        }
#pragma unroll
        for (int e = 0; e < 4; ++e) { const int ch = 4 * lane + e; const u32x4 vv = (u32x4){vt[e][0], vt[e][1], vt[e][2], vt[e][3]};
            *(u32x4*)(F.vtb() + ((size_t)(c * 8 + h) * 256 + ch) * 64 + 8 * g) = vv; }
    }
    LDS_BARRIER();
    {
        const int fr = lane & 15, fq = lane >> 4, jt = w >> 1, n0 = 2 * (w & 1), t = 16 * jt + fr;
        f32x4 ac[2] = {(f32x4){0.f, 0.f, 0.f, 0.f}, (f32x4){0.f, 0.f, 0.f, 0.f}};
#pragma unroll
        for (int kk = 0; kk < 4; ++kk) {
            const bf16x8 a = *(const LAS bf16x8*)(QH + t * LQ + 32 * kk + 8 * fq);
#pragma unroll
            for (int n = 0; n < 2; ++n) ac[n] = mfma16(*(const LAS bf16x8*)(KH + (16 * (n0 + n) + fr) * LQ + 32 * kk + 8 * fq), a, ac[n]);
        }
#pragma unroll
        for (int n = 0; n < 2; ++n) { const int t2b = 16 * (n0 + n) + 4 * fq; float p[4];
#pragma unroll
            for (int r = 0; r < 4; ++r) { const int dd = t > t2b + r ? t - (t2b + r) : (t2b + r) - t; p[r] = ac[n][r] * __builtin_amdgcn_exp2f((float)dd * lg2); }
            u32x2 ow; ow.x = pk2(p[0], p[1]); ow.y = pk2(p[2], p[3]);
            *(LAS u32x2*)(PL + t * LT + t2b) = ow; }
    }
    LDS_BARRIER();
    *(u32x4*)(F.pib() + ((size_t)(c * 8 + h) * 64 + (F.tid >> 3)) * 64 + (F.tid & 7) * 8) = *(const LAS u32x4*)(PL + (F.tid >> 3) * LT + (F.tid & 7) * 8);
    LDS_BARRIER();
}

constexpr int NSEG = 8, CPS = NCH / NSEG;
template <int MIX, int MODE> __device__ __forceinline__ void chain_seg_item(const Ctx& F, int item, int seg) {
    LAS bf16_t* QL0 = (LAS bf16_t*)F.lds; LAS bf16_t* KL0 = QL0 + 64 * LQ; LAS bf16_t* QL1 = KL0 + 128 * LT; LAS bf16_t* KL1 = QL1 + 64 * LQ; LAS float* DL = (LAS float*)(KL1 + 128 * LT);
    LAS bf16_t* PL0 = (LAS bf16_t*)(DL + 256); LAS bf16_t* PL1 = PL0 + 64 * LT;
    const bf16_t* PI = MIX == 0 ? F.pia() : F.pib();
    const int lane = F.lane, w = F.wave, tid = F.tid, fr = lane & 15, fq = lane >> 4;
    const int h = MIX == 0 ? item : (item >> 1), vhalf = MIX == 0 ? 0 : (item & 1), sitem = MIX == 0 ? item : 8 + item;
    const int ocol = (MIX == 0 ? h * 128 : 1024 + h * 256 + vhalf * 128) + 16 * w + 4 * fq;
    const bf16_t* QT = MIX == 0 ? F.qta() : F.qtb(); const bf16_t* KT = MIX == 0 ? F.kta() : F.ktb(); const bf16_t* VT = MIX == 0 ? F.vta() : F.vtb();
    const int vrow = (MIX == 0 ? 0 : vhalf * 128) + 16 * w + fr, VW = MIX == 0 ? 128 : 256;
    const float g64 = MIX == 1 ? __builtin_amdgcn_exp2f(64.f * __builtin_amdgcn_logf(1.f - __builtin_amdgcn_exp2f((float)(-5 - h)))) : 1.f;
    f32x4* SLOC = (f32x4*)F.sloc(); float* DSEG = F.dseg();
#define SLOC_AT(d_, s_, a_) SLOC[((((size_t)(sitem * 2 + (d_)) * NSEG + (s_)) * 8 + (a_)) * 8 + w) * 64 + lane]
    const float lg2g = MIX == 1 ? __builtin_amdgcn_logf(1.f - __builtin_amdgcn_exp2f((float)(-5 - h))) : 0.f;
    const float gam = 1.f - __builtin_amdgcn_exp2f((float)(-5 - h)), gami = __builtin_amdgcn_rcpf(gam); (void)gam; (void)gami;
    f32x4 S0[8], S1[8];
#pragma unroll
    for (int a = 0; a < 8; ++a) { S0[a] = (f32x4){0.f, 0.f, 0.f, 0.f}; S1[a] = S0[a]; }
    if (MODE == 1) {
        const float gseg = MIX == 1 ? __builtin_amdgcn_exp2f((float)(64 * CPS) * __builtin_amdgcn_logf(1.f - __builtin_amdgcn_exp2f((float)(-5 - h)))) : 1.f;
#pragma unroll 1
        for (int i = 0; i < NSEG - 1; ++i) {
            const bool fw = i < seg; const int s = fw ? i : NSEG - 1 - (i - seg), dI = fw ? 0 : 1;
            f32x4 ld[8], dvv[8];
#pragma unroll
            for (int a = 0; a < 8; ++a) { ld[a] = SLOC_AT(dI, s, a);
                dvv[a] = MIX == 0 ? *(const f32x4*)(DSEG + ((size_t)(h * 2 + dI) * NSEG + s) * 128 + 16 * a + 4 * fq) : (f32x4){gseg, gseg, gseg, gseg}; }
            __builtin_amdgcn_sched_barrier(0);
            if (fw) {
#pragma unroll
                for (int a = 0; a < 8; ++a) S0[a] = S0[a] * dvv[a] + ld[a];
            } else {
#pragma unroll
                for (int a = 0; a < 8; ++a) S1[a] = S1[a] * dvv[a] + ld[a];
            }
        }
    }
    float one_ = 1.f; asm volatile("" : "+v"(one_));
    u32x4 qreg[2][2], kreg[2][2], preg[2]; bf16x8 vreg[2][2]; f32x4 dreg = (f32x4){one_, one_, one_, one_}, dprod = dreg;
#define CS_ISSUE(i_) do { _Pragma("unroll") for (int d = 0; d < 2; ++d) { const int c__ = d ? seg * CPS + CPS - 1 - (i_) : seg * CPS + (i_); const size_t img = ((size_t)((MIX == 1 ? 0 : d) * NCH + c__) * 8 + h) * 8192; \
            _Pragma("unroll") for (int i = 0; i < 2; ++i) { if (MODE == 1) qreg[d][i] = *(const u32x4*)(QT + img + (size_t)(tid + 512 * i) * 8); kreg[d][i] = *(const u32x4*)(KT + img + (size_t)(tid + 512 * i) * 8); } \
            _Pragma("unroll") for (int ks = 0; ks < 2; ++ks) vreg[d][ks] = *(const bf16x8*)(VT + ((size_t)(c__ * 8 + h) * VW + vrow) * 64 + 32 * ks + 8 * fq); \
            if (MODE == 1 && (i_) < CPS / 2) preg[d] = *(const u32x4*)(PI + (size_t)(c__ * 8 + h) * 4096 + (size_t)tid * 8); } \
            if (MIX == 0 && tid < 64) { const int d = tid >> 5; const int c__ = d ? seg * CPS + CPS - 1 - (i_) : seg * CPS + (i_); dreg = *(const f32x4*)(F.da() + ((size_t)(d * NCH + c__) * 8 + h) * 128 + 4 * (tid & 31)); } } while (0)
    CS_ISSUE(0);
    u32x2 oreg[2][4];
#define CS_OLOAD(i_) do { if (MODE == 1) { const int cf_ = seg * CPS + (i_), cb_ = seg * CPS + CPS - 1 - (i_); _Pragma("unroll") for (int tt = 0; tt < 4; ++tt) { \
            oreg[0][tt] = *(const u32x2*)(F.obuf() + (size_t)(cf_ * 64 + 16 * tt + (F.lane & 15)) * YW + ocol); oreg[1][tt] = *(const u32x2*)(F.obuf() + (size_t)(cb_ * 64 + 16 * tt + (F.lane & 15)) * YW + ocol); } } } while (0)
#pragma unroll 1
    for (int it = 0; it < CPS; ++it) {
        const int cf = seg * CPS + it, cb = seg * CPS + CPS - 1 - it;
        int tid_l = F.tid; asm volatile("" : "+v"(tid_l)); const int tid = tid_l, lane = tid_l & 63, fr = lane & 15, fq = lane >> 4; (void)lane;
#pragma unroll
        for (int i = 0; i < 2; ++i) { const int p = tid + 512 * i;
            if (MODE == 1 && MIX == 1) {
                const int tq = p >> 4;
#pragma unroll
                for (int d2 = 0; d2 < 2; ++d2) { u32x4 qw = qreg[d2][i]; const float sc = __builtin_amdgcn_exp2f((float)(d2 ? 64 - tq : tq + 1) * lg2g);
#pragma unroll
                    for (int e2 = 0; e2 < 4; ++e2) qw[e2] = pk2(__uint_as_float(qw[e2] << 16) * sc, __uint_as_float(qw[e2] & 0xffff0000u) * sc);
                    qreg[d2][i] = qw; }
            }
            if (MODE == 1) { *(LAS u32x4*)(QL0 + (p >> 4) * LQ + (p & 15) * 8) = qreg[0][i]; *(LAS u32x4*)(QL1 + (p >> 4) * LQ + (p & 15) * 8) = qreg[1][i]; }
            if (MIX == 1) {
                const int tq0 = (p & 7) * 8;
#pragma unroll
                for (int d2 = 0; d2 < 2; ++d2) { u32x4 kw = kreg[d2][i];
                    float sc = __builtin_amdgcn_exp2f((float)(d2 ? tq0 : 63 - tq0) * lg2g); const float st = d2 ? gam : gami;
#pragma unroll
                    for (int e2 = 0; e2 < 4; ++e2) { const float s0 = sc, s1 = sc * st; sc = s1 * st;
                        kw[e2] = pk2(__uint_as_float(kw[e2] << 16) * s0, __uint_as_float(kw[e2] & 0xffff0000u) * s1); }
                    kreg[d2][i] = kw; __builtin_amdgcn_sched_barrier(0); }
            }
            *(LAS u32x4*)(KL0 + (p >> 3) * LT + (p & 7) * 8) = kreg[0][i]; *(LAS u32x4*)(KL1 + (p >> 3) * LT + (p & 7) * 8) = kreg[1][i]; }
        if (MIX == 0 && tid < 64) { *(LAS f32x4*)(DL + 4 * tid) = dreg; dprod = dprod * dreg; }
        const bool first = MODE == 1 && it < CPS / 2;
        if (first) { *(LAS u32x4*)(PL0 + (tid >> 3) * LT + (tid & 7) * 8) = preg[0]; *(LAS u32x4*)(PL1 + (tid >> 3) * LT + (tid & 7) * 8) = preg[1]; }
        const bf16x8 vf00 = vreg[0][0], vf01 = vreg[0][1], vf10 = vreg[1][0], vf11 = vreg[1][1];
        LDS_BARRIER();
        if (it + 1 < CPS) CS_ISSUE(it + 1);
#pragma unroll
        for (int d = 0; d < 2; ++d) {
            f32x4 (&S)[8] = d ? S1 : S0; const LAS bf16_t* QL = d ? QL1 : QL0; const LAS bf16_t* KL = d ? KL1 : KL0; const int t0 = (d ? cb : cf) * 64;
            if (MODE == 1) {
                bf16x8 sf[4];
#pragma unroll
                for (int kk = 0; kk < 4; ++kk) { u32x4 pw; pw.x = pk2(S[2 * kk][0], S[2 * kk][1]); pw.y = pk2(S[2 * kk][2], S[2 * kk][3]); pw.z = pk2(S[2 * kk + 1][0], S[2 * kk + 1][1]); pw.w = pk2(S[2 * kk + 1][2], S[2 * kk + 1][3]);
                    sf[kk] = __builtin_bit_cast(bf16x8, pw); }
                const LAS bf16_t* PLd = d ? PL1 : PL0; const bf16x8 va0 = d ? vf10 : vf00, va1 = d ? vf11 : vf01;
#pragma unroll
                for (int tt = 0; tt < 4; ++tt) {
                    f32x4 acc = (f32x4){0.f, 0.f, 0.f, 0.f};
                    if (first) {
                        acc = mfma16(va0, *(const LAS bf16x8*)(PLd + (16 * tt + fr) * LT + 8 * fq), acc);
                        acc = mfma16(va1, *(const LAS bf16x8*)(PLd + (16 * tt + fr) * LT + 32 + 8 * fq), acc);
                    }
#pragma unroll
                    for (int kk = 0; kk < 4; ++kk) {
                        const LAS bf16_t* qp = QL + (16 * tt + fr) * LQ + 32 * kk + 4 * fq;
                        const u32x2 lo = *(const LAS u32x2*)qp, hi = *(const LAS u32x2*)(qp + 16);
                        const u32x4 bw = (u32x4){lo.x, lo.y, hi.x, hi.y};
                        acc = mfma16(sf[kk], __builtin_bit_cast(bf16x8, bw), acc);
                    }
                    const u32x2 ow = first ? (u32x2){0u, 0u} : (d ? oreg[1][tt] : oreg[0][tt]);
                    u32x2 nw; nw.x = pk2(__uint_as_float(ow.x << 16) + acc[0], __uint_as_float(ow.x & 0xffff0000u) + acc[1]); nw.y = pk2(__uint_as_float(ow.y << 16) + acc[2], __uint_as_float(ow.y & 0xffff0000u) + acc[3]);
                    *(u32x2*)(F.obuf() + (size_t)(t0 + 16 * tt + fr) * YW + ocol) = nw;
                }
            }
            const bf16x8 vf0 = d ? vf10 : vf00, vf1 = d ? vf11 : vf01;
#pragma unroll
            for (int a = 0; a < 8; ++a) {
                if (MIX == 0) S[a] = S[a] * *(const LAS f32x4*)(DL + d * 128 + 16 * a + 4 * fq); else S[a] = S[a] * g64;
                S[a] = mfma16(*(const LAS bf16x8*)(KL + (16 * a + fr) * LT + 8 * fq), vf0, S[a]);
                S[a] = mfma16(*(const LAS bf16x8*)(KL + (16 * a + fr) * LT + 32 + 8 * fq), vf1, S[a]);
            }
        }
        if (it + 1 < CPS && it + 1 >= CPS / 2) CS_OLOAD(it + 1);
        LDS_BARRIER();
    }
#undef CS_OLOAD
    if (MODE == 0) {
#pragma unroll
        for (int a = 0; a < 8; ++a) { SLOC_AT(0, seg, a) = S0[a]; SLOC_AT(1, seg, a) = S1[a]; }
        if (MIX == 0 && tid < 64) *(f32x4*)(DSEG + ((size_t)(h * 2 + (tid >> 5)) * NSEG + seg) * 128 + 4 * (tid & 31)) = dprod;
    }
#undef CS_ISSUE
#undef SLOC_AT
}
__device__ __forceinline__ void rwkv_code_pass(const Ctx& F, int l, int part, int nparts) {
    const float* mu = F.in(7) + (size_t)l * 2 * CSHIFT + 3072;
    for (int idx = part * 512 + F.tid; idx < SEQ * 32; idx += nparts * 512) {
        const int t = idx >> 5, pc = idx & 31;
        const int tm = t > 0 ? t - 1 : t, tn = t < SEQ - 1 ? t + 1 : t;
        const bf16_t* cb0 = F.ecb() + 3072 + 8 * pc;
        const u32x4 pw = *(const u32x4*)(cb0 + (size_t)t * LDEC);
        const u32x4 mw = *(const u32x4*)(cb0 + (size_t)tm * LDEC) & (t > 0 ? 0xffffffffu : 0u);
        const u32x4 nw = *(const u32x4*)(cb0 + (size_t)tn * LDEC) & (t < SEQ - 1 ? 0xffffffffu : 0u);
        const f32x4 m0a = *(const f32x4*)(mu + 8 * pc), m0b = *(const f32x4*)(mu + 8 * pc + 4), m1a = *(const f32x4*)(mu + CSHIFT + 8 * pc), m1b = *(const f32x4*)(mu + CSHIFT + 8 * pc + 4);
        float o[8];
#pragma unroll
        for (int e2 = 0; e2 < 4; ++e2) {
#pragma unroll
            for (int hl = 0; hl < 2; ++hl) { const int e = 2 * e2 + hl;
                const float p = hl ? __uint_as_float(pw[e2] & 0xffff0000u) : __uint_as_float(pw[e2] << 16), pm = hl ? __uint_as_float(mw[e2] & 0xffff0000u) : __uint_as_float(mw[e2] << 16), pn = hl ? __uint_as_float(nw[e2] & 0xffff0000u) : __uint_as_float(nw[e2] << 16);
                const float m0 = e < 4 ? m0a[e & 3] : m0b[e & 3], m1 = e < 4 ? m1a[e & 3] : m1b[e & 3];
                float s = p + m0 * (pm - p) + m1 * (pn - p);
                if (pc < 16) s = 1.f - 2.f * __builtin_amdgcn_rcpf(1.f + __builtin_amdgcn_exp2f(2.8853900817779268f * s));
                o[e] = s; } }
        u32x4 ow; ow.x = pk2(o[0], o[1]); ow.y = pk2(o[2], o[3]); ow.z = pk2(o[4], o[5]); ow.w = pk2(o[6], o[7]);
        *(u32x4*)(F.codeb() + (size_t)t * 256 + 8 * pc) = ow;
    }
}
__device__ __forceinline__ void rwkv_local_item(const Ctx& F, int l, int c, int h) {
    LAS bf16_t* AL = (LAS bf16_t*)F.lds; LAS bf16_t* BE = AL + 64 * LT; LAS bf16_t* KTL = BE + 64 * LT; LAS bf16_t* RT = KTL + 64 * LT; LAS bf16_t* VT = RT + 64 * LT;
    LAS bf16_t* BBT = VT + 64 * LT; LAS bf16_t* KBT = BBT + 64 * LT; LAS bf16_t* AAB = KBT + 64 * LT; LAS bf16_t* AAK = AAB + 64 * LT; LAS bf16_t* ARB = AAK + 64 * LT; LAS bf16_t* ARK = ARB + 64 * LT;
    LAS bf16_t* XT = ARK + 64 * LT;
    LAS float* DG = (LAS float*)(XT + 128 * LT);
    LAS bf16_t* TB = (LAS bf16_t*)(DG + 1024);
    LAS bf16_t* RKVS = (LAS bf16_t*)(F.lds + 103424);
    LAS float* TOT = (LAS float*)(F.lds + 129024);
    LAS float* PCV = TOT + 1024;
#define RW_FRESH() int tid_l = F.tid; asm volatile("" : "+v"(tid_l)); const int tid = tid_l, lane = tid_l & 63, fr = lane & 15, fq = lane >> 4; (void)tid; (void)fr; (void)fq
    const int w = F.wave, t0 = c * 64; const int lane = F.lane, col = h * 64 + lane;
    const float* mu = F.in(7) + (size_t)l * 2 * CSHIFT;
    const float mr0 = mu[col], mr1 = mu[CSHIFT + col], mk0 = mu[1024 + col], mk1 = mu[CSHIFT + 1024 + col], mv0 = mu[2048 + col], mv1 = mu[CSHIFT + 2048 + col];
    const float kkw = F.in(12)[l * 1024 + col], kaw = F.in(13)[l * 1024 + col], rkw = F.in(14)[l * 1024 + col];
    float sr[8], sk[8], sv[8], kkn[8];
    float lw2r[2][8], ar[2][8];
    bf16_t pr[10], pk[10], pv[10];
    {
        constexpr int LC = 264, LO = 68;
        LAS bf16_t* CODE = (LAS bf16_t*)F.lds; LAS float* LOUT = (LAS float*)(F.lds + 64 * LC * 2);
        bf16x8 la[2][2]; f32x4 lb[2];
        {
            const int gi = w >> 1, kind = gi >> 1, dd = gi & 1, fr0 = lane & 15, fq0 = lane >> 4;
            const bf16_t* A = F.lwt() + ((size_t)gi * 1024 + h * 64) * 64;
            const float* bias = (kind == 0 ? F.in(8) : F.in(10)) + (l * 2 + dd) * 1024 + h * 64;
#pragma unroll
            for (int ci = 0; ci < 2; ++ci) { const int ct = 2 * (w & 1) + ci;
                la[ci][0] = *(const bf16x8*)(A + (size_t)(16 * ct + fr0) * 64 + 8 * fq0); la[ci][1] = *(const bf16x8*)(A + (size_t)(16 * ct + fr0) * 64 + 32 + 8 * fq0);
                lb[ci] = *(const f32x4*)(bias + 16 * ct + 4 * fq0); }
        }
        u32x4 rkvw[4];
#pragma unroll
        for (int i = 0; i < 4; ++i) { int pp = F.tid + 512 * i; pp = pp < 1584 ? pp : 1583; const int kind = pp >= 1056 ? 2 : (pp >= 528 ? 1 : 0), rem = pp - 528 * kind; int t = t0 - 1 + (rem >> 3); t = t < 0 ? 0 : (t >= SEQ ? SEQ - 1 : t);
            rkvw[i] = *(const u32x4*)(F.ecb() + (size_t)t * LDEC + kind * 1024 + h * 64 + (rem & 7) * 8); }
        u32x4 cpw[4];
#pragma unroll
        for (int hh = 0; hh < 4; ++hh) cpw[hh] = *(const u32x4*)(F.codeb() + (size_t)(t0 + (F.tid >> 3)) * 256 + 32 * (F.tid & 7) + 8 * hh);
        {
            RW_FRESH();
            const int tok = tid >> 3, cg = tid & 7;
#pragma unroll
            for (int hh = 0; hh < 4; ++hh) *(LAS u32x4*)(CODE + tok * LC + 32 * cg + 8 * hh) = cpw[hh];
#pragma unroll
            for (int i = 0; i < 4; ++i) { const int pp = tid + 512 * i; const int kind = pp >= 1056 ? 2 : (pp >= 528 ? 1 : 0), rem = pp - 528 * kind; const int tt = t0 - 1 + (rem >> 3);
                const unsigned okm = (tt >= 0 && tt < SEQ) ? 0xffffffffu : 0u;
                if (pp < 1584) *(LAS u32x4*)(RKVS + (kind * 66 + (rem >> 3)) * 64 + (rem & 7) * 8) = rkvw[i] & okm; }
        }
        LDS_BARRIER();
        {
            RW_FRESH();
            const int gi = w >> 1, kind = gi >> 1;
#pragma unroll
            for (int ci = 0; ci < 2; ++ci) {
                const int ct = 2 * (w & 1) + ci;
                const bf16x8 a0 = la[ci][0], a1 = la[ci][1];
                const f32x4 bv = lb[ci];
#pragma unroll
                for (int tt = 0; tt < 4; ++tt) {
                    f32x4 acc = bv;
                    acc = mfma16(a0, *(const LAS bf16x8*)(CODE + (16 * tt + fr) * LC + gi * 64 + 8 * fq), acc);
                    acc = mfma16(a1, *(const LAS bf16x8*)(CODE + (16 * tt + fr) * LC + gi * 64 + 32 + 8 * fq), acc);
                    f32x4 y;
#pragma unroll
                    for (int r = 0; r < 4; ++r) { const float sg = sigmoidf_(acc[r]); y[r] = kind == 0 ? (-0.6065306597126334f * LOG2E) * sg : sg; }
                    *(LAS f32x4*)(LOUT + (gi * 64 + 16 * tt + fr) * LO + 16 * ct + 4 * fq) = y;
                }
            }
        }
        LDS_BARRIER();
#pragma unroll
        for (int dd = 0; dd < 2; ++dd)
#pragma unroll
            for (int jj = 0; jj < 8; ++jj) { lw2r[dd][jj] = LOUT[(dd * 64 + 8 * w + jj) * LO + lane]; ar[dd][jj] = LOUT[((2 + dd) * 64 + 8 * w + jj) * LO + lane]; }
        LDS_BARRIER();
    }
    {
#pragma unroll
        for (int i = 0; i < 10; ++i) { pr[i] = RKVS[(8 * w + i) * 64 + lane]; pk[i] = RKVS[(66 + 8 * w + i) * 64 + lane]; pv[i] = RKVS[(132 + 8 * w + i) * 64 + lane]; }
#pragma unroll
        for (int jj = 0; jj < 8; ++jj) {
            sr[jj] = bf2f(pr[jj + 1]) + mr0 * (bf2f(pr[jj]) - bf2f(pr[jj + 1])) + mr1 * (bf2f(pr[jj + 2]) - bf2f(pr[jj + 1]));
            sk[jj] = bf2f(pk[jj + 1]) + mk0 * (bf2f(pk[jj]) - bf2f(pk[jj + 1])) + mk1 * (bf2f(pk[jj + 2]) - bf2f(pk[jj + 1]));
            sv[jj] = bf2f(pv[jj + 1]) + mv0 * (bf2f(pv[jj]) - bf2f(pv[jj + 1])) + mv1 * (bf2f(pv[jj + 2]) - bf2f(pv[jj + 1]));
            F.svb()[(size_t)(t0 + 8 * w + jj) * 1024 + col] = (bf16_t)f2bf(sv[jj]);
        }
        float kq[8];
#pragma unroll
        for (int jj = 0; jj < 8; ++jj) { const float kkr = sk[jj] * kkw; kq[jj] = kkr * kkr; }
        const float ksum = multi_sum8(kq, lane);
#pragma unroll
        for (int jj = 0; jj < 8; ++jj) kkn[jj] = sk[jj] * kkw * __builtin_amdgcn_rsqf(rlf(ksum, ms8_lane(jj)) + 1e-12f);
    }
    {
        float t0s = 0.f, t1s = 0.f;
#pragma unroll
        for (int jj = 0; jj < 8; ++jj) { t0s += lw2r[0][jj]; t1s += lw2r[1][jj]; }
        TOT[w * 64 + lane] = t0s; TOT[512 + w * 64 + lane] = t1s;
    }
    LDS_BARRIER();
    f32x4 oacc[2] = {(f32x4){0.f, 0.f, 0.f, 0.f}, (f32x4){0.f, 0.f, 0.f, 0.f}};
#pragma unroll 1
    for (int d = 0; d < 2; ++d) {
        {
            float lw2[8], av[8], kd[8];
            float bq[8];
#pragma unroll
            for (int jj = 0; jj < 8; ++jj) { lw2[jj] = d ? lw2r[1][jj] : lw2r[0][jj]; av[jj] = d ? ar[1][jj] : ar[0][jj]; kd[jj] = sk[jj] * (1.f + (av[jj] - 1.f) * kaw);
                bq[jj] = sr[jj] * kd[jj] * rkw; }
            const float bonl = multi_sum8(bq, lane);
            if (lane < 8) F.bons()[((size_t)d * SEQ + t0 + 8 * w + ms8_index(lane)) * 16 + h] = bonl;
            unsigned bbp[4] = {0u, 0u, 0u, 0u}, kbp[4] = {0u, 0u, 0u, 0u}, vtp[4] = {0u, 0u, 0u, 0u};
            const int j0 = d ? 63 - (8 * w + 7) : 8 * w;
            float off = 0.f, l63 = 0.f;
#pragma unroll
            for (int gg = 0; gg < 8; ++gg) { const float tg = TOT[d * 512 + gg * 64 + lane]; l63 += tg; const bool bef = d == 0 ? gg < w : gg > w; off += bef ? tg : 0.f; }
            if (w == 0) PCV[lane] = __builtin_amdgcn_exp2f(l63);
            float lam[8];
            if (d == 0) { float run = off;
#pragma unroll
                for (int jj = 0; jj < 8; ++jj) { run += lw2[jj]; lam[jj] = run; } }
            else { float run = off;
#pragma unroll
                for (int jj = 7; jj >= 0; --jj) { run += lw2[jj]; lam[jj] = run; } }
#pragma unroll
            for (int jj = 0; jj < 8; ++jj) {
                const int tl = 8 * w + jj, j = d ? 63 - tl : tl;
                const float ep = __builtin_amdgcn_exp2f(lam[jj]), en = __builtin_amdgcn_exp2f(-lam[jj]), eb = __builtin_amdgcn_exp2f(l63 - lam[jj]);
                const float bet = kkn[jj] * av[jj];
                AL[j * LT + lane] = (bf16_t)f2bf(-kkn[jj] * __builtin_amdgcn_exp2f(lam[jj] - lw2[jj]));
                BE[j * LT + lane] = (bf16_t)f2bf(bet * en); KTL[j * LT + lane] = (bf16_t)f2bf(kd[jj] * en); RT[j * LT + lane] = (bf16_t)f2bf(sr[jj] * ep);
                const unsigned bb = f2bf(bet * eb), kb = f2bf(kd[jj] * eb), vb = f2bf(sv[jj]);
                bbp[jj >> 1] |= bb << (16 * (jj & 1)); kbp[jj >> 1] |= kb << (16 * (jj & 1)); vtp[jj >> 1] |= vb << (16 * (jj & 1));
                if ((jj & 3) == 3) __builtin_amdgcn_sched_barrier(0);
            }
            if (d) {
#pragma unroll
                for (int q = 0; q < 2; ++q) { unsigned a, b;
                    a = bbp[q]; b = bbp[3 - q]; bbp[q] = (b >> 16) | (b << 16); bbp[3 - q] = (a >> 16) | (a << 16);
                    a = kbp[q]; b = kbp[3 - q]; kbp[q] = (b >> 16) | (b << 16); kbp[3 - q] = (a >> 16) | (a << 16);
                    a = vtp[q]; b = vtp[3 - q]; vtp[q] = (b >> 16) | (b << 16); vtp[3 - q] = (a >> 16) | (a << 16); }
            }
            *(LAS u32x4*)(VT + lane * LT + j0) = (u32x4){vtp[0], vtp[1], vtp[2], vtp[3]};
            *(LAS u32x4*)(BBT + lane * LT + j0) = (u32x4){bbp[0], bbp[1], bbp[2], bbp[3]};
            *(LAS u32x4*)(KBT + lane * LT + j0) = (u32x4){kbp[0], kbp[1], kbp[2], kbp[3]};
        }
        LDS_BARRIER();
        {
            RW_FRESH(); const int blk = w >> 1;
            const LAS bf16_t* Am = blk < 2 ? AL : RT; const LAS bf16_t* Bm = (blk & 1) ? KTL : BE;
            LAS bf16_t* Om = blk == 0 ? AAB : (blk == 1 ? AAK : (blk == 2 ? ARB : ARK));
            const int incl = blk >> 1;
#pragma unroll
            for (int ri = 0; ri < 2; ++ri) {
                const int jt = 2 * (w & 1) + ri, j = 16 * jt + fr;
                const bf16x8 a0 = *(const LAS bf16x8*)(Am + j * LT + 8 * fq), a1 = *(const LAS bf16x8*)(Am + j * LT + 32 + 8 * fq);
#pragma unroll
                for (int ct = 0; ct < 4; ++ct) {
                    f32x4 acc = (f32x4){0.f, 0.f, 0.f, 0.f};
                    acc = mfma16(*(const LAS bf16x8*)(Bm + (16 * ct + fr) * LT + 8 * fq), a0, acc);
                    acc = mfma16(*(const LAS bf16x8*)(Bm + (16 * ct + fr) * LT + 32 + 8 * fq), a1, acc);
                    const int j2b = 16 * ct + 4 * fq;
                    float v[4];
#pragma unroll
                    for (int r = 0; r < 4; ++r) v[r] = (j2b + r < j + incl) ? acc[r] : 0.f;
                    if (blk == 0 && ct == jt) *(LAS f32x4*)(DG + jt * 256 + fr * 16 + 4 * fq) = (f32x4){v[0], v[1], v[2], v[3]};
                    u32x2 ow; ow.x = pk2(v[0], v[1]); ow.y = pk2(v[2], v[3]);
                    *(LAS u32x2*)(Om + j * LT + j2b) = ow;
                }
            }
        }
        LDS_BARRIER();
        f32x4 rhs[4];
        {
            RW_FRESH();
            if (w >= 4) {
#pragma unroll
                for (int bi = 0; bi < 4; ++bi) { f32x4 acc = (f32x4){0.f, 0.f, 0.f, 0.f};
#pragma unroll
                    for (int ks = 0; ks < 2; ++ks) acc = mfma16(*(const LAS bf16x8*)(AAK + (16 * bi + fr) * LT + 32 * ks + 8 * fq), *(const LAS bf16x8*)(VT + (16 * (w - 4) + fr) * LT + 32 * ks + 8 * fq), acc);
                    rhs[bi] = acc; }
            } else {
#pragma unroll
                for (int bi = 0; bi < 4; ++bi)
#pragma unroll
                    for (int r = 0; r < 4; ++r) rhs[bi][r] = bf2f(AL[(16 * bi + 4 * fq + r) * LT + 16 * w + fr]);
            }
            if (w == 0) {
                const int blk = lane >> 4, cc = lane & 15; float x[16];
#pragma unroll
                for (int jl = 0; jl < 16; ++jl) {
                    float s = (jl == cc) ? 1.f : 0.f;
#pragma unroll
                    for (int j2 = 0; j2 < jl; ++j2) s += DG[blk * 256 + jl * 16 + j2] * x[j2];
                    x[jl] = s;
                    TB[blk * 384 + jl * 24 + cc] = (bf16_t)f2bf(s);
                }
            }
        }
        LDS_BARRIER();
        {
            RW_FRESH();
            f32x4 X[4]; const u32x2 z2 = (u32x2){0u, 0u};
#pragma unroll
            for (int bi = 0; bi < 4; ++bi) {
                f32x4 s = rhs[bi];
                if (bi >= 1) {
                    u32x4 bw; bw.x = pk2(X[0][0], X[0][1]); bw.y = pk2(X[0][2], X[0][3]);
                    if (bi >= 2) { bw.z = pk2(X[1][0], X[1][1]); bw.w = pk2(X[1][2], X[1][3]); } else { bw.z = 0u; bw.w = 0u; }
                    const LAS bf16_t* ap = AAB + (16 * bi + fr) * LT + 4 * fq; const u32x2 lo = *(const LAS u32x2*)ap, hi = *(const LAS u32x2*)(ap + 16);
                    const u32x4 aw = (u32x4){lo.x, lo.y, hi.x, hi.y};
                    s = mfma16(__builtin_bit_cast(bf16x8, aw), __builtin_bit_cast(bf16x8, bw), s);
                }
                if (bi == 3) {
                    u32x4 bw; bw.x = pk2(X[2][0], X[2][1]); bw.y = pk2(X[2][2], X[2][3]); bw.z = 0u; bw.w = 0u;
                    const LAS bf16_t* ap = AAB + (48 + fr) * LT + 32 + 4 * fq; const u32x2 lo = *(const LAS u32x2*)ap;
                    const u32x4 aw = (u32x4){lo.x, lo.y, z2.x, z2.y};
                    s = mfma16(__builtin_bit_cast(bf16x8, aw), __builtin_bit_cast(bf16x8, bw), s);
                }
                {
                    u32x4 bw; bw.x = pk2(s[0], s[1]); bw.y = pk2(s[2], s[3]); bw.z = 0u; bw.w = 0u;
                    const u32x2 lo = *(const LAS u32x2*)(TB + bi * 384 + fr * 24 + 4 * fq);
                    const u32x4 aw = (u32x4){lo.x, lo.y, z2.x, z2.y};
                    X[bi] = mfma16(__builtin_bit_cast(bf16x8, aw), __builtin_bit_cast(bf16x8, bw), (f32x4){0.f, 0.f, 0.f, 0.f});
                }
                u32x2 ow; ow.x = pk2(X[bi][0], X[bi][1]); ow.y = pk2(X[bi][2], X[bi][3]);
                *(LAS u32x2*)(XT + (16 * w + fr) * LT + 16 * bi + 4 * fq) = ow;
            }
        }
        LDS_BARRIER();
        {
            RW_FRESH();
            const size_t img = ((size_t)(d * NCH + c) * 16 + h) * 4096;
#pragma unroll
            for (int ti = 0; ti < 2; ++ti) {
                const int tile = 2 * w + ti, rt = tile >> 2, ct = tile & 3;
                {
                    f32x4 acc = (f32x4){0.f, 0.f, 0.f, 0.f};
#pragma unroll
                    for (int ks = 0; ks < 2; ++ks) acc = mfma16(*(const LAS bf16x8*)(XT + (16 * rt + fr) * LT + 32 * ks + 8 * fq), *(const LAS bf16x8*)(ARB + (16 * ct + fr) * LT + 32 * ks + 8 * fq), acc);
                    const int j = 16 * ct + fr, k0 = 16 * rt + 4 * fq;
                    const u32x2 rw = *(const LAS u32x2*)(RT + j * LT + k0);
                    u32x2 ow; ow.x = pk2(acc[0] + __uint_as_float(rw.x << 16), acc[1] + __uint_as_float(rw.x & 0xffff0000u)); ow.y = pk2(acc[2] + __uint_as_float(rw.y << 16), acc[3] + __uint_as_float(rw.y & 0xffff0000u));
                    *(u32x2*)(F.rhi() + img + j * 64 + k0) = ow;
                }
                {
                    f32x4 acc = (f32x4){0.f, 0.f, 0.f, 0.f};
#pragma unroll
                    for (int ks = 0; ks < 2; ++ks) acc = mfma16(*(const LAS bf16x8*)(XT + (16 * rt + fr) * LT + 32 * ks + 8 * fq), *(const LAS bf16x8*)(BBT + (16 * ct + fr) * LT + 32 * ks + 8 * fq), acc);
                    const int k = 16 * ct + fr, kp0 = 16 * rt + 4 * fq; const float pc = PCV[k];
#pragma unroll
                    for (int r = 0; r < 4; ++r) acc[r] += (kp0 + r == k) ? pc : 0.f;
                    u32x2 ow; ow.x = pk2(acc[0], acc[1]); ow.y = pk2(acc[2], acc[3]);
                    *(u32x2*)(F.mi() + img + k * 64 + kp0) = ow;
                }
                {
                    f32x4 acc = (f32x4){0.f, 0.f, 0.f, 0.f};
#pragma unroll
                    for (int ks = 0; ks < 2; ++ks) {
                        acc = mfma16(*(const LAS bf16x8*)(BBT + (16 * rt + fr) * LT + 32 * ks + 8 * fq), *(const LAS bf16x8*)(XT + (64 + 16 * ct + fr) * LT + 32 * ks + 8 * fq), acc);
                        acc = mfma16(*(const LAS bf16x8*)(KBT + (16 * rt + fr) * LT + 32 * ks + 8 * fq), *(const LAS bf16x8*)(VT + (16 * ct + fr) * LT + 32 * ks + 8 * fq), acc);
                    }
                    const int v = 16 * ct + fr, k0 = 16 * rt + 4 * fq;
                    u32x2 ow; ow.x = pk2(acc[0], acc[1]); ow.y = pk2(acc[2], acc[3]);
                    *(u32x2*)(F.ni() + img + v * 64 + k0) = ow;
                }
                {
                    const int tl = 16 * ct + fr, j = d ? 63 - tl : tl;
                    f32x4 acc = (f32x4){0.f, 0.f, 0.f, 0.f};
#pragma unroll
                    for (int ks = 0; ks < 2; ++ks) {
                        acc = mfma16(*(const LAS bf16x8*)(XT + (64 + 16 * rt + fr) * LT + 32 * ks + 8 * fq), *(const LAS bf16x8*)(ARB + j * LT + 32 * ks + 8 * fq), acc);
                        acc = mfma16(*(const LAS bf16x8*)(VT + (16 * rt + fr) * LT + 32 * ks + 8 * fq), *(const LAS bf16x8*)(ARK + j * LT + 32 * ks + 8 * fq), acc);
                    }
                    if (d) { acc = acc + oacc[ti]; u32x2 ow; ow.x = pk2(acc[0], acc[1]); ow.y = pk2(acc[2], acc[3]);
                        *(u32x2*)(F.obuf() + (size_t)(t0 + tl) * YW + 3072 + h * 64 + 16 * rt + 4 * fq) = ow; }
                    else oacc[ti] = acc;
                }
            }
        }
        LDS_BARRIER();
    }
}
#undef RW_FRESH
constexpr int NSEGC = 16, CPSC = NCH / NSEGC;
constexpr int GSEG = 4;
template <int MODE> __device__ __forceinline__ void rwkv_seg_item(const Ctx& F, int h, int seg) {
    LAS bf16_t* ML0 = (LAS bf16_t*)F.lds; LAS bf16_t* ML1 = ML0 + 64 * LT; LAS bf16_t* RL0 = ML1 + 64 * LT; LAS bf16_t* RL1 = RL0 + 64 * LT;
    const int lane = F.lane, w = F.wave, tid = F.tid, fr = lane & 15, fq = lane >> 4;
    f32x4* NSG = (f32x4*)F.cseg(); bf16_t* MSG = F.cmseg();
#define NSG_AT(d_, s_, a_) NSG[((((size_t)(h * 2 + (d_)) * NSEGC + (s_)) * 4 + (a_)) * 4 + (w & 3)) * 64 + lane]
#define MSG_AT(d_, s_) (MSG + ((size_t)(h * 2 + (d_)) * NSEGC + (s_)) * 4096)
    f32x4 X0[4], X1[4];
#pragma unroll
    for (int a = 0; a < 4; ++a) {
        X0[a] = (f32x4){0.f, 0.f, 0.f, 0.f};
        if (MODE == 0 && w >= 4) {
#pragma unroll
            for (int r = 0; r < 4; ++r) X0[a][r] = (16 * a + 4 * fq + r == 16 * (w - 4) + fr) ? 1.f : 0.f;
        }
        X1[a] = X0[a];
    }
#define RW_SF(X, sf) do { _Pragma("unroll") for (int kk = 0; kk < 2; ++kk) { u32x4 pw; pw.x = pk2(X[2 * kk][0], X[2 * kk][1]); pw.y = pk2(X[2 * kk][2], X[2 * kk][3]); pw.z = pk2(X[2 * kk + 1][0], X[2 * kk + 1][1]); pw.w = pk2(X[2 * kk + 1][2], X[2 * kk + 1][3]); sf[kk] = __builtin_bit_cast(bf16x8, pw); } } while (0)
#define RW_UPD(X, ML, init, sf) do { _Pragma("unroll") for (int a = 0; a < 4; ++a) { f32x4 acc = init[a]; _Pragma("unroll") for (int kk = 0; kk < 2; ++kk) { const LAS bf16_t* mp = ML + (16 * a + fr) * LT + 32 * kk + 4 * fq; \
            const u32x2 lo = *(const LAS u32x2*)mp, hi = *(const LAS u32x2*)(mp + 16); const u32x4 aw = (u32x4){lo.x, lo.y, hi.x, hi.y}; acc = mfma16(__builtin_bit_cast(bf16x8, aw), sf[kk], acc); } init[a] = acc; } \
            _Pragma("unroll") for (int a = 0; a < 4; ++a) X[a] = init[a]; } while (0)
    if (MODE == 1) {
        const int g = seg / GSEG, kq = seg % GSEG, NG = NSEGC / GSEG;
        const int nf = g + (kq > 0 ? 1 : 0), nb = (NG - 1 - g) + (kq < GSEG - 1 ? 1 : 0), ns = nf > nb ? nf : nb;
#pragma unroll 1
        for (int i = 0; i < ns; ++i) {
            const bool df = i < nf, db = i < nb;
            const int sf_ = i < g ? GSEG * i + GSEG - 1 : seg - 1, sb_ = i < NG - 1 - g ? GSEG * (NG - 1 - i) : seg + 1;
            if (df) *(LAS u32x4*)(ML0 + (tid >> 3) * LT + (tid & 7) * 8) = *(const u32x4*)(MSG_AT(0, sf_) + (size_t)tid * 8);
            if (db) *(LAS u32x4*)(ML1 + (tid >> 3) * LT + (tid & 7) * 8) = *(const u32x4*)(MSG_AT(1, sb_) + (size_t)tid * 8);
            LDS_BARRIER();
            if (w < 4) {
                if (df) { bf16x8 sf[2]; RW_SF(X0, sf); f32x4 init[4];
#pragma unroll
                    for (int a = 0; a < 4; ++a) init[a] = NSG_AT(0, sf_, a);
                    RW_UPD(X0, ML0, init, sf); }
                if (db) { bf16x8 sf[2]; RW_SF(X1, sf); f32x4 init[4];
#pragma unroll
                    for (int a = 0; a < 4; ++a) init[a] = NSG_AT(1, sb_, a);
                    RW_UPD(X1, ML1, init, sf); }
            }
            LDS_BARRIER();
        }
    }
    u32x4 mreg[2], rreg[2]; u32x2 nreg[2][4];
    constexpr int NIT = MODE == 0 ? GSEG * CPSC : CPSC;
#define RS_ISSUE(i_) do { _Pragma("unroll") for (int d = 0; d < 2; ++d) { const int c__ = d ? seg * CPSC + NIT - 1 - (i_) : seg * CPSC + (i_); const size_t img = ((size_t)(d * NCH + c__) * 16 + h) * 4096; \
            mreg[d] = *(const u32x4*)(F.mi() + img + (size_t)tid * 8); if (MODE == 1) rreg[d] = *(const u32x4*)(F.rhi() + img + (size_t)tid * 8); \
            if (w < 4) { _Pragma("unroll") for (int a = 0; a < 4; ++a) nreg[d][a] = *(const u32x2*)(F.ni() + img + (16 * w + fr) * 64 + 16 * a + 4 * fq); } } } while (0)
    RS_ISSUE(0);
    u32x2 oreg[2][4];
#define RS_OLOAD(i_) do { if (MODE == 1 && w < 4) { const int cf_ = seg * CPSC + (i_), cb_ = seg * CPSC + NIT - 1 - (i_); _Pragma("unroll") for (int tt = 0; tt < 4; ++tt) { \
            oreg[0][tt] = *(const u32x2*)(F.obuf() + (size_t)(cf_ * 64 + 16 * tt + (F.lane & 15)) * YW + 3072 + h * 64 + 16 * w + 4 * (F.lane >> 4)); \
            oreg[1][tt] = *(const u32x2*)(F.obuf() + (size_t)(cb_ * 64 + 16 * tt + (F.lane & 15)) * YW + 3072 + h * 64 + 16 * w + 4 * (F.lane >> 4)); } } } while (0)
    RS_OLOAD(0);
#pragma unroll 1
    for (int it = 0; it < NIT; ++it) {
        const int cf = seg * CPSC + it, cb = seg * CPSC + NIT - 1 - it;
        *(LAS u32x4*)(ML0 + (tid >> 3) * LT + (tid & 7) * 8) = mreg[0]; *(LAS u32x4*)(ML1 + (tid >> 3) * LT + (tid & 7) * 8) = mreg[1];
        if (MODE == 1) { *(LAS u32x4*)(RL0 + (tid >> 3) * LT + (tid & 7) * 8) = rreg[0]; *(LAS u32x4*)(RL1 + (tid >> 3) * LT + (tid & 7) * 8) = rreg[1]; }
        f32x4 nin[2][4];
#pragma unroll
        for (int d = 0; d < 2; ++d)
#pragma unroll
            for (int a = 0; a < 4; ++a) nin[d][a] = (w < 4) ? (f32x4){__uint_as_float(nreg[d][a].x << 16), __uint_as_float(nreg[d][a].x & 0xffff0000u), __uint_as_float(nreg[d][a].y << 16), __uint_as_float(nreg[d][a].y & 0xffff0000u)} : (f32x4){0.f, 0.f, 0.f, 0.f};
        LDS_BARRIER();
        if (it + 1 < NIT) RS_ISSUE(it + 1);
        if (MODE == 0 || w < 4) {
#pragma unroll
            for (int d = 0; d < 2; ++d) {
                f32x4 (&X)[4] = d ? X1 : X0; const LAS bf16_t* ML = d ? ML1 : ML0; const LAS bf16_t* RL = d ? RL1 : RL0; const int t0 = (d ? cb : cf) * 64;
                bf16x8 sf[2]; RW_SF(X, sf);
                if (MODE == 1) {
#pragma unroll
                    for (int tt = 0; tt < 4; ++tt) {
                        const int tl = 16 * tt + fr, j = d ? 63 - tl : tl;
                        f32x4 acc = (f32x4){0.f, 0.f, 0.f, 0.f};
#pragma unroll
                        for (int kk = 0; kk < 2; ++kk) { const LAS bf16_t* qp = RL + j * LT + 32 * kk + 4 * fq; const u32x2 lo = *(const LAS u32x2*)qp, hi = *(const LAS u32x2*)(qp + 16);
                            const u32x4 bw = (u32x4){lo.x, lo.y, hi.x, hi.y}; acc = mfma16(sf[kk], __builtin_bit_cast(bf16x8, bw), acc); }
                        const u32x2 ow = d ? oreg[1][tt] : oreg[0][tt];
                        u32x2 nw; nw.x = pk2(__uint_as_float(ow.x << 16) + acc[0], __uint_as_float(ow.x & 0xffff0000u) + acc[1]); nw.y = pk2(__uint_as_float(ow.y << 16) + acc[2], __uint_as_float(ow.y & 0xffff0000u) + acc[3]);
                        *(u32x2*)(F.obuf() + (size_t)(t0 + tl) * YW + 3072 + h * 64 + 16 * w + 4 * fq) = nw;
                    }
                }
                RW_UPD(X, ML, nin[d], sf);
            }
        }
        if (it + 1 < NIT) RS_OLOAD(it + 1);
        if (MODE == 0 && (it % CPSC) == CPSC - 1) {
            const int sf_ = seg + it / CPSC, sb_ = seg + GSEG - 1 - it / CPSC;
            if (w < 4) {
#pragma unroll
                for (int a = 0; a < 4; ++a) { NSG_AT(0, sf_, a) = X0[a]; NSG_AT(1, sb_, a) = X1[a]; }
            } else {
#pragma unroll
                for (int a = 0; a < 4; ++a)
#pragma unroll
                    for (int r = 0; r < 4; ++r) { const int k = 16 * a + 4 * fq + r, kp = 16 * (w - 4) + fr;
                        MSG_AT(0, sf_)[k * 64 + kp] = (bf16_t)f2bf(X0[a][r]); MSG_AT(1, sb_)[k * 64 + kp] = (bf16_t)f2bf(X1[a][r]); }
            }
        }
        LDS_BARRIER();
    }
#undef RS_OLOAD
#undef RS_ISSUE
#undef RW_SF
#undef RW_UPD
#undef NSG_AT
#undef MSG_AT
}
__device__ __forceinline__ void unpack8(const u32x4 w, float (&v)[8]) {
    v[0] = __uint_as_float(w.x << 16); v[1] = __uint_as_float(w.x & 0xffff0000u); v[2] = __uint_as_float(w.y << 16); v[3] = __uint_as_float(w.y & 0xffff0000u);
    v[4] = __uint_as_float(w.z << 16); v[5] = __uint_as_float(w.z & 0xffff0000u); v[6] = __uint_as_float(w.w << 16); v[7] = __uint_as_float(w.w & 0xffff0000u);
}
__device__ __forceinline__ u32x4 pack8(const float (&v)[8]) { u32x4 w; w.x = pk2(v[0], v[1]); w.y = pk2(v[2], v[3]); w.z = pk2(v[4], v[5]); w.w = pk2(v[6], v[7]); return w; }
template <int NL> __device__ __forceinline__ float group_sum(float v) {
    if (NL == 8) return row_sum8(v);
    v = row_sum16(v);
    if (NL == 32) { const auto r = __builtin_amdgcn_permlane16_swap(__float_as_uint(v), __float_as_uint(v), false, false); v = __uint_as_float(r[0]) + __uint_as_float(r[1]); }
    return v;
}
__device__ __forceinline__ void norm_phase(const Ctx& F, int l) {
    const int gw = blockIdx.x * NWAVES + F.wave, NGW = F.G * NWAVES, lane = F.lane;
    const float* ga = F.in(4) + l * 1024; const float* gb = F.in(5) + l * 2048; const float* bb = F.in(6) + l * 2048; const float* gc = F.in(15) + l * 1024; const float* bc = F.in(16) + l * 1024;
#pragma unroll 1
    for (int t = gw; t < SEQ; t += NGW) {
        bf16_t* orow = F.obuf() + (size_t)t * YW; const bf16_t* prow = F.lbuf() + (size_t)t * LDL;
        float epsA = 1e-6f, epsB = 1e-5f, epsC = 64e-5f; asm volatile("" : "+s"(epsA), "+s"(epsB), "+s"(epsC));
        u32x4 ow[8], gt[8], svw[2]; float bn[2];
#pragma unroll
        for (int j = 0; j < 8; ++j) { ow[j] = *(const u32x4*)(orow + 8 * (64 * j + lane)); gt[j] = *(const u32x4*)(prow + 8 * (64 * j + lane)); }
#pragma unroll
        for (int j = 0; j < 2; ++j) { const int q = 64 * j + lane, hd = q >> 3;
            svw[j] = *(const u32x4*)(F.svb() + (size_t)t * 1024 + 8 * q); bn[j] = F.bons()[(size_t)t * 16 + hd] + F.bons()[((size_t)SEQ + t) * 16 + hd]; }
#pragma unroll
        for (int j = 0; j < 8; ++j) {
            float o[8], g[8], y[8], pg[8], pb[8]; unpack8(ow[j], o); unpack8(gt[j], g);
#pragma unroll
            for (int e = 0; e < 8; ++e) g[e] = siluf_(g[e]);
            {
                const int ch = 8 * (64 * (j < 2 ? j : j < 6 ? j - 2 : j - 6) + lane);
                const float* gsrc = (j < 2 ? ga : j < 6 ? gb : gc) + ch;
                const f32x4 g0 = *(const f32x4*)gsrc, g1 = *(const f32x4*)(gsrc + 4);
                pg[0] = g0.x; pg[1] = g0.y; pg[2] = g0.z; pg[3] = g0.w; pg[4] = g1.x; pg[5] = g1.y; pg[6] = g1.z; pg[7] = g1.w;
                if (j >= 2) { const float* bsrc = (j < 6 ? bb : bc) + ch; const f32x4 b0 = *(const f32x4*)bsrc, b1 = *(const f32x4*)(bsrc + 4);
                    pb[0] = b0.x; pb[1] = b0.y; pb[2] = b0.z; pb[3] = b0.w; pb[4] = b1.x; pb[5] = b1.y; pb[6] = b1.z; pb[7] = b1.w; }
            }
            if (j < 2) {
                float s = 0.f;
#pragma unroll
                for (int e = 0; e < 8; ++e) s += o[e] * o[e];
                const float r = rsqrtf(group_sum<16>(s) * (1.f / 128.f) + epsA);
#pragma unroll
                for (int e = 0; e < 8; ++e) y[e] = o[e] * r * pg[e] * g[e];
            } else if (j < 6) {
                float s = 0.f;
#pragma unroll
                for (int e = 0; e < 8; ++e) s += o[e];
                const float mean = group_sum<32>(s) * (1.f / 256.f); float q = 0.f;
#pragma unroll
                for (int e = 0; e < 8; ++e) { o[e] -= mean; q += o[e] * o[e]; }
                const float r = rsqrtf(group_sum<32>(q) * (1.f / 256.f) + epsB);
#pragma unroll
                for (int e = 0; e < 8; ++e) y[e] = (o[e] * r * pg[e] + pb[e]) * g[e];
            } else {
                float s = 0.f;
#pragma unroll
                for (int e = 0; e < 8; ++e) s += o[e];
                const float mean = group_sum<8>(s) * (1.f / 64.f); float q = 0.f;
#pragma unroll
                for (int e = 0; e < 8; ++e) { o[e] -= mean; q += o[e] * o[e]; }
                const float r = rsqrtf(group_sum<8>(q) * (1.f / 64.f) + epsC);
                float sv[8]; unpack8(svw[j - 6], sv);
#pragma unroll
                for (int e = 0; e < 8; ++e) y[e] = (o[e] * r * pg[e] + pb[e] + bn[j - 6] * sv[e]) * g[e];
            }
            *(u32x4*)(orow + 8 * (64 * j + lane)) = pack8(y);
            if (j & 1) __builtin_amdgcn_sched_barrier(0);
        }
    }
}
constexpr int PB = 9, PH_PER_LAYER = 2 * PB + 2, NPHASE = 1 + 2 * PH_PER_LAYER;

__global__ void __launch_bounds__(NWAVES * 64, 2) fwd_kernel(Args args) {
    extern __shared__ __attribute__((aligned(16))) unsigned char lds_raw[];
    Ctx F;
    F.lds = (LAS unsigned char*)lds_raw;
    const int ph_lo = args.ph_lo, ph_hi = args.ph_hi;
    if (ph_hi < 0) cg::this_grid().sync();
    volatile LAS unsigned* bst = (volatile LAS unsigned*)(F.lds + LDS_BYTES - 64);
    if (threadIdx.x < 16) bst[threadIdx.x] = 0u;
    __syncthreads();
    XcdBarrier gbar = xcd_barrier_post((unsigned*)(args.ws + WS_BAR), bst);
    if (ph_lo == 0) { KArgs* ap = (KArgs*)__builtin_amdgcn_kernarg_segment_ptr(); asm volatile("" : "+s"(ap)); F.ap = ap; F.tid = threadIdx.x; F.G = gridDim.x; rope_table(F); }
#pragma unroll 1
    for (int ph = ph_lo; ph < ph_hi; ++ph) {
        if (ph > ph_lo) { XcdBarrier gb = gbar; asm volatile("" : "+s"(gb.bar), "+s"(gb.x)); xcd_barrier(gb); }
        { KArgs* ap = (KArgs*)__builtin_amdgcn_kernarg_segment_ptr(); asm volatile("" : "+s"(ap)); F.ap = ap;
          int tid = threadIdx.x; asm volatile("" : "+v"(tid)); F.tid = tid; F.lane = tid & 63; F.wave = __builtin_amdgcn_readfirstlane(tid >> 6);
          int G = gridDim.x; asm volatile("" : "+s"(G)); F.G = G; }
        int bid = blockIdx.x; asm volatile("" : "+s"(bid));
        if (ph == 0) { prep_phase(F, 0); continue; }
        const int l = (ph - 1) / PH_PER_LAYER, r = (ph - 1) % PH_PER_LAYER;
        if (r == 2 * PB + 1) { prep_phase(F, l + 1); continue; }
        const int b = r / PB, k = r % PB;
        const bool is_out = (r == 2 * PB);
        if (!is_out) {
            if (k == 1) {
                for (int it = bid; it < NCH * 8; it += F.G) hgrn_local_item(F, l, it >> 3, it & 7);
                { int tid = threadIdx.x; asm volatile("" : "+v"(tid)); F.tid = tid; F.lane = tid & 63; F.wave = __builtin_amdgcn_readfirstlane(tid >> 6); }
                for (int it = bid; it < NCH * 8; it += F.G) ret_local_item(F, it >> 3, it & 7);
            } else if (k == 2) {
                if (bid < 64) chain_seg_item<0, 0>(F, bid >> 3, bid & 7); else if (bid < 192) chain_seg_item<1, 0>(F, (bid - 64) >> 3, (bid - 64) & 7);
                else rwkv_code_pass(F, l, bid - 192, 64);
            } else if (k == 3) {
                for (int it = bid; it < NCH * 16; it += F.G) rwkv_local_item(F, l, it >> 4, it & 15);
            } else if (k == 4) {
                if (bid < 64) chain_seg_item<0, 1>(F, bid >> 3, bid & 7); else if (bid < 192) chain_seg_item<1, 1>(F, (bid - 64) >> 3, (bid - 64) & 7);
                else { rwkv_seg_item<0>(F, (bid - 192) >> 2, GSEG * ((bid - 192) & 3)); __syncthreads(); }
            } else if (k == 5) { if (bid < 16 * NSEGC) rwkv_seg_item<1>(F, bid >> 4, bid & 15); }
            else if (k == 7) norm_phase(F, l);
        }
        const bool xgemm = !is_out && k == 4 && bid >= 192;
        const bool is_gemm = is_out || k == 0 || k == 6 || k == 8 || xgemm;
        if (is_gemm) {
            const int nsub = (!is_out && k == 8) ? 2 : 1;
#pragma unroll 1
            for (int sub = 0; sub < nsub; ++sub) {
                pg8::Gemm g; pg8::StaticOrder S; EpiAny E; E.l = l; E.b = b; E.s = 0; E.gcol = 0;
                if (is_out) {
                    g = pg8::Gemm{F.mixbf(), F.WoutT(), 1024, 1024, 1024}; S.init(MTOK, DM, F.G, bid); E.kind = 5;
                } else if (k == 0) {
                    g = pg8::Gemm{F.xg() + (size_t)b * SEQ * DM, F.WinT(), 1024, 1024, 1024}; S.init(SEQ, LDE, F.G, bid); E.kind = 0;
                } else if (k == 6) {
                    g = pg8::Gemm{F.xg() + (size_t)b * SEQ * DM, F.WinT() + (size_t)LDE * DM, 1024, 1024, 1024}; S.init(SEQ, LDL, F.G, bid); E.kind = 1;
                } else if (k == 4) {
                    g = pg8::Gemm{F.xg() + (size_t)b * SEQ * DM, F.WinT() + (size_t)(LDE + LDL) * DM, 1024, 1024, 1024}; S.init(SEQ, LDLX, 64, bid - 192); E.kind = 6;
                } else {
                    const int sp = bid & 1, seg4 = 2 * sp + sub, koff = 1024 * seg4;
                    g = pg8::Gemm{F.obuf() + koff, F.WcatT() + koff, YW, YW, 1024}; S.init(SEQ, DM, F.G >> 1, bid >> 1); E.kind = 2 + sub; E.s = sp;
                    E.gcol = L_MG + 1024 * (seg4 == 0 ? 0 : (seg4 == 3 ? 2 : 1));
                }
                pg8::gemm_phase<EpiAny, pg8::StaticOrder>(F.lds, g, S, E);
            }
        }
    }
}

extern "C" void kernel_launch(void* const* d_in, const int* in_sizes, int n_in, void* d_out, int out_size, void* d_ws, size_t ws_size, hipStream_t stream) {
    static int grid = 0;
    if (grid == 0) {
        if (n_in != 22 || in_sizes[0] != MTOK * DM || out_size != MTOK * DM || ws_size < WS_END) { fprintf(stderr, "kernel_launch: unexpected problem (n_in %d, in0 %d, out %d, ws %zu)\n", n_in, n_in > 0 ? in_sizes[0] : -1, out_size, ws_size); grid = -1; return; }
        int dev = 0, cus = 0, per_cu = 0;
        if (hipGetDevice(&dev) != hipSuccess || hipDeviceGetAttribute(&cus, hipDeviceAttributeMultiprocessorCount, dev) != hipSuccess) { grid = -1; return; }
        if (hipFuncSetAttribute((const void*)fwd_kernel, hipFuncAttributeMaxDynamicSharedMemorySize, LDS_BYTES) != hipSuccess) { fprintf(stderr, "kernel_launch: hipFuncSetAttribute failed\n"); grid = -1; return; }
        if (hipOccupancyMaxActiveBlocksPerMultiprocessor(&per_cu, (const void*)fwd_kernel, NWAVES * 64, LDS_BYTES) != hipSuccess || per_cu < 1) { fprintf(stderr, "kernel_launch: occupancy query says %d blocks per CU\n", per_cu); (void)hipGetLastError(); grid = -1; return; }
        if (cus < 256) { fprintf(stderr, "kernel_launch: this build deals the segment items one per workgroup and needs 256 CUs (found %d)\n", cus); grid = -1; return; }
        grid = 256;
    }
    if (grid < 0) return;
    if (hipMemsetAsync((char*)d_ws + WS_CTL, 0, CTL_ZERO_BYTES, stream) != hipSuccess) { fprintf(stderr, "kernel_launch: hipMemsetAsync failed\n"); return; }
    Args a{};
    for (int i = 0; i < 22; ++i) a.in[i] = (const float*)d_in[i];
    a.out = (float*)d_out; a.ws = (unsigned char*)d_ws;
    a.ph_lo = 0; a.ph_hi = NPHASE;
    void* kargs[] = {&a};
    hipError_t e = hipLaunchCooperativeKernel((const void*)fwd_kernel, dim3(grid), dim3(NWAVES * 64), kargs, LDS_BYTES, stream);
    if (e != hipSuccess) fprintf(stderr, "kernel_launch: cooperative launch failed: %s (grid %d)\n", hipGetErrorString(e), grid);
}
```

```cpp
#include <hip/hip_runtime.h>
#include <hip/hip_cooperative_groups.h>
#include <cstdio>
#include <cstdint>
namespace cg = cooperative_groups;

#define LAS __attribute__((address_space(3)))
#define GAS __attribute__((address_space(1)))
typedef unsigned short bf16_t;
typedef short bf16x8 __attribute__((ext_vector_type(8)));
typedef float f32x4 __attribute__((ext_vector_type(4)));
typedef float f32x2 __attribute__((ext_vector_type(2)));
typedef unsigned u32x4 __attribute__((ext_vector_type(4)));
typedef unsigned u32x2 __attribute__((ext_vector_type(2)));

constexpr int DM = 1024, NB = 2, SEQ = 8192, MTOK = NB * SEQ, DEPTH = 2;
constexpr int NIN = 18688;
constexpr int LDE = 11520, LDL = 6144, LDLX = 1024;
constexpr int LDEAB = 8192, LDEC = 3328;
constexpr int E_AQ = 0, E_AFF = 1024, E_AFB = 2048, E_AI = 3072, E_BQ = 4096, E_BK = 5120, E_BV = 6144, E_CS = 8192;
constexpr int L_AG = 0, L_BG = 1024, L_CG = 3072, L_MG = 4096;
constexpr int CSHIFT = 3328;
constexpr int YW = 4096;

__device__ __forceinline__ float bf2f(bf16_t h) { return __uint_as_float((unsigned)h << 16); }
typedef __bf16 bf16x2_t __attribute__((ext_vector_type(2)));
__device__ __forceinline__ unsigned pk2(float lo, float hi) { const f32x2 v = {lo, hi}; return __builtin_bit_cast(unsigned, __builtin_convertvector(v, bf16x2_t)); }
__device__ __forceinline__ unsigned f2bf(float f) { return pk2(f, 0.f) & 0xffffu; }
__device__ __forceinline__ float sigmoidf_(float x) { return __builtin_amdgcn_rcpf(1.0f + __builtin_amdgcn_exp2f(-1.4426950408889634f * x)); }
__device__ __forceinline__ float siluf_(float x) { return x * sigmoidf_(x); }
__device__ __forceinline__ float row_sum16(float v) {
    v += __int_as_float(__builtin_amdgcn_update_dpp(0, __float_as_int(v), 0xB1, 0xf, 0xf, false));
    v += __int_as_float(__builtin_amdgcn_update_dpp(0, __float_as_int(v), 0x4E, 0xf, 0xf, false));
    v += __int_as_float(__builtin_amdgcn_update_dpp(0, __float_as_int(v), 0x141, 0xf, 0xf, false));
    v += __int_as_float(__builtin_amdgcn_update_dpp(0, __float_as_int(v), 0x140, 0xf, 0xf, false));
    return v;
}
__device__ __forceinline__ float row_sum8(float v) {
    v += __int_as_float(__builtin_amdgcn_update_dpp(0, __float_as_int(v), 0xB1, 0xf, 0xf, false));
    v += __int_as_float(__builtin_amdgcn_update_dpp(0, __float_as_int(v), 0x4E, 0xf, 0xf, false));
    v += __int_as_float(__builtin_amdgcn_update_dpp(0, __float_as_int(v), 0x141, 0xf, 0xf, false));
    return v;
}
__device__ __forceinline__ float wave_sum(float v) {
    v = row_sum16(v);
    return __uint_as_float((unsigned)__builtin_amdgcn_readlane((int)__float_as_uint(v), 0)) + __uint_as_float((unsigned)__builtin_amdgcn_readlane((int)__float_as_uint(v), 16))
         + __uint_as_float((unsigned)__builtin_amdgcn_readlane((int)__float_as_uint(v), 32)) + __uint_as_float((unsigned)__builtin_amdgcn_readlane((int)__float_as_uint(v), 48));
}
__device__ __forceinline__ float multi_sum8(const float (&v)[8], int lane) {
    const bool sA = ((lane ^ (lane >> 2)) & 1) != 0, sB = (((lane >> 1) ^ (lane >> 2)) & 1) != 0, sC = (lane & 4) != 0;
    float w[4], x[2];
#pragma unroll
    for (int i = 0; i < 4; ++i) { const float keep = sA ? v[2 * i + 1] : v[2 * i], give = sA ? v[2 * i] : v[2 * i + 1];
        w[i] = keep + __int_as_float(__builtin_amdgcn_update_dpp(0, __float_as_int(give), 0xB1, 0xf, 0xf, false)); }
#pragma unroll
    for (int i = 0; i < 2; ++i) { const float keep = sB ? w[2 * i + 1] : w[2 * i], give = sB ? w[2 * i] : w[2 * i + 1];
        x[i] = keep + __int_as_float(__builtin_amdgcn_update_dpp(0, __float_as_int(give), 0x4E, 0xf, 0xf, false)); }
    float y;
    { const float keep = sC ? x[1] : x[0], give = sC ? x[0] : x[1]; y = keep + __int_as_float(__builtin_amdgcn_update_dpp(0, __float_as_int(give), 0x141, 0xf, 0xf, false)); }
    y += __int_as_float(__builtin_amdgcn_update_dpp(0, __float_as_int(y), 0x128, 0xf, 0xf, false));
    { const auto r = __builtin_amdgcn_permlane16_swap(__float_as_uint(y), __float_as_uint(y), false, false); y = __uint_as_float(r[0]) + __uint_as_float(r[1]); }
    { const auto r = __builtin_amdgcn_permlane32_swap(__float_as_uint(y), __float_as_uint(y), false, false); y = __uint_as_float(r[0]) + __uint_as_float(r[1]); }
    return y;
}
__device__ __forceinline__ constexpr int ms8_lane(int i) { return i < 4 ? i : 11 - i; }
__device__ __forceinline__ int ms8_index(int lane) { return (lane & 4) ? 11 - (lane & 7) : (lane & 7); }
__device__ __forceinline__ float rlf(float x, int k) { return __uint_as_float((unsigned)__builtin_amdgcn_readlane((int)__float_as_uint(x), k)); }
__device__ __forceinline__ f32x4 mfma16(bf16x8 a, bf16x8 b, f32x4 c) { return __builtin_amdgcn_mfma_f32_16x16x32_bf16(a, b, c, 0, 0, 0); }
#define LDS_BARRIER() do { asm volatile("s_waitcnt lgkmcnt(0)" ::: "memory"); __builtin_amdgcn_s_barrier(); asm volatile("" ::: "memory"); } while (0)
namespace pg8 {
constexpr int BM = 256, BK = 64, HALF = 128, HTB = HALF * BK * 2  , STAGE_BYTES = 8 * HTB, NXCD = 8, WGM = 8;

__host__ __device__ __forceinline__ int lds_byte(int r, int c) { const int st = (r >> 4) * 2 + (c >> 5), rr = r & 15, cc = c & 31, ob = rr * 64 + cc * 2; return st * 1024 + (ob ^ (((ob >> 9) & 1) << 5)); }
__host__ __device__ __forceinline__ void stage_rc(int b, int& R, int& C) { const int st = b / 1024, sb = b % 1024, swz = sb ^ (((sb >> 9) & 1) << 5); R = (st >> 1) * 16 + swz / 64; C = (st & 1) * 32 + (swz % 64) / 2; }
__host__ __device__ __forceinline__ int perm32(int rho) { const int n = rho >> 4, i = rho & 15; return 8 * (i >> 2) + 4 * n + (i & 3); }

struct Unit { int pm, pn; };
struct Gemm { const bf16_t* A; const bf16_t* Bt; int lda, ldb, K; };

struct StaticOrder {
    int nM, nN, nwg, G, c;
    __host__ __device__ void init(int M, int N, int G_, int c_) { nM = M / BM; nN = N / BM; nwg = nM * nN; G = G_; c = c_; }
    __host__ __device__ bool next(int i, Unit& u) const {
        const long L = (long)i * G + c; if (L >= nwg) return false;
        int wgid = (int)L; { const int q = nwg / NXCD, r = nwg % NXCD, xcd = wgid % NXCD, off = wgid / NXCD; wgid = (xcd < r ? xcd * (q + 1) : r * (q + 1) + (xcd - r) * q) + off; }
        const int nig = WGM * nN, gid = wgid / nig, fm = gid * WGM, gsz = (nM - fm) < WGM ? (nM - fm) : WGM;
        u.pm = fm + ((wgid % nig) % gsz); u.pn = (wgid % nig) / gsz; return true;
    }
};

__device__ __forceinline__ unsigned cvt_pk_bf16(float lo, float hi) { unsigned r; asm volatile("v_cvt_pk_bf16_f32 %0, %1, %2" : "=v"(r) : "v"(lo), "v"(hi)); return r; }

template <class Epi, class Sched>
__device__ __forceinline__ void gemm_phase(LAS unsigned char* lds, const Gemm g, const Sched& S, const Epi& E) {
    int tid = threadIdx.x; asm volatile("" : "+v"(tid));
    const int wid = __builtin_amdgcn_readfirstlane(tid >> 6), lane = tid & 63, wr = wid >> 2, wc = wid & 3, fr = lane & 15, fq = lane >> 4;
    const int nt = g.K / BK;
    unsigned voffA[2], voffB[2];
#pragma unroll
    for (int i = 0; i < 2; ++i) { int R, C; stage_rc(tid * 16 + i * 8192, R, C); const int Rb = (R & ~31) + perm32(R & 31);
        voffA[i] = (unsigned)(R * g.lda + C) * 2u; voffB[i] = (unsigned)(Rb * g.ldb + C) * 2u; }
    const size_t kstep = (size_t)(BK * 2);
    const size_t hsA = (size_t)HALF * g.lda * 2, hsB = (size_t)HALF * g.ldb * 2;
    const size_t tsA = 2 * hsA, tsB = 2 * hsB;
    const unsigned ldsw = (unsigned)wid * 1024u;
    const int aoff = lds_byte(wr * 64 + fr, fq * 8), boff = lds_byte(wc * 32 + fr, fq * 8);
#define PG8_SA(b, h) (((b) * 2 + (h)) * HTB)
#define PG8_SB(b, h) ((4 + (b) * 2 + (h)) * HTB)
#define PG8_STAGE(bufoff, gbase, voff) do { _Pragma("unroll") for (int _i = 0; _i < 2; ++_i) \
        __builtin_amdgcn_global_load_lds((const unsigned*)((const char*)(gbase) + (voff)[_i]), (LAS unsigned*)(lds + (bufoff) + ldsw + _i * 8192), 16, 0, 0); } while (0)
#define PG8_LDA(dst, b, h) do { _Pragma("unroll") for (int m = 0; m < 4; ++m) _Pragma("unroll") for (int k = 0; k < 2; ++k) dst[m][k] = *(const LAS bf16x8*)(lds + PG8_SA(b, h) + aoff + m * 2048 + k * 1024); } while (0)
#define PG8_LDB(dst, b, h) do { _Pragma("unroll") for (int n = 0; n < 2; ++n) _Pragma("unroll") for (int k = 0; k < 2; ++k) dst[n][k] = *(const LAS bf16x8*)(lds + PG8_SB(b, h) + boff + n * 2048 + k * 1024); } while (0)
#define PG8_MMA(ai, bj, At, Bt) do { __builtin_amdgcn_s_setprio(1); _Pragma("unroll") for (int m = 0; m < 4; ++m) _Pragma("unroll") for (int n = 0; n < 2; ++n) _Pragma("unroll") for (int k = 0; k < 2; ++k) \
        acc[ai][bj][m][n] = __builtin_amdgcn_mfma_f32_16x16x32_bf16(Bt[n][k], At[m][k], acc[ai][bj][m][n], 0, 0, 0); __builtin_amdgcn_s_setprio(0); } while (0)
#define PG8_WAIT_V(n) asm volatile("s_waitcnt vmcnt(" #n ")" ::: "memory")
#define PG8_WAIT_L(n) asm volatile("s_waitcnt lgkmcnt(" #n ")" ::: "memory")
#define PG8_BAR __builtin_amdgcn_s_barrier()
#define PG8_SCHED __builtin_amdgcn_sched_barrier(0)
    Unit cur, nxt; int ui = 0;
    if (!S.next(0, cur)) return;
    f32x4 acc[2][2][4][2];
#pragma unroll
    for (int a = 0; a < 2; ++a)
#pragma unroll
        for (int b = 0; b < 2; ++b)
#pragma unroll
            for (int m = 0; m < 4; ++m)
#pragma unroll
                for (int n = 0; n < 2; ++n) acc[a][b][m][n] = (f32x4){0.f, 0.f, 0.f, 0.f};
    bf16x8 At[4][2], B0[2][2], B1[2][2];
    const char* cA = (const char*)g.A + (size_t)cur.pm * tsA; const char* cB = (const char*)g.Bt + (size_t)cur.pn * tsB;
    PG8_STAGE(PG8_SB(0, 0), cB, voffB); PG8_STAGE(PG8_SB(0, 1), cB + hsB, voffB); PG8_STAGE(PG8_SA(0, 0), cA, voffA); PG8_STAGE(PG8_SA(0, 1), cA + hsA, voffA);
    if (wr == 1) PG8_BAR;
    PG8_WAIT_V(2); PG8_BAR;
    PG8_STAGE(PG8_SB(1, 0), cB + kstep, voffB); PG8_STAGE(PG8_SA(1, 0), cA + kstep, voffA); PG8_STAGE(PG8_SB(1, 1), cB + hsB + kstep, voffB);
    PG8_WAIT_V(6); PG8_BAR;
    for (;;) {
        const bool has_next = S.next(ui + 1, nxt);
        const char* nA = has_next ? (const char*)g.A + (size_t)nxt.pm * tsA : cA; const char* nB = has_next ? (const char*)g.Bt + (size_t)nxt.pn * tsB : cB;
        for (int t = 0; t < nt; t += 2) {
            const bool last = (t == nt - 2);
            const char* a1 = cA + (size_t)(t + 1) * kstep;
            const char* a2 = last ? nA : cA + (size_t)(t + 2) * kstep; const char* b2 = last ? nB : cB + (size_t)(t + 2) * kstep;
            const char* a3 = a2 + kstep; const char* b3 = b2 + kstep;
            PG8_LDB(B0, 0, 0); PG8_LDB(B1, 0, 1); PG8_SCHED; PG8_LDA(At, 0, 0); PG8_STAGE(PG8_SA(1, 1), a1 + hsA, voffA);
            PG8_WAIT_V(8); PG8_WAIT_L(0); PG8_BAR; PG8_MMA(0, 0, At, B0); PG8_MMA(0, 1, At, B1); PG8_BAR; PG8_SCHED;
            PG8_LDA(At, 0, 1); PG8_STAGE(PG8_SB(0, 0), b2, voffB); PG8_STAGE(PG8_SB(0, 1), b2 + hsB, voffB); PG8_STAGE(PG8_SA(0, 0), a2, voffA);
            PG8_WAIT_V(8); PG8_WAIT_L(0); PG8_BAR; PG8_MMA(1, 0, At, B0); PG8_MMA(1, 1, At, B1); PG8_BAR; PG8_SCHED;
            PG8_LDB(B0, 1, 0); PG8_LDB(B1, 1, 1); PG8_SCHED; PG8_LDA(At, 1, 0); PG8_STAGE(PG8_SA(0, 1), a2 + hsA, voffA);
            PG8_WAIT_V(8); PG8_WAIT_L(0); PG8_BAR; PG8_MMA(0, 0, At, B0); PG8_MMA(0, 1, At, B1); PG8_BAR; PG8_SCHED;
            PG8_LDA(At, 1, 1); PG8_STAGE(PG8_SB(1, 0), b3, voffB); PG8_STAGE(PG8_SB(1, 1), b3 + hsB, voffB); PG8_STAGE(PG8_SA(1, 0), a3, voffA);
            PG8_WAIT_V(8); PG8_WAIT_L(0); PG8_BAR; PG8_MMA(1, 0, At, B0); PG8_MMA(1, 1, At, B1); PG8_BAR; PG8_SCHED;
        }
        if (wr == 0) PG8_BAR;
        E(acc, cur, wr, wc, fr, fq);
        if (!has_next) break;
#pragma unroll
        for (int a = 0; a < 2; ++a)
#pragma unroll
            for (int b = 0; b < 2; ++b)
#pragma unroll
                for (int m = 0; m < 4; ++m)
#pragma unroll
                    for (int n = 0; n < 2; ++n) acc[a][b][m][n] = (f32x4){0.f, 0.f, 0.f, 0.f};
        cur = nxt; cA = nA; cB = nB; ++ui;
        if (wr == 1) PG8_BAR;
    }
    PG8_WAIT_V(0);
    PG8_BAR;
#undef PG8_SA
#undef PG8_SB
#undef PG8_STAGE
#undef PG8_LDA
#undef PG8_LDB
#undef PG8_MMA
#undef PG8_WAIT_V
#undef PG8_WAIT_L
#undef PG8_BAR
#undef PG8_SCHED
}
}
struct EpiProj {
    bf16_t* O; int ldc; int silu_lo, silu_hi, sig_lo;
    __device__ __forceinline__ void operator()(const f32x4 (&acc)[2][2][4][2], const pg8::Unit& u, int wr, int wc, int fr, int fq) const {
        const int pn = u.pn;
        const int act = (pn >= silu_lo && pn < silu_hi) ? 1 : (pn >= sig_lo ? 2 : 0);
        const int row0 = u.pm * 256 + wr * 64 + fr, col0 = pn * 256 + wc * 32 + 8 * fq;
#pragma unroll
        for (int ai = 0; ai < 2; ++ai)
#pragma unroll
            for (int m = 0; m < 4; ++m) {
                const int row = row0 + ai * 128 + m * 16; bf16_t* rowp = O + (size_t)row * ldc + col0;
#pragma unroll
                for (int bj = 0; bj < 2; ++bj) {
                    float v[8];
#pragma unroll
                    for (int j = 0; j < 4; ++j) { v[j] = acc[ai][bj][m][0][j]; v[4 + j] = acc[ai][bj][m][1][j]; }
                    if (act == 1) {
#pragma unroll
                        for (int j = 0; j < 8; ++j) v[j] = siluf_(v[j]);
                    } else if (act == 2) {
#pragma unroll
                        for (int j = 0; j < 8; ++j) v[j] = sigmoidf_(v[j]);
                    }
                    u32x4 w; w.x = pg8::cvt_pk_bf16(v[0], v[1]); w.y = pg8::cvt_pk_bf16(v[2], v[3]); w.z = pg8::cvt_pk_bf16(v[4], v[5]); w.w = pg8::cvt_pk_bf16(v[6], v[7]);
                    *(u32x4*)(rowp + bj * 128) = w;
                }
            }
    }
};
template <int KIND> struct EpiMix {
    const bf16_t* gate; int ldg; float* part; bf16_t* outbf;
    __device__ __forceinline__ void operator()(const f32x4 (&acc)[2][2][4][2], const pg8::Unit& u, int wr, int wc, int fr, int fq) const {
        const int row0 = u.pm * 256 + wr * 64 + fr, col0 = u.pn * 256 + wc * 32 + 8 * fq;
#pragma unroll
        for (int ai = 0; ai < 2; ++ai)
#pragma unroll
            for (int m = 0; m < 4; ++m) {
                const int row = row0 + ai * 128 + m * 16;
#pragma unroll
                for (int bj = 0; bj < 2; ++bj) {
                    const int col = col0 + bj * 128;
                    const u32x4 gw = *(const u32x4*)(gate + (size_t)row * ldg + col);
                    float gv[8]; gv[0] = __uint_as_float(gw.x << 16); gv[1] = __uint_as_float(gw.x & 0xffff0000u); gv[2] = __uint_as_float(gw.y << 16); gv[3] = __uint_as_float(gw.y & 0xffff0000u);
                    gv[4] = __uint_as_float(gw.z << 16); gv[5] = __uint_as_float(gw.z & 0xffff0000u); gv[6] = __uint_as_float(gw.w << 16); gv[7] = __uint_as_float(gw.w & 0xffff0000u);
                    float* pp = part + (size_t)row * 1024 + col;
                    f32x4 p0 = (f32x4){0.f, 0.f, 0.f, 0.f}, p1 = p0;
                    if (KIND != 0) { p0 = *(const f32x4*)pp; p1 = *(const f32x4*)(pp + 4); }
#pragma unroll
                    for (int j = 0; j < 4; ++j) { p0[j] += gv[j] * acc[ai][bj][m][0][j]; p1[j] += gv[4 + j] * acc[ai][bj][m][1][j]; }
                    if (KIND != 2) { *(f32x4*)pp = p0; *(f32x4*)(pp + 4) = p1; }
                    else { u32x4 w; w.x = pg8::cvt_pk_bf16(p0[0], p0[1]); w.y = pg8::cvt_pk_bf16(p0[2], p0[3]); w.z = pg8::cvt_pk_bf16(p1[0], p1[1]); w.w = pg8::cvt_pk_bf16(p1[2], p1[3]);
                        *(u32x4*)(outbf + (size_t)row * 1024 + col) = w; }
                }
            }
    }
};
struct EpiOut {
    const float* base; float* out;
    __device__ __forceinline__ void operator()(const f32x4 (&acc)[2][2][4][2], const pg8::Unit& u, int wr, int wc, int fr, int fq) const {
        const int row0 = u.pm * 256 + wr * 64 + fr, col0 = u.pn * 256 + wc * 32 + 8 * fq;
#pragma unroll
        for (int ai = 0; ai < 2; ++ai)
#pragma unroll
            for (int mp = 0; mp < 2; ++mp) {
                f32x4 bv[2][2][2];
#pragma unroll
                for (int mi = 0; mi < 2; ++mi)
#pragma unroll
                    for (int bj = 0; bj < 2; ++bj) { const size_t off = (size_t)(row0 + ai * 128 + (2 * mp + mi) * 16) * 1024 + col0 + bj * 128;
                        bv[mi][bj][0] = *(const f32x4*)(base + off); bv[mi][bj][1] = *(const f32x4*)(base + off + 4); }
#pragma unroll
                for (int mi = 0; mi < 2; ++mi)
#pragma unroll
                    for (int bj = 0; bj < 2; ++bj) { const int m = 2 * mp + mi; const size_t off = (size_t)(row0 + ai * 128 + m * 16) * 1024 + col0 + bj * 128;
                        *(f32x4*)(out + off) = bv[mi][bj][0] + acc[ai][bj][m][0]; *(f32x4*)(out + off + 4) = bv[mi][bj][1] + acc[ai][bj][m][1]; }
            }
    }
};

constexpr size_t MiB = 1u << 20;
constexpr size_t WS_CTL = 0, WS_ROPE = 1 * MiB, WS_RSTD = 5 * MiB, WS_LWT = 5 * MiB + 128 * 1024  , WS_WIN = 6 * MiB, WS_WCAT = 43 * MiB, WS_WOUT = 51 * MiB, WS_XG = 53 * MiB, WS_MIXBF = 85 * MiB,
                 WS_EAB = 117 * MiB, WS_EC = 245 * MiB, WS_L = 117 * MiB  , WS_OBUF = 297 * MiB,
                 WS_QTA = 361 * MiB, WS_KTA = 393 * MiB, WS_VTA = 425 * MiB, WS_DA = 441 * MiB, WS_QTB = 442 * MiB, WS_KTB = 474 * MiB, WS_VTB = 506 * MiB, WS_SLOC = 538 * MiB, WS_DSEG = 562 * MiB, WS_CSEG = 563 * MiB, WS_CMSEG = 571 * MiB, WS_END = 583 * MiB,
                 WS_RH = 117 * MiB, WS_MI = 149 * MiB, WS_NI = 181 * MiB  ,
                 WS_SV = 458 * MiB, WS_BONS = 490 * MiB  , WS_LX = 213 * MiB  , WS_CODE = 213 * MiB  , WS_PIA = 491 * MiB, WS_PIB = 575 * MiB  , WS_PART = 361 * MiB;
static_assert(WS_WIN + (size_t)NIN * DM * 2 <= WS_WCAT && WS_EAB + (size_t)SEQ * LDEAB * 2 <= WS_EC && WS_EC + (size_t)SEQ * LDEC * 2 <= WS_OBUF && WS_NI + 32 * MiB <= WS_EC && WS_END <= 584 * MiB, "d_ws map");
constexpr size_t WS_BAR = 4096, CTL_ZERO_BYTES = 65536;
constexpr int LDS_BYTES = 147456;
constexpr int NWAVES = 8;

struct Args {
    const float* in[22]; float* out; unsigned char* ws; int ph_lo, ph_hi;
};
typedef const __attribute__((address_space(4))) Args KArgs;
struct Ctx {
    LAS unsigned char* lds; int tid, lane, wave, G; KArgs* ap;
    __device__ __forceinline__ const float* in(int i) const { return ap->in[i]; }
    __device__ __forceinline__ float* out() const { return ap->out; }
    __device__ __forceinline__ unsigned char* ws() const { return ap->ws; }
    __device__ __forceinline__ f32x2* rope() const { return (f32x2*)(ap->ws + WS_ROPE); }
    __device__ __forceinline__ bf16_t* lwt() const { return (bf16_t*)(ap->ws + WS_LWT); }
    __device__ __forceinline__ float* rstd() const { return (float*)(ap->ws + WS_RSTD); }
    __device__ __forceinline__ float* part() const { return (float*)(ap->ws + WS_PART); }
    __device__ __forceinline__ bf16_t* WinT() const { return (bf16_t*)(ap->ws + WS_WIN); }
    __device__ __forceinline__ bf16_t* WcatT() const { return (bf16_t*)(ap->ws + WS_WCAT); }
    __device__ __forceinline__ bf16_t* WoutT() const { return (bf16_t*)(ap->ws + WS_WOUT); }
    __device__ __forceinline__ bf16_t* xg() const { return (bf16_t*)(ap->ws + WS_XG); }
    __device__ __forceinline__ bf16_t* mixbf() const { return (bf16_t*)(ap->ws + WS_MIXBF); }
    __device__ __forceinline__ bf16_t* eab() const { return (bf16_t*)(ap->ws + WS_EAB); }
    __device__ __forceinline__ bf16_t* ecb() const { return (bf16_t*)(ap->ws + WS_EC); }
    __device__ __forceinline__ bf16_t* lbuf() const { return (bf16_t*)(ap->ws + WS_L); }
    __device__ __forceinline__ bf16_t* lxbuf() const { return (bf16_t*)(ap->ws + WS_LX); }
    __device__ __forceinline__ bf16_t* qta() const { return (bf16_t*)(ap->ws + WS_QTA); }
    __device__ __forceinline__ bf16_t* kta() const { return (bf16_t*)(ap->ws + WS_KTA); }
    __device__ __forceinline__ bf16_t* vta() const { return (bf16_t*)(ap->ws + WS_VTA); }
    __device__ __forceinline__ float* da() const { return (float*)(ap->ws + WS_DA); }
    __device__ __forceinline__ bf16_t* qtb() const { return (bf16_t*)(ap->ws + WS_QTB); }
    __device__ __forceinline__ bf16_t* ktb() const { return (bf16_t*)(ap->ws + WS_KTB); }
    __device__ __forceinline__ bf16_t* vtb() const { return (bf16_t*)(ap->ws + WS_VTB); }
    __device__ __forceinline__ bf16_t* obuf() const { return (bf16_t*)(ap->ws + WS_OBUF); }
    __device__ __forceinline__ float* sloc() const { return (float*)(ap->ws + WS_SLOC); }
    __device__ __forceinline__ float* dseg() const { return (float*)(ap->ws + WS_DSEG); }
    __device__ __forceinline__ float* cseg() const { return (float*)(ap->ws + WS_CSEG); }
    __device__ __forceinline__ bf16_t* cmseg() const { return (bf16_t*)(ap->ws + WS_CMSEG); }
    __device__ __forceinline__ bf16_t* codeb() const { return (bf16_t*)(ap->ws + WS_CODE); }
    __device__ __forceinline__ bf16_t* pia() const { return (bf16_t*)(ap->ws + WS_PIA); }
    __device__ __forceinline__ bf16_t* pib() const { return (bf16_t*)(ap->ws + WS_PIB); }
    __device__ __forceinline__ bf16_t* rhi() const { return (bf16_t*)(ap->ws + WS_RH); }
    __device__ __forceinline__ bf16_t* mi() const { return (bf16_t*)(ap->ws + WS_MI); }
    __device__ __forceinline__ bf16_t* ni() const { return (bf16_t*)(ap->ws + WS_NI); }
    __device__ __forceinline__ bf16_t* svb() const { return (bf16_t*)(ap->ws + WS_SV); }
    __device__ __forceinline__ float* bons() const { return (float*)(ap->ws + WS_BONS); }
};
#define LDS_WAIT() asm volatile("s_waitcnt lgkmcnt(0)" ::: "memory")

__device__ __forceinline__ int win_row(int n) { return n < 4096 ? n : n < 5120 ? 11520 + (n - 4096) : n < 9216 ? 4096 + (n - 5120) : n < 11264 ? 11520 + 1024 + (n - 9216) : n < 14592 ? 8192 + (n - 11264) : n < 15616 ? 11520 + 3072 + (n - 14592) : 11520 + 4096 + (n - 15616); }
__device__ __forceinline__ void transpose_item(const float* W, int N, bf16_t* WT, int ldt, int koff, LAS float* scr, int item, int lane, bool permin = false) {
    const int nblk = N / 64, kb = item / nblk, nb = item % nblk, k0 = 64 * kb, n0 = 64 * nb; const int r0 = permin ? win_row(n0) : n0;
#pragma unroll
    for (int ih = 0; ih < 2; ++ih) {
        float wv[32];
#pragma unroll
        for (int i = 0; i < 32; ++i) wv[i] = W[(size_t)(k0 + 32 * ih + i) * N + n0 + lane];
#pragma unroll
        for (int i = 0; i < 32; ++i) scr[(32 * ih + i) * 65 + lane] = wv[i];
    }
    LDS_WAIT(); asm volatile("" ::: "memory");
    const int c = lane & 7;
#pragma unroll
    for (int j = 0; j < 8; ++j) { const int n = (lane >> 3) + 8 * j; const LAS float* s = scr + (8 * c) * 65 + n;
        u32x4 o; o.x = pk2(s[0 * 65], s[1 * 65]); o.y = pk2(s[2 * 65], s[3 * 65]); o.z = pk2(s[4 * 65], s[5 * 65]); o.w = pk2(s[6 * 65], s[7 * 65]);
        *(u32x4*)(WT + (size_t)(r0 + n) * ldt + koff + k0 + 8 * c) = o; }
    LDS_WAIT(); asm volatile("" ::: "memory");
}

__device__ __forceinline__ void prep_phase(const Ctx& F, int l) {
    const int gw = blockIdx.x * NWAVES + F.wave, NGW = F.G * NWAVES;
    if (l < 2) {
        LAS float* scr = (LAS float*)(F.lds + F.wave * 16640);
        const float* Win = F.in(2) + (size_t)l * DM * NIN;
        const float* Wa = F.in(17) + (size_t)l * 1024 * 1024; const float* Wb = F.in(18) + (size_t)l * 2048 * 1024; const float* Wc = F.in(19) + (size_t)l * 1024 * 1024; const float* Wo = F.in(20) + (size_t)l * 1024 * 1024;
        constexpr int I_IN = 16 * (NIN / 64), I_A = 16 * 16, I_B = 32 * 16, I_C = 16 * 16, I_O = 16 * 16, I_L = 4 * 16;
        for (int it = gw; it < I_IN + I_A + I_B + I_C + I_O + I_L; it += NGW) {
            int r = it;
            if (r < I_L) { const int gi = r >> 4, kind = gi >> 1, d = gi & 1;
                transpose_item((kind == 0 ? F.in(9) : F.in(11)) + (size_t)(l * 2 + d) * 65536, 1024, F.lwt() + (size_t)gi * 65536, 64, 0, scr, r & 15, F.lane); continue; } r -= I_L;
            if (r < I_IN) { transpose_item(Win, NIN, F.WinT(), 1024, 0, scr, r, F.lane, true); continue; } r -= I_IN;
            if (r < I_A) { transpose_item(Wa, 1024, F.WcatT(), 4096, 0, scr, r, F.lane); continue; } r -= I_A;
            if (r < I_B) { transpose_item(Wb, 1024, F.WcatT(), 4096, 1024, scr, r, F.lane); continue; } r -= I_B;
            if (r < I_C) { transpose_item(Wc, 1024, F.WcatT(), 4096, 3072, scr, r, F.lane); continue; } r -= I_C;
            transpose_item(Wo, 1024, F.WoutT(), 1024, 0, scr, r, F.lane);
        }
    }
    const float* xsrc = (l == 0) ? F.in(0) : F.out();
    const float* gsrc = (l < 2) ? F.in(1) + l * DM : F.in(21);
    f32x4 g4[4];
#pragma unroll
    for (int j = 0; j < 4; ++j) g4[j] = *((const f32x4*)gsrc + F.lane + 64 * j);
    f32x4 v[4];
#pragma unroll
    for (int j = 0; j < 4; ++j) v[j] = *((const f32x4*)(xsrc + (size_t)gw * DM) + F.lane + 64 * j);
    for (int m = gw; m < MTOK; m += NGW) {
        const int mn = m + NGW < MTOK ? m + NGW : m;
        f32x4 nv[4];
#pragma unroll
        for (int j = 0; j < 4; ++j) nv[j] = *((const f32x4*)(xsrc + (size_t)mn * DM) + F.lane + 64 * j);
        float s = 0.f;
#pragma unroll
        for (int j = 0; j < 4; ++j) s += (v[j].x * v[j].x + v[j].y * v[j].y) + (v[j].z * v[j].z + v[j].w * v[j].w);
        float eps_ = 1e-6f; asm volatile("" : "+s"(eps_));
        const float rs = rsqrtf(wave_sum(s) * (1.f / DM) + eps_);
        if (l < 2) {
            unsigned long long* o8 = (unsigned long long*)(F.xg() + (size_t)m * DM) + F.lane;
#pragma unroll
            for (int j = 0; j < 4; ++j) { const f32x4 gg = g4[j] * rs;
                o8[64 * j] = (unsigned long long)pk2(v[j].x * gg.x, v[j].y * gg.y) | ((unsigned long long)pk2(v[j].z * gg.z, v[j].w * gg.w) << 32); }
        } else {
            f32x4* orow = (f32x4*)(F.out() + (size_t)m * DM) + F.lane;
#pragma unroll
            for (int j = 0; j < 4; ++j) orow[64 * j] = v[j] * rs * g4[j];
        }
#pragma unroll
        for (int j = 0; j < 4; ++j) v[j] = nv[j];
    }
}

__device__ __forceinline__ void rope_table(const Ctx& F) {
    for (int idx = blockIdx.x * 512 + F.tid; idx < SEQ * 64; idx += F.G * 512) {
        const int t = idx >> 6, j = idx & 63;
        const float inv = (float)exp2(-(double)(2 * j) * (13.287712379549449 / 128.0));
        const float ang = (float)t * inv;
        const double rev = (double)ang * 0.15915494309189535; const double fr = rev - rint(rev);
        const float x = (float)(fr * 6.283185307179586);
        F.rope()[idx] = (f32x2){cosf(x), sinf(x)};
    }
}
constexpr size_t WS_MIXCNT = 32768;
struct EpiAny {
    int kind, l, b, s, gcol;
    __device__ __forceinline__ bool stores16() const { return kind <= 1; }
    __device__ __forceinline__ void operator()(const f32x4 (&acc)[2][2][4][2], const pg8::Unit& u, int wr, int wc, int fr, int fq) const {
        Ctx F; { KArgs* ap = (KArgs*)__builtin_amdgcn_kernarg_segment_ptr(); asm volatile("" : "+s"(ap)); F.ap = ap; }
        if (kind == 0) {
            if (u.pn < 32) { EpiProj e{F.eab(), LDEAB, 0, 4, 1 << 30}; e(acc, u, wr, wc, fr, fq); }
            else { EpiProj e{F.ecb() - 32 * 256, LDEC, 0, 0, 1 << 30}; e(acc, u, wr, wc, fr, fq); }
        }
        else if (kind == 1) { EpiProj e{F.lbuf(), LDL, 0, 0, 16};     e(acc, u, wr, wc, fr, fq); }
        else if (kind == 7) { EpiProj e{F.ecb() + (gcol - 32) * 256, LDEC, 0, 0, 1 << 30}; e(acc, u, wr, wc, fr, fq); }
        else if (kind == 6) { EpiProj e{F.lxbuf(), LDLX, 0, 0, 0}; e(acc, u, wr, wc, fr, fq); }
        else if (kind == 5) { EpiOut e{l == 0 ? F.in(0) : F.out(), F.out()}; e(acc, u, wr, wc, fr, fq); }
        else {
            const bool gx = gcol >= LDL;
            const bf16_t* gate = gx ? F.lxbuf() : F.lbuf() + gcol; const int ldg = gx ? LDLX : LDL; bf16_t* mine = (bf16_t*)F.part() + (size_t)s * SEQ * DM;
            const int row0 = u.pm * 256 + wr * 64 + fr, col0 = u.pn * 256 + wc * 32 + 8 * fq;
#pragma unroll
            for (int ai = 0; ai < 2; ++ai)
#pragma unroll
                for (int mp = 0; mp < 2; ++mp) {
                    u32x4 gwv[2][2], pwv[2][2];
#pragma unroll
                    for (int mi = 0; mi < 2; ++mi)
#pragma unroll
                        for (int bj = 0; bj < 2; ++bj) { const int row = row0 + ai * 128 + (2 * mp + mi) * 16, col = col0 + bj * 128;
                            gwv[mi][bj] = *(const u32x4*)(gate + (size_t)row * ldg + col);
                            if (kind == 3) pwv[mi][bj] = *(const u32x4*)(mine + (size_t)row * 1024 + col); else pwv[mi][bj] = (u32x4){0u, 0u, 0u, 0u}; }
#pragma unroll
                    for (int mi = 0; mi < 2; ++mi)
#pragma unroll
                        for (int bj = 0; bj < 2; ++bj) { const int m = 2 * mp + mi; const int row = row0 + ai * 128 + m * 16, col = col0 + bj * 128;
                            const u32x4 gw = gwv[mi][bj], pw = pwv[mi][bj];
                            const f32x4 g0 = (f32x4){__uint_as_float(gw.x << 16), __uint_as_float(gw.x & 0xffff0000u), __uint_as_float(gw.y << 16), __uint_as_float(gw.y & 0xffff0000u)};
                            const f32x4 g1 = (f32x4){__uint_as_float(gw.z << 16), __uint_as_float(gw.z & 0xffff0000u), __uint_as_float(gw.w << 16), __uint_as_float(gw.w & 0xffff0000u)};
                            f32x4 p0 = g0 * acc[ai][bj][m][0], p1 = g1 * acc[ai][bj][m][1];
                            p0 += (f32x4){__uint_as_float(pw.x << 16), __uint_as_float(pw.x & 0xffff0000u), __uint_as_float(pw.y << 16), __uint_as_float(pw.y & 0xffff0000u)};
                            p1 += (f32x4){__uint_as_float(pw.z << 16), __uint_as_float(pw.z & 0xffff0000u), __uint_as_float(pw.w << 16), __uint_as_float(pw.w & 0xffff0000u)};
                            u32x4 w; w.x = pg8::cvt_pk_bf16(p0[0], p0[1]); w.y = pg8::cvt_pk_bf16(p0[2], p0[3]); w.z = pg8::cvt_pk_bf16(p1[0], p1[1]); w.w = pg8::cvt_pk_bf16(p1[2], p1[3]);
                            *(u32x4*)(mine + (size_t)row * 1024 + col) = w; }
                }
            if (kind == 3) {
                extern __shared__ __attribute__((aligned(16))) unsigned char lds_dyn[];
                volatile LAS unsigned* flag = (volatile LAS unsigned*)((LAS unsigned char*)lds_dyn + LDS_BYTES - 32);
                asm volatile("s_waitcnt vmcnt(0)" ::: "memory");
                __syncthreads();
                if (threadIdx.x == 0) {
                    unsigned* cnt = (unsigned*)(F.ws() + WS_MIXCNT) + 64 * (u.pm * 4 + u.pn);
                    __builtin_amdgcn_fence(__ATOMIC_RELEASE, "agent");
                    asm volatile("s_waitcnt vmcnt(0)" ::: "memory");
                    const unsigned old = __hip_atomic_fetch_add(cnt, 1u, __ATOMIC_RELAXED, __HIP_MEMORY_SCOPE_AGENT);
                    if (old & 1u) { __builtin_amdgcn_fence(__ATOMIC_ACQUIRE, "agent"); asm volatile("s_waitcnt vmcnt(0)" ::: "memory"); }
                    flag[0] = old & 1u;
                }
                __syncthreads();
                if (flag[0]) {
                    const bf16_t* other = (const bf16_t*)F.part() + (size_t)(1 - s) * SEQ * DM; bf16_t* outbf = F.mixbf() + (size_t)b * SEQ * DM;
#pragma unroll
                    for (int ai = 0; ai < 2; ++ai)
#pragma unroll
                        for (int mp = 0; mp < 2; ++mp) {
                            u32x4 pwv[2][2], qwv[2][2];
#pragma unroll
                            for (int mi = 0; mi < 2; ++mi)
#pragma unroll
                                for (int bj = 0; bj < 2; ++bj) { const size_t off = (size_t)(row0 + ai * 128 + (2 * mp + mi) * 16) * 1024 + col0 + bj * 128; pwv[mi][bj] = *(const u32x4*)(other + off); qwv[mi][bj] = *(const u32x4*)(mine + off); }
#pragma unroll
                            for (int mi = 0; mi < 2; ++mi)
#pragma unroll
                                for (int bj = 0; bj < 2; ++bj) { const size_t off = (size_t)(row0 + ai * 128 + (2 * mp + mi) * 16) * 1024 + col0 + bj * 128; const u32x4 pw = pwv[mi][bj], qw = qwv[mi][bj];
                                    const f32x4 a0 = (f32x4){__uint_as_float(qw.x << 16), __uint_as_float(qw.x & 0xffff0000u), __uint_as_float(qw.y << 16), __uint_as_float(qw.y & 0xffff0000u)} + (f32x4){__uint_as_float(pw.x << 16), __uint_as_float(pw.x & 0xffff0000u), __uint_as_float(pw.y << 16), __uint_as_float(pw.y & 0xffff0000u)};
                                    const f32x4 a1 = (f32x4){__uint_as_float(qw.z << 16), __uint_as_float(qw.z & 0xffff0000u), __uint_as_float(qw.w << 16), __uint_as_float(qw.w & 0xffff0000u)} + (f32x4){__uint_as_float(pw.z << 16), __uint_as_float(pw.z & 0xffff0000u), __uint_as_float(pw.w << 16), __uint_as_float(pw.w & 0xffff0000u)};
                                    u32x4 w; w.x = pg8::cvt_pk_bf16(a0[0], a0[1]); w.y = pg8::cvt_pk_bf16(a0[2], a0[3]); w.z = pg8::cvt_pk_bf16(a1[0], a1[1]); w.w = pg8::cvt_pk_bf16(a1[2], a1[3]);
                                    *(u32x4*)(outbf + off) = w; }
                        }
                }
                __syncthreads();
            }
        }
    }
};
#define XB_TMO      128
#define XB_XCNT(j)  (256  + 64 * (j))
#define XB_XSUB(j)  (1280 + 64 * (j))
#define XB_XGEN(j)  (2304 + 64 * (j))
#define XB_TOP      3328
#define XB_TOPGEN   3392
#define XCD_BAR_WORDS 3456
#define XB_SPIN_CAP (1u << 18)

__device__ __forceinline__ unsigned xb_ld(unsigned* p)              { return __hip_atomic_load(p, __ATOMIC_RELAXED, __HIP_MEMORY_SCOPE_AGENT); }
__device__ __forceinline__ unsigned xb_add(unsigned* p, unsigned v) { return __hip_atomic_fetch_add(p, v, __ATOMIC_RELAXED, __HIP_MEMORY_SCOPE_AGENT); }
__device__ __forceinline__ unsigned xb_xcc_id() { return (unsigned)__builtin_amdgcn_s_getreg((3 << 11) | 20) & 0xFu; }
#define XB_SPIN(cond, bar) do { unsigned _sp = 0; while (cond) { __builtin_amdgcn_s_sleep(1); \
    if ((++_sp & 255u) == 0u) { if (xb_ld(&(bar)[XB_TMO])) break; if (_sp > XB_SPIN_CAP) { atomicAdd(&(bar)[XB_TMO], 1u); break; } } } } while (0)

struct XcdBarrier {
    unsigned* bar; unsigned x;
    volatile LAS unsigned* st;
};

__device__ __forceinline__ XcdBarrier xcd_barrier_post(unsigned* bar, volatile LAS unsigned* st) {
    XcdBarrier b; b.bar = bar; b.x = xb_xcc_id(); b.st = st;
    if (threadIdx.x == 0) (void)xb_add(&bar[XB_XCNT(b.x)], 1u);
    return b;
}
__device__ __forceinline__ void xcd_barrier_complete(unsigned* bar, unsigned x, unsigned& nloc, unsigned& nx) {
    const unsigned G = gridDim.x * gridDim.y * gridDim.z;
    unsigned sum, cnt, mine, sp = 0u;
    for (;;) {
        sum = 0u; cnt = 0u; mine = 0u;
#pragma unroll
        for (unsigned j = 0; j < 16; ++j) { const unsigned c = xb_ld(&bar[XB_XCNT(j)]); sum += c; cnt += (c > 0u) ? 1u : 0u; mine = (j == x) ? c : mine; }
        if (sum == G) break;
        __builtin_amdgcn_s_sleep(1);
        if ((++sp & 255u) == 0u) { if (xb_ld(&bar[XB_TMO])) break; if (sp > XB_SPIN_CAP) { atomicAdd(&bar[XB_TMO], 1u); break; } }
    }
    nloc = mine > 0u ? mine : 1u; nx = cnt > 0u ? cnt : 1u;
}

__device__ __forceinline__ void xcd_barrier(const XcdBarrier& b) {
    asm volatile("s_waitcnt vmcnt(0)" ::: "memory");
    __syncthreads();
    if (threadIdx.x == 0) {
        unsigned* bar = b.bar;
        __builtin_amdgcn_s_waitcnt(0);
        unsigned nloc = b.st[0], nx = b.st[1];
        if (nloc == 0u) { xcd_barrier_complete(bar, b.x, nloc, nx); b.st[0] = nloc; b.st[1] = nx; }
        const unsigned old = xb_add(&bar[XB_XSUB(b.x)], 1u);
        const unsigned gen = old / nloc;
        if (old + 1u == (gen + 1u) * nloc) {
            __builtin_amdgcn_fence(__ATOMIC_RELEASE, "agent");
            asm volatile("s_waitcnt vmcnt(0)" ::: "memory");
            const unsigned og = xb_add(&bar[XB_TOP], 1u);
            const unsigned tg = og / nx;
            if (og + 1u == (tg + 1u) * nx) xb_add(&bar[XB_TOPGEN], 1u);
            else XB_SPIN(xb_ld(&bar[XB_TOPGEN]) == tg, bar);
            __builtin_amdgcn_fence(__ATOMIC_ACQUIRE, "agent");
            xb_add(&bar[XB_XGEN(b.x)], 1u);
            asm volatile("s_waitcnt vmcnt(0)" ::: "memory");
        } else {
            XB_SPIN(xb_ld(&bar[XB_XGEN(b.x)]) == gen, bar);
            __builtin_amdgcn_fence(__ATOMIC_ACQUIRE, "agent");
            asm volatile("s_waitcnt vmcnt(0)" ::: "memory");
        }
    }
    __syncthreads();
}


constexpr int LQ = 136, LT = 72;
constexpr int NCH = SEQ / 64;
constexpr float LOG2E = 1.4426950408889634f;

__device__ __forceinline__ void hgrn_gate(float x, float lb, float& lf2, float& kv) {
    x = fminf(fmaxf(x, -30.f), 30.f);
    const float e = __builtin_amdgcn_exp2f(-LOG2E * x), r = __builtin_amdgcn_rcpf(1.f + e);
    const float f = fmaxf(lb + (1.f - lb) * r, 1e-6f);
    kv = (1.f - lb) * (e * r); lf2 = __builtin_amdgcn_logf(f);
}
__device__ __forceinline__ float ex2c(float x) { return __builtin_amdgcn_exp2f(fminf(x, 115.f)); }
__device__ __forceinline__ void hgrn_local_item(const Ctx& F, int l, int c, int h) {
    LAS bf16_t* QHF = (LAS bf16_t*)F.lds; LAS bf16_t* KHF = QHF + 64 * LQ; LAS bf16_t* QHB = KHF + 64 * LQ; LAS bf16_t* KHB = QHB + 64 * LQ;
    LAS bf16_t* VTL = KHB + 64 * LQ; LAS bf16_t* PL = VTL + 128 * LT; LAS float* TOT = (LAS float*)(PL + 64 * LT);
    const int lane = F.lane, g = F.wave, ch0 = 2 * lane, t0 = c * 64;
    const bf16_t* rp = F.eab() + (size_t)(t0 + 8 * g) * LDEAB + h * 128 + ch0;
    unsigned qw[8], iw[8]; float lff[8][2], lfb[8][2], kf[8][2], kb[8][2];
    float lbf[2] = {0.f, 0.f}, lbb[2] = {0.f, 0.f};
    {
        unsigned fw[8], bw[8];
#pragma unroll
        for (int jj = 0; jj < 8; ++jj) { const bf16_t* r = rp + (size_t)jj * LDEAB; qw[jj] = *(const unsigned*)(r); fw[jj] = *(const unsigned*)(r + 1024); bw[jj] = *(const unsigned*)(r + 2048); iw[jj] = *(const unsigned*)(r + 3072); }
        { const float* lg = F.in(3); const int c0 = h * 128 + ch0;
          const f32x2 g0 = *(const f32x2*)(lg + c0), g1 = *(const f32x2*)(lg + 1024 + c0), g2 = *(const f32x2*)(lg + 2048 + c0), g3 = *(const f32x2*)(lg + 3072 + c0);
          if (l == 1) { lbf[0] = sigmoidf_(g2.x - g0.x); lbf[1] = sigmoidf_(g2.y - g0.y); lbb[0] = sigmoidf_(g3.x - g1.x); lbb[1] = sigmoidf_(g3.y - g1.y); } }
#pragma unroll
        for (int jj = 0; jj < 8; ++jj) {
            hgrn_gate(__uint_as_float(fw[jj] << 16), lbf[0], lff[jj][0], kf[jj][0]); hgrn_gate(__uint_as_float(fw[jj] & 0xffff0000u), lbf[1], lff[jj][1], kf[jj][1]);
            hgrn_gate(__uint_as_float(bw[jj] << 16), lbb[0], lfb[jj][0], kb[jj][0]); hgrn_gate(__uint_as_float(bw[jj] & 0xffff0000u), lbb[1], lfb[jj][1], kb[jj][1]);
        }
    }
    {
        float sf0 = 0.f, sf1 = 0.f, sb0 = 0.f, sb1 = 0.f;
#pragma unroll
        for (int jj = 0; jj < 8; ++jj) { sf0 += lff[jj][0]; sf1 += lff[jj][1]; sb0 += lfb[jj][0]; sb1 += lfb[jj][1]; }
        *(LAS f32x2*)(TOT + g * 128 + ch0) = (f32x2){sf0, sf1}; *(LAS f32x2*)(TOT + 1024 + g * 128 + ch0) = (f32x2){sb0, sb1};
    }
    LDS_BARRIER();
    float offf[2] = {0.f, 0.f}, b31[2] = {0.f, 0.f}, b63[2] = {0.f, 0.f}, offb[2] = {0.f, 0.f}, pb32[2] = {0.f, 0.f}, totb[2] = {0.f, 0.f};
#pragma unroll
    for (int gg = 0; gg < 8; ++gg) {
        const f32x2 tf = *(const LAS f32x2*)(TOT + gg * 128 + ch0), tb = *(const LAS f32x2*)(TOT + 1024 + gg * 128 + ch0);
#pragma unroll
        for (int e = 0; e < 2; ++e) { const float a = e ? tf.y : tf.x, b = e ? tb.y : tb.x;
            offf[e] += gg < g ? a : 0.f; offb[e] += gg < g ? b : 0.f; if (gg < 4) { b31[e] += a; pb32[e] += b; } b63[e] += a; totb[e] += b; }
    }
    const size_t imgF = ((size_t)(0 * NCH + c) * 8 + h) * 8192, imgB = ((size_t)(1 * NCH + c) * 8 + h) * 8192;
    bf16_t* QTg = F.qta(); bf16_t* KTg = F.kta();
    float runf[2] = {offf[0], offf[1]}, runb[2] = {offb[0], offb[1]};
    unsigned ktf[2][4], ktb[2][4], vtw[2][4];
#pragma unroll
    for (int jj = 0; jj < 8; ++jj) {
        const int t = 8 * g + jj;
        const float q[2] = {__uint_as_float(qw[jj] << 16), __uint_as_float(qw[jj] & 0xffff0000u)};
        float qhf[2], khf[2], qtf[2], ktfv[2], qhb[2], khb[2], qtb[2], ktbv[2];
#pragma unroll
        for (int e = 0; e < 2; ++e) {
            runf[e] += lff[jj][e];
            const float bf = runf[e], xf = bf - b31[e];
            qhf[e] = q[e] * ex2c(xf); khf[e] = kf[jj][e] * ex2c(-xf); qtf[e] = q[e] * __builtin_amdgcn_exp2f(bf); ktfv[e] = kf[jj][e] * __builtin_amdgcn_exp2f(b63[e] - bf);
            const float sb = totb[e] - runb[e];
            runb[e] += lfb[jj][e];
            const float xb = sb - (totb[e] - pb32[e]);
            qhb[e] = q[e] * ex2c(xb); khb[e] = kb[jj][e] * ex2c(-xb); qtb[e] = q[e] * __builtin_amdgcn_exp2f(sb); ktbv[e] = kb[jj][e] * __builtin_amdgcn_exp2f(totb[e] - sb);
        }
        *(LAS unsigned*)(QHF + t * LQ + ch0) = pk2(qhf[0], qhf[1]); *(LAS unsigned*)(KHF + t * LQ + ch0) = pk2(khf[0], khf[1]);
        *(LAS unsigned*)(QHB + t * LQ + ch0) = pk2(qhb[0], qhb[1]); *(LAS unsigned*)(KHB + t * LQ + ch0) = pk2(khb[0], khb[1]);
        *(unsigned*)(QTg + imgF + t * 128 + ch0) = pk2(qtf[0], qtf[1]); *(unsigned*)(QTg + imgB + t * 128 + ch0) = pk2(qtb[0], qtb[1]);
#pragma unroll
        for (int e = 0; e < 2; ++e) {
            const unsigned kfb = f2bf(ktfv[e]), kbb = f2bf(ktbv[e]), vb = e ? (iw[jj] >> 16) : (iw[jj] & 0xffffu);
            if (jj & 1) { ktf[e][jj >> 1] |= kfb << 16; ktb[e][jj >> 1] |= kbb << 16; vtw[e][jj >> 1] |= vb << 16; }
            else { ktf[e][jj >> 1] = kfb; ktb[e][jj >> 1] = kbb; vtw[e][jj >> 1] = vb; }
        }
    }
#pragma unroll
    for (int e = 0; e < 2; ++e) {
        const int ch = ch0 + e;
        *(u32x4*)(KTg + imgF + ch * 64 + 8 * g) = (u32x4){ktf[e][0], ktf[e][1], ktf[e][2], ktf[e][3]};
        *(u32x4*)(KTg + imgB + ch * 64 + 8 * g) = (u32x4){ktb[e][0], ktb[e][1], ktb[e][2], ktb[e][3]};
        const u32x4 vv = (u32x4){vtw[e][0], vtw[e][1], vtw[e][2], vtw[e][3]};
        *(u32x4*)(F.vta() + ((size_t)(c * 8 + h) * 128 + ch) * 64 + 8 * g) = vv;
    }
    if (g == 0) {
        *(f32x2*)(F.da() + ((size_t)(0 * NCH + c) * 8 + h) * 128 + ch0) = (f32x2){__builtin_amdgcn_exp2f(b63[0]), __builtin_amdgcn_exp2f(b63[1])};
        *(f32x2*)(F.da() + ((size_t)(1 * NCH + c) * 8 + h) * 128 + ch0) = (f32x2){__builtin_amdgcn_exp2f(totb[0]), __builtin_amdgcn_exp2f(totb[1])};
    }
    LDS_BARRIER();
    {
        const int fr = lane & 15, fq = lane >> 4, jt = g >> 1, n0 = 2 * (g & 1), t = 16 * jt + fr;
        f32x4 af[2] = {(f32x4){0.f, 0.f, 0.f, 0.f}, (f32x4){0.f, 0.f, 0.f, 0.f}}, ab[2] = {af[0], af[0]};
#pragma unroll
        for (int kk = 0; kk < 4; ++kk) {
            const bf16x8 a_f = *(const LAS bf16x8*)(QHF + t * LQ + 32 * kk + 8 * fq), a_b = *(const LAS bf16x8*)(QHB + t * LQ + 32 * kk + 8 * fq);
#pragma unroll
            for (int n = 0; n < 2; ++n) {
                const bf16x8 b_f = *(const LAS bf16x8*)(KHF + (16 * (n0 + n) + fr) * LQ + 32 * kk + 8 * fq), b_b = *(const LAS bf16x8*)(KHB + (16 * (n0 + n) + fr) * LQ + 32 * kk + 8 * fq);
                af[n] = mfma16(b_f, a_f, af[n]); ab[n] = mfma16(b_b, a_b, ab[n]);
            }
        }
#pragma unroll
        for (int n = 0; n < 2; ++n) { const int t2b = 16 * (n0 + n) + 4 * fq; float p[4];
#pragma unroll
            for (int r = 0; r < 4; ++r) p[r] = (t2b + r <= t ? af[n][r] : 0.f) + (t2b + r >= t ? ab[n][r] : 0.f);
            u32x2 ow; ow.x = pk2(p[0], p[1]); ow.y = pk2(p[2], p[3]);
            *(LAS u32x2*)(PL + t * LT + t2b) = ow; }
    }
    LDS_BARRIER();
    *(u32x4*)(F.pia() + ((size_t)(c * 8 + h) * 64 + (F.tid >> 3)) * 64 + (F.tid & 7) * 8) = *(const LAS u32x4*)(PL + (F.tid >> 3) * LT + (F.tid & 7) * 8);
    LDS_BARRIER();
}

__device__ __forceinline__ void ret_local_item(const Ctx& F, int c, int h) {
    LAS bf16_t* QH = (LAS bf16_t*)F.lds; LAS bf16_t* KH = QH + 64 * LQ; LAS bf16_t* VTL = KH + 64 * LQ; LAS bf16_t* PL = VTL + 256 * LT;
    const int lane = F.lane, w = F.wave, t0 = c * 64;
    const float lg2 = __builtin_amdgcn_logf(1.f - __builtin_amdgcn_exp2f((float)(-5 - h)));
    const float scale = 0.08838834764831845f;
    const size_t imgF = ((size_t)(0 * NCH + c) * 8 + h) * 8192, imgB = ((size_t)(1 * NCH + c) * 8 + h) * 8192;
    u32x2 vw_[8];
    {
        const int cq = lane & 31, tg = w * 2 + (lane >> 5), c1 = 2 * cq;
        unsigned kf[4][2];
        unsigned qa_[4], qb_[4], ka_[4], kb_[4]; f32x4 cs_[4];
#pragma unroll
        for (int jj = 0; jj < 4; ++jj) { const int t = 4 * tg + jj; const bf16_t* row = F.eab() + (size_t)(t0 + t) * LDEAB + h * 128 + c1;
            qa_[jj] = *(const unsigned*)(row + E_BQ); qb_[jj] = *(const unsigned*)(row + E_BQ + 64); ka_[jj] = *(const unsigned*)(row + E_BK); kb_[jj] = *(const unsigned*)(row + E_BK + 64);
            cs_[jj] = *(const f32x4*)(F.rope() + (size_t)(t0 + t) * 64 + c1); }
#pragma unroll
        for (int jj = 0; jj < 8; ++jj) vw_[jj] = *(const u32x2*)(F.eab() + (size_t)(t0 + 8 * w + jj) * LDEAB + E_BV + h * 256 + 4 * lane);
#pragma unroll
        for (int jj = 0; jj < 4; ++jj) {
            const int t = 4 * tg + jj;
            const unsigned qa = qa_[jj], qb = qb_[jj], ka = ka_[jj], kbw = kb_[jj];
            const f32x4 cs = cs_[jj];
            const float q1[2] = {__uint_as_float(qa << 16), __uint_as_float(qa & 0xffff0000u)}, q2[2] = {__uint_as_float(qb << 16), __uint_as_float(qb & 0xffff0000u)};
            const float k1[2] = {__uint_as_float(ka << 16), __uint_as_float(ka & 0xffff0000u)}, k2[2] = {__uint_as_float(kbw << 16), __uint_as_float(kbw & 0xffff0000u)};
            const float co[2] = {cs.x, cs.z}, si[2] = {cs.y, cs.w};
            float qh[4], kh[4];
#pragma unroll
            for (int e = 0; e < 2; ++e) { qh[e] = q1[e] * co[e] - q2[e] * si[e]; qh[2 + e] = q2[e] * co[e] + q1[e] * si[e];
                kh[e] = (k1[e] * co[e] - k2[e] * si[e]) * scale; kh[2 + e] = (k2[e] * co[e] + k1[e] * si[e]) * scale; }
            *(LAS unsigned*)(QH + t * LQ + c1) = pk2(qh[0], qh[1]); *(LAS unsigned*)(QH + t * LQ + 64 + c1) = pk2(qh[2], qh[3]);
            *(LAS unsigned*)(KH + t * LQ + c1) = pk2(kh[0], kh[1]); *(LAS unsigned*)(KH + t * LQ + 64 + c1) = pk2(kh[2], kh[3]);
            bf16_t* qf = F.qtb() + imgF + t * 128 + c1;
            *(unsigned*)qf = pk2(qh[0], qh[1]); *(unsigned*)(qf + 64) = pk2(qh[2], qh[3]);
#pragma unroll
            for (int e = 0; e < 4; ++e) { const unsigned a = f2bf(kh[e]);
                if (jj & 1) kf[e][jj >> 1] |= a << 16; else kf[e][jj >> 1] = a; }
        }
#pragma unroll
        for (int e = 0; e < 4; ++e) { const int ch = c1 + (e & 1) + 64 * (e >> 1);
            *(u32x2*)(F.ktb() + imgF + ch * 64 + 4 * tg) = (u32x2){kf[e][0], kf[e][1]}; }
    }
    {
        const int g = w; unsigned vt[4][4];
#pragma unroll
        for (int jj = 0; jj < 8; ++jj) {
            const u32x2 vw = vw_[jj];
            const unsigned v4[4] = {vw.x & 0xffffu, vw.x >> 16, vw.y & 0xffffu, vw.y >> 16};
#pragma unroll
            for (int e = 0; e < 4; ++e) { if (jj & 1) vt[e][jj >> 1] |= v4[e] << 16; else vt[e][jj >> 1] = v4[e]; }
        }
#pragma unroll
        for (int e = 0; e < 4; ++e) { const int ch = 4 * lane + e; const u32x4 vv = (u32x4){vt[e][0], vt[e][1], vt[e][2], vt[e][3]};
            *(u32x4*)(F.vtb() + ((size_t)(c * 8 + h) * 256 + ch) * 64 + 8 * g) = vv; }
    }
    LDS_BARRIER();
    {
        const int fr = lane & 15, fq = lane >> 4, jt = w >> 1, n0 = 2 * (w & 1), t = 16 * jt + fr;
        f32x4 ac[2] = {(f32x4){0.f, 0.f, 0.f, 0.f}, (f32x4){0.f, 0.f, 0.f, 0.f}};
#pragma unroll
        for (int kk = 0; kk < 4; ++kk) {
            const bf16x8 a = *(const LAS bf16x8*)(QH + t * LQ + 32 * kk + 8 * fq);
#pragma unroll
            for (int n = 0; n < 2; ++n) ac[n] = mfma16(*(const LAS bf16x8*)(KH + (16 * (n0 + n) + fr) * LQ + 32 * kk + 8 * fq), a, ac[n]);
        }
#pragma unroll
        for (int n = 0; n < 2; ++n) { const int t2b = 16 * (n0 + n) + 4 * fq; float p[4];
#pragma unroll
            for (int r = 0; r < 4; ++r) { const int dd = t > t2b + r ? t - (t2b + r) : (t2b + r) - t; p[r] = ac[n][r] * __builtin_amdgcn_exp2f((float)dd * lg2); }
            u32x2 ow; ow.x = pk2(p[0], p[1]); ow.y = pk2(p[2], p[3]);
            *(LAS u32x2*)(PL + t * LT + t2b) = ow; }
    }
    LDS_BARRIER();
    *(u32x4*)(F.pib() + ((size_t)(c * 8 + h) * 64 + (F.tid >> 3)) * 64 + (F.tid & 7) * 8) = *(const LAS u32x4*)(PL + (F.tid >> 3) * LT + (F.tid & 7) * 8);
    LDS_BARRIER();
}

constexpr int NSEG = 8, CPS = NCH / NSEG;
template <int MIX, int MODE> __device__ __forceinline__ void chain_seg_item(const Ctx& F, int item, int seg) {
    LAS bf16_t* QL0 = (LAS bf16_t*)F.lds; LAS bf16_t* KL0 = QL0 + 64 * LQ; LAS bf16_t* QL1 = KL0 + 128 * LT; LAS bf16_t* KL1 = QL1 + 64 * LQ; LAS float* DL = (LAS float*)(KL1 + 128 * LT);
    LAS bf16_t* PL0 = (LAS bf16_t*)(DL + 256); LAS bf16_t* PL1 = PL0 + 64 * LT;
    const bf16_t* PI = MIX == 0 ? F.pia() : F.pib();
    const int lane = F.lane, w = F.wave, tid = F.tid, fr = lane & 15, fq = lane >> 4;
    const int h = MIX == 0 ? item : (item >> 1), vhalf = MIX == 0 ? 0 : (item & 1), sitem = MIX == 0 ? item : 8 + item;
    const int ocol = (MIX == 0 ? h * 128 : 1024 + h * 256 + vhalf * 128) + 16 * w + 4 * fq;
    const bf16_t* QT = MIX == 0 ? F.qta() : F.qtb(); const bf16_t* KT = MIX == 0 ? F.kta() : F.ktb(); const bf16_t* VT = MIX == 0 ? F.vta() : F.vtb();
    const int vrow = (MIX == 0 ? 0 : vhalf * 128) + 16 * w + fr, VW = MIX == 0 ? 128 : 256;
    const float g64 = MIX == 1 ? __builtin_amdgcn_exp2f(64.f * __builtin_amdgcn_logf(1.f - __builtin_amdgcn_exp2f((float)(-5 - h)))) : 1.f;
    f32x4* SLOC = (f32x4*)F.sloc(); float* DSEG = F.dseg();
#define SLOC_AT(d_, s_, a_) SLOC[((((size_t)(sitem * 2 + (d_)) * NSEG + (s_)) * 8 + (a_)) * 8 + w) * 64 + lane]
    const float lg2g = MIX == 1 ? __builtin_amdgcn_logf(1.f - __builtin_amdgcn_exp2f((float)(-5 - h))) : 0.f;
    const float gam = 1.f - __builtin_amdgcn_exp2f((float)(-5 - h)), gami = __builtin_amdgcn_rcpf(gam); (void)gam; (void)gami;
    f32x4 S0[8], S1[8];
#pragma unroll
    for (int a = 0; a < 8; ++a) { S0[a] = (f32x4){0.f, 0.f, 0.f, 0.f}; S1[a] = S0[a]; }
    if (MODE == 1) {
        const float gseg = MIX == 1 ? __builtin_amdgcn_exp2f((float)(64 * CPS) * __builtin_amdgcn_logf(1.f - __builtin_amdgcn_exp2f((float)(-5 - h)))) : 1.f;
#pragma unroll 1
        for (int i = 0; i < NSEG - 1; ++i) {
            const bool fw = i < seg; const int s = fw ? i : NSEG - 1 - (i - seg), dI = fw ? 0 : 1;
            f32x4 ld[8], dvv[8];
#pragma unroll
            for (int a = 0; a < 8; ++a) { ld[a] = SLOC_AT(dI, s, a);
                dvv[a] = MIX == 0 ? *(const f32x4*)(DSEG + ((size_t)(h * 2 + dI) * NSEG + s) * 128 + 16 * a + 4 * fq) : (f32x4){gseg, gseg, gseg, gseg}; }
            __builtin_amdgcn_sched_barrier(0);
            if (fw) {
#pragma unroll
                for (int a = 0; a < 8; ++a) S0[a] = S0[a] * dvv[a] + ld[a];
            } else {
#pragma unroll
                for (int a = 0; a < 8; ++a) S1[a] = S1[a] * dvv[a] + ld[a];
            }
        }
    }
    float one_ = 1.f; asm volatile("" : "+v"(one_));
    u32x4 qreg[2][2], kreg[2][2], preg[2]; bf16x8 vreg[2][2]; f32x4 dreg = (f32x4){one_, one_, one_, one_}, dprod = dreg;
#define CS_ISSUE(i_) do { _Pragma("unroll") for (int d = 0; d < 2; ++d) { const int c__ = d ? seg * CPS + CPS - 1 - (i_) : seg * CPS + (i_); const size_t img = ((size_t)((MIX == 1 ? 0 : d) * NCH + c__) * 8 + h) * 8192; \
            _Pragma("unroll") for (int i = 0; i < 2; ++i) { if (MODE == 1) qreg[d][i] = *(const u32x4*)(QT + img + (size_t)(tid + 512 * i) * 8); kreg[d][i] = *(const u32x4*)(KT + img + (size_t)(tid + 512 * i) * 8); } \
            _Pragma("unroll") for (int ks = 0; ks < 2; ++ks) vreg[d][ks] = *(const bf16x8*)(VT + ((size_t)(c__ * 8 + h) * VW + vrow) * 64 + 32 * ks + 8 * fq); \
            if (MODE == 1 && (i_) < CPS / 2) preg[d] = *(const u32x4*)(PI + (size_t)(c__ * 8 + h) * 4096 + (size_t)tid * 8); } \
            if (MIX == 0 && tid < 64) { const int d = tid >> 5; const int c__ = d ? seg * CPS + CPS - 1 - (i_) : seg * CPS + (i_); dreg = *(const f32x4*)(F.da() + ((size_t)(d * NCH + c__) * 8 + h) * 128 + 4 * (tid & 31)); } } while (0)
    CS_ISSUE(0);
    u32x2 oreg[2][4];
#define CS_OLOAD(i_) do { if (MODE == 1) { const int cf_ = seg * CPS + (i_), cb_ = seg * CPS + CPS - 1 - (i_); _Pragma("unroll") for (int tt = 0; tt < 4; ++tt) { \
            oreg[0][tt] = *(const u32x2*)(F.obuf() + (size_t)(cf_ * 64 + 16 * tt + (F.lane & 15)) * YW + ocol); oreg[1][tt] = *(const u32x2*)(F.obuf() + (size_t)(cb_ * 64 + 16 * tt + (F.lane & 15)) * YW + ocol); } } } while (0)
#pragma unroll 1
    for (int it = 0; it < CPS; ++it) {
        const int cf = seg * CPS + it, cb = seg * CPS + CPS - 1 - it;
        int tid_l = F.tid; asm volatile("" : "+v"(tid_l)); const int tid = tid_l, lane = tid_l & 63, fr = lane & 15, fq = lane >> 4; (void)lane;
#pragma unroll
        for (int i = 0; i < 2; ++i) { const int p = tid + 512 * i;
            if (MODE == 1 && MIX == 1) {
                const int tq = p >> 4;
#pragma unroll
                for (int d2 = 0; d2 < 2; ++d2) { u32x4 qw = qreg[d2][i]; const float sc = __builtin_amdgcn_exp2f((float)(d2 ? 64 - tq : tq + 1) * lg2g);
#pragma unroll
                    for (int e2 = 0; e2 < 4; ++e2) qw[e2] = pk2(__uint_as_float(qw[e2] << 16) * sc, __uint_as_float(qw[e2] & 0xffff0000u) * sc);
                    qreg[d2][i] = qw; }
            }
            if (MODE == 1) { *(LAS u32x4*)(QL0 + (p >> 4) * LQ + (p & 15) * 8) = qreg[0][i]; *(LAS u32x4*)(QL1 + (p >> 4) * LQ + (p & 15) * 8) = qreg[1][i]; }
            if (MIX == 1) {
                const int tq0 = (p & 7) * 8;
#pragma unroll
                for (int d2 = 0; d2 < 2; ++d2) { u32x4 kw = kreg[d2][i];
                    float sc = __builtin_amdgcn_exp2f((float)(d2 ? tq0 : 63 - tq0) * lg2g); const float st = d2 ? gam : gami;
#pragma unroll
                    for (int e2 = 0; e2 < 4; ++e2) { const float s0 = sc, s1 = sc * st; sc = s1 * st;
                        kw[e2] = pk2(__uint_as_float(kw[e2] << 16) * s0, __uint_as_float(kw[e2] & 0xffff0000u) * s1); }
                    kreg[d2][i] = kw; __builtin_amdgcn_sched_barrier(0); }
            }
            *(LAS u32x4*)(KL0 + (p >> 3) * LT + (p & 7) * 8) = kreg[0][i]; *(LAS u32x4*)(KL1 + (p >> 3) * LT + (p & 7) * 8) = kreg[1][i]; }
        if (MIX == 0 && tid < 64) { *(LAS f32x4*)(DL + 4 * tid) = dreg; dprod = dprod * dreg; }
        const bool first = MODE == 1 && it < CPS / 2;
        if (first) { *(LAS u32x4*)(PL0 + (tid >> 3) * LT + (tid & 7) * 8) = preg[0]; *(LAS u32x4*)(PL1 + (tid >> 3) * LT + (tid & 7) * 8) = preg[1]; }
        const bf16x8 vf00 = vreg[0][0], vf01 = vreg[0][1], vf10 = vreg[1][0], vf11 = vreg[1][1];
        LDS_BARRIER();
        if (it + 1 < CPS) CS_ISSUE(it + 1);
#pragma unroll
        for (int d = 0; d < 2; ++d) {
            f32x4 (&S)[8] = d ? S1 : S0; const LAS bf16_t* QL = d ? QL1 : QL0; const LAS bf16_t* KL = d ? KL1 : KL0; const int t0 = (d ? cb : cf) * 64;
            if (MODE == 1) {
                bf16x8 sf[4];
#pragma unroll
                for (int kk = 0; kk < 4; ++kk) { u32x4 pw; pw.x = pk2(S[2 * kk][0], S[2 * kk][1]); pw.y = pk2(S[2 * kk][2], S[2 * kk][3]); pw.z = pk2(S[2 * kk + 1][0], S[2 * kk + 1][1]); pw.w = pk2(S[2 * kk + 1][2], S[2 * kk + 1][3]);
                    sf[kk] = __builtin_bit_cast(bf16x8, pw); }
                const LAS bf16_t* PLd = d ? PL1 : PL0; const bf16x8 va0 = d ? vf10 : vf00, va1 = d ? vf11 : vf01;
#pragma unroll
                for (int tt = 0; tt < 4; ++tt) {
                    f32x4 acc = (f32x4){0.f, 0.f, 0.f, 0.f};
                    if (first) {
                        acc = mfma16(va0, *(const LAS bf16x8*)(PLd + (16 * tt + fr) * LT + 8 * fq), acc);
                        acc = mfma16(va1, *(const LAS bf16x8*)(PLd + (16 * tt + fr) * LT + 32 + 8 * fq), acc);
                    }
#pragma unroll
                    for (int kk = 0; kk < 4; ++kk) {
                        const LAS bf16_t* qp = QL + (16 * tt + fr) * LQ + 32 * kk + 4 * fq;
                        const u32x2 lo = *(const LAS u32x2*)qp, hi = *(const LAS u32x2*)(qp + 16);
                        const u32x4 bw = (u32x4){lo.x, lo.y, hi.x, hi.y};
                        acc = mfma16(sf[kk], __builtin_bit_cast(bf16x8, bw), acc);
                    }
                    const u32x2 ow = first ? (u32x2){0u, 0u} : (d ? oreg[1][tt] : oreg[0][tt]);
                    u32x2 nw; nw.x = pk2(__uint_as_float(ow.x << 16) + acc[0], __uint_as_float(ow.x & 0xffff0000u) + acc[1]); nw.y = pk2(__uint_as_float(ow.y << 16) + acc[2], __uint_as_float(ow.y & 0xffff0000u) + acc[3]);
                    *(u32x2*)(F.obuf() + (size_t)(t0 + 16 * tt + fr) * YW + ocol) = nw;
                }
            }
            const bf16x8 vf0 = d ? vf10 : vf00, vf1 = d ? vf11 : vf01;
#pragma unroll
            for (int a = 0; a < 8; ++a) {
                if (MIX == 0) S[a] = S[a] * *(const LAS f32x4*)(DL + d * 128 + 16 * a + 4 * fq); else S[a] = S[a] * g64;
                S[a] = mfma16(*(const LAS bf16x8*)(KL + (16 * a + fr) * LT + 8 * fq), vf0, S[a]);
                S[a] = mfma16(*(const LAS bf16x8*)(KL + (16 * a + fr) * LT + 32 + 8 * fq), vf1, S[a]);
            }
        }
        if (it + 1 < CPS && it + 1 >= CPS / 2) CS_OLOAD(it + 1);
        LDS_BARRIER();
    }
#undef CS_OLOAD
    if (MODE == 0) {
#pragma unroll
        for (int a = 0; a < 8; ++a) { SLOC_AT(0, seg, a) = S0[a]; SLOC_AT(1, seg, a) = S1[a]; }
        if (MIX == 0 && tid < 64) *(f32x4*)(DSEG + ((size_t)(h * 2 + (tid >> 5)) * NSEG + seg) * 128 + 4 * (tid & 31)) = dprod;
    }
#undef CS_ISSUE
#undef SLOC_AT
}
__device__ __forceinline__ void rwkv_code_pass(const Ctx& F, int l, int part, int nparts) {
    const float* mu = F.in(7) + (size_t)l * 2 * CSHIFT + 3072;
    for (int idx = part * 512 + F.tid; idx < SEQ * 32; idx += nparts * 512) {
        const int t = idx >> 5, pc = idx & 31;
        const int tm = t > 0 ? t - 1 : t, tn = t < SEQ - 1 ? t + 1 : t;
        const bf16_t* cb0 = F.ecb() + 3072 + 8 * pc;
        const u32x4 pw = *(const u32x4*)(cb0 + (size_t)t * LDEC);
        const u32x4 mw = *(const u32x4*)(cb0 + (size_t)tm * LDEC) & (t > 0 ? 0xffffffffu : 0u);
        const u32x4 nw = *(const u32x4*)(cb0 + (size_t)tn * LDEC) & (t < SEQ - 1 ? 0xffffffffu : 0u);
        const f32x4 m0a = *(const f32x4*)(mu + 8 * pc), m0b = *(const f32x4*)(mu + 8 * pc + 4), m1a = *(const f32x4*)(mu + CSHIFT + 8 * pc), m1b = *(const f32x4*)(mu + CSHIFT + 8 * pc + 4);
        float o[8];
#pragma unroll
        for (int e2 = 0; e2 < 4; ++e2) {
#pragma unroll
            for (int hl = 0; hl < 2; ++hl) { const int e = 2 * e2 + hl;
                const float p = hl ? __uint_as_float(pw[e2] & 0xffff0000u) : __uint_as_float(pw[e2] << 16), pm = hl ? __uint_as_float(mw[e2] & 0xffff0000u) : __uint_as_float(mw[e2] << 16), pn = hl ? __uint_as_float(nw[e2] & 0xffff0000u) : __uint_as_float(nw[e2] << 16);
                const float m0 = e < 4 ? m0a[e & 3] : m0b[e & 3], m1 = e < 4 ? m1a[e & 3] : m1b[e & 3];
                float s = p + m0 * (pm - p) + m1 * (pn - p);
                if (pc < 16) s = 1.f - 2.f * __builtin_amdgcn_rcpf(1.f + __builtin_amdgcn_exp2f(2.8853900817779268f * s));
                o[e] = s; } }
        u32x4 ow; ow.x = pk2(o[0], o[1]); ow.y = pk2(o[2], o[3]); ow.z = pk2(o[4], o[5]); ow.w = pk2(o[6], o[7]);
        *(u32x4*)(F.codeb() + (size_t)t * 256 + 8 * pc) = ow;
    }
}
__device__ __forceinline__ void rwkv_local_item(const Ctx& F, int l, int c, int h) {
    LAS bf16_t* AL = (LAS bf16_t*)F.lds; LAS bf16_t* BE = AL + 64 * LT; LAS bf16_t* KTL = BE + 64 * LT; LAS bf16_t* RT = KTL + 64 * LT; LAS bf16_t* VT = RT + 64 * LT;
    LAS bf16_t* BBT = VT + 64 * LT; LAS bf16_t* KBT = BBT + 64 * LT; LAS bf16_t* AAB = KBT + 64 * LT; LAS bf16_t* AAK = AAB + 64 * LT; LAS bf16_t* ARB = AAK + 64 * LT; LAS bf16_t* ARK = ARB + 64 * LT;
    LAS bf16_t* XT = ARK + 64 * LT;
    LAS float* DG = (LAS float*)(XT + 128 * LT);
    LAS bf16_t* TB = (LAS bf16_t*)(DG + 1024);
    LAS bf16_t* RKVS = (LAS bf16_t*)(F.lds + 103424);
    LAS float* TOT = (LAS float*)(F.lds + 129024);
    LAS float* PCV = TOT + 1024;
#define RW_FRESH() int tid_l = F.tid; asm volatile("" : "+v"(tid_l)); const int tid = tid_l, lane = tid_l & 63, fr = lane & 15, fq = lane >> 4; (void)tid; (void)fr; (void)fq
    const int w = F.wave, t0 = c * 64; const int lane = F.lane, col = h * 64 + lane;
    const float* mu = F.in(7) + (size_t)l * 2 * CSHIFT;
    const float mr0 = mu[col], mr1 = mu[CSHIFT + col], mk0 = mu[1024 + col], mk1 = mu[CSHIFT + 1024 + col], mv0 = mu[2048 + col], mv1 = mu[CSHIFT + 2048 + col];
    const float kkw = F.in(12)[l * 1024 + col], kaw = F.in(13)[l * 1024 + col], rkw = F.in(14)[l * 1024 + col];
    float sr[8], sk[8], sv[8], kkn[8];
    float lw2r[2][8], ar[2][8];
    bf16_t pr[10], pk[10], pv[10];
    {
        constexpr int LC = 264, LO = 68;
        LAS bf16_t* CODE = (LAS bf16_t*)F.lds; LAS float* LOUT = (LAS float*)(F.lds + 64 * LC * 2);
        bf16x8 la[2][2]; f32x4 lb[2];
        {
            const int gi = w >> 1, kind = gi >> 1, dd = gi & 1, fr0 = lane & 15, fq0 = lane >> 4;
            const bf16_t* A = F.lwt() + ((size_t)gi * 1024 + h * 64) * 64;
            const float* bias = (kind == 0 ? F.in(8) : F.in(10)) + (l * 2 + dd) * 1024 + h * 64;
#pragma unroll
            for (int ci = 0; ci < 2; ++ci) { const int ct = 2 * (w & 1) + ci;
                la[ci][0] = *(const bf16x8*)(A + (size_t)(16 * ct + fr0) * 64 + 8 * fq0); la[ci][1] = *(const bf16x8*)(A + (size_t)(16 * ct + fr0) * 64 + 32 + 8 * fq0);
                lb[ci] = *(const f32x4*)(bias + 16 * ct + 4 * fq0); }
        }
        u32x4 rkvw[4];
#pragma unroll
        for (int i = 0; i < 4; ++i) { int pp = F.tid + 512 * i; pp = pp < 1584 ? pp : 1583; const int kind = pp >= 1056 ? 2 : (pp >= 528 ? 1 : 0), rem = pp - 528 * kind; int t = t0 - 1 + (rem >> 3); t = t < 0 ? 0 : (t >= SEQ ? SEQ - 1 : t);
            rkvw[i] = *(const u32x4*)(F.ecb() + (size_t)t * LDEC + kind * 1024 + h * 64 + (rem & 7) * 8); }
        u32x4 cpw[4];
#pragma unroll
        for (int hh = 0; hh < 4; ++hh) cpw[hh] = *(const u32x4*)(F.codeb() + (size_t)(t0 + (F.tid >> 3)) * 256 + 32 * (F.tid & 7) + 8 * hh);
        {
            RW_FRESH();
            const int tok = tid >> 3, cg = tid & 7;
#pragma unroll
            for (int hh = 0; hh < 4; ++hh) *(LAS u32x4*)(CODE + tok * LC + 32 * cg + 8 * hh) = cpw[hh];
#pragma unroll
            for (int i = 0; i < 4; ++i) { const int pp = tid + 512 * i; const int kind = pp >= 1056 ? 2 : (pp >= 528 ? 1 : 0), rem = pp - 528 * kind; const int tt = t0 - 1 + (rem >> 3);
                const unsigned okm = (tt >= 0 && tt < SEQ) ? 0xffffffffu : 0u;
                if (pp < 1584) *(LAS u32x4*)(RKVS + (kind * 66 + (rem >> 3)) * 64 + (rem & 7) * 8) = rkvw[i] & okm; }
        }
        LDS_BARRIER();
        {
            RW_FRESH();
            const int gi = w >> 1, kind = gi >> 1;
#pragma unroll
            for (int ci = 0; ci < 2; ++ci) {
                const int ct = 2 * (w & 1) + ci;
                const bf16x8 a0 = la[ci][0], a1 = la[ci][1];
                const f32x4 bv = lb[ci];
#pragma unroll
                for (int tt = 0; tt < 4; ++tt) {
                    f32x4 acc = bv;
                    acc = mfma16(a0, *(const LAS bf16x8*)(CODE + (16 * tt + fr) * LC + gi * 64 + 8 * fq), acc);
                    acc = mfma16(a1, *(const LAS bf16x8*)(CODE + (16 * tt + fr) * LC + gi * 64 + 32 + 8 * fq), acc);
                    f32x4 y;
#pragma unroll
                    for (int r = 0; r < 4; ++r) { const float sg = sigmoidf_(acc[r]); y[r] = kind == 0 ? (-0.6065306597126334f * LOG2E) * sg : sg; }
                    *(LAS f32x4*)(LOUT + (gi * 64 + 16 * tt + fr) * LO + 16 * ct + 4 * fq) = y;
                }
            }
        }
        LDS_BARRIER();
#pragma unroll
        for (int dd = 0; dd < 2; ++dd)
#pragma unroll
            for (int jj = 0; jj < 8; ++jj) { lw2r[dd][jj] = LOUT[(dd * 64 + 8 * w + jj) * LO + lane]; ar[dd][jj] = LOUT[((2 + dd) * 64 + 8 * w + jj) * LO + lane]; }
        LDS_BARRIER();
    }
    {
#pragma unroll
        for (int i = 0; i < 10; ++i) { pr[i] = RKVS[(8 * w + i) * 64 + lane]; pk[i] = RKVS[(66 + 8 * w + i) * 64 + lane]; pv[i] = RKVS[(132 + 8 * w + i) * 64 + lane]; }
#pragma unroll
        for (int jj = 0; jj < 8; ++jj) {
            sr[jj] = bf2f(pr[jj + 1]) + mr0 * (bf2f(pr[jj]) - bf2f(pr[jj + 1])) + mr1 * (bf2f(pr[jj + 2]) - bf2f(pr[jj + 1]));
            sk[jj] = bf2f(pk[jj + 1]) + mk0 * (bf2f(pk[jj]) - bf2f(pk[jj + 1])) + mk1 * (bf2f(pk[jj + 2]) - bf2f(pk[jj + 1]));
            sv[jj] = bf2f(pv[jj + 1]) + mv0 * (bf2f(pv[jj]) - bf2f(pv[jj + 1])) + mv1 * (bf2f(pv[jj + 2]) - bf2f(pv[jj + 1]));
            F.svb()[(size_t)(t0 + 8 * w + jj) * 1024 + col] = (bf16_t)f2bf(sv[jj]);
        }
        float kq[8];
#pragma unroll
        for (int jj = 0; jj < 8; ++jj) { const float kkr = sk[jj] * kkw; kq[jj] = kkr * kkr; }
        const float ksum = multi_sum8(kq, lane);
#pragma unroll
        for (int jj = 0; jj < 8; ++jj) kkn[jj] = sk[jj] * kkw * __builtin_amdgcn_rsqf(rlf(ksum, ms8_lane(jj)) + 1e-12f);
    }
    {
        float t0s = 0.f, t1s = 0.f;
#pragma unroll
        for (int jj = 0; jj < 8; ++jj) { t0s += lw2r[0][jj]; t1s += lw2r[1][jj]; }
        TOT[w * 64 + lane] = t0s; TOT[512 + w * 64 + lane] = t1s;
    }
    LDS_BARRIER();
    f32x4 oacc[2] = {(f32x4){0.f, 0.f, 0.f, 0.f}, (f32x4){0.f, 0.f, 0.f, 0.f}};
#pragma unroll 1
    for (int d = 0; d < 2; ++d) {
        {
            float lw2[8], av[8], kd[8];
            float bq[8];
#pragma unroll
            for (int jj = 0; jj < 8; ++jj) { lw2[jj] = d ? lw2r[1][jj] : lw2r[0][jj]; av[jj] = d ? ar[1][jj] : ar[0][jj]; kd[jj] = sk[jj] * (1.f + (av[jj] - 1.f) * kaw);
                bq[jj] = sr[jj] * kd[jj] * rkw; }
            const float bonl = multi_sum8(bq, lane);
            if (lane < 8) F.bons()[((size_t)d * SEQ + t0 + 8 * w + ms8_index(lane)) * 16 + h] = bonl;
            unsigned bbp[4] = {0u, 0u, 0u, 0u}, kbp[4] = {0u, 0u, 0u, 0u}, vtp[4] = {0u, 0u, 0u, 0u};
            const int j0 = d ? 63 - (8 * w + 7) : 8 * w;
            float off = 0.f, l63 = 0.f;
#pragma unroll
            for (int gg = 0; gg < 8; ++gg) { const float tg = TOT[d * 512 + gg * 64 + lane]; l63 += tg; const bool bef = d == 0 ? gg < w : gg > w; off += bef ? tg : 0.f; }
            if (w == 0) PCV[lane] = __builtin_amdgcn_exp2f(l63);
            float lam[8];
            if (d == 0) { float run = off;
#pragma unroll
                for (int jj = 0; jj < 8; ++jj) { run += lw2[jj]; lam[jj] = run; } }
            else { float run = off;
#pragma unroll
                for (int jj = 7; jj >= 0; --jj) { run += lw2[jj]; lam[jj] = run; } }
#pragma unroll
            for (int jj = 0; jj < 8; ++jj) {
                const int tl = 8 * w + jj, j = d ? 63 - tl : tl;
                const float ep = __builtin_amdgcn_exp2f(lam[jj]), en = __builtin_amdgcn_exp2f(-lam[jj]), eb = __builtin_amdgcn_exp2f(l63 - lam[jj]);
                const float bet = kkn[jj] * av[jj];
                AL[j * LT + lane] = (bf16_t)f2bf(-kkn[jj] * __builtin_amdgcn_exp2f(lam[jj] - lw2[jj]));
                BE[j * LT + lane] = (bf16_t)f2bf(bet * en); KTL[j * LT + lane] = (bf16_t)f2bf(kd[jj] * en); RT[j * LT + lane] = (bf16_t)f2bf(sr[jj] * ep);
                const unsigned bb = f2bf(bet * eb), kb = f2bf(kd[jj] * eb), vb = f2bf(sv[jj]);
                bbp[jj >> 1] |= bb << (16 * (jj & 1)); kbp[jj >> 1] |= kb << (16 * (jj & 1)); vtp[jj >> 1] |= vb << (16 * (jj & 1));
                if ((jj & 3) == 3) __builtin_amdgcn_sched_barrier(0);
            }
            if (d) {
#pragma unroll
                for (int q = 0; q < 2; ++q) { unsigned a, b;
                    a = bbp[q]; b = bbp[3 - q]; bbp[q] = (b >> 16) | (b << 16); bbp[3 - q] = (a >> 16) | (a << 16);
                    a = kbp[q]; b = kbp[3 - q]; kbp[q] = (b >> 16) | (b << 16); kbp[3 - q] = (a >> 16) | (a << 16);
                    a = vtp[q]; b = vtp[3 - q]; vtp[q] = (b >> 16) | (b << 16); vtp[3 - q] = (a >> 16) | (a << 16); }
            }
            *(LAS u32x4*)(VT + lane * LT + j0) = (u32x4){vtp[0], vtp[1], vtp[2], vtp[3]};
            *(LAS u32x4*)(BBT + lane * LT + j0) = (u32x4){bbp[0], bbp[1], bbp[2], bbp[3]};
            *(LAS u32x4*)(KBT + lane * LT + j0) = (u32x4){kbp[0], kbp[1], kbp[2], kbp[3]};
        }
        LDS_BARRIER();
        {
            RW_FRESH(); const int blk = w >> 1;
            const LAS bf16_t* Am = blk < 2 ? AL : RT; const LAS bf16_t* Bm = (blk & 1) ? KTL : BE;
            LAS bf16_t* Om = blk == 0 ? AAB : (blk == 1 ? AAK : (blk == 2 ? ARB : ARK));
            const int incl = blk >> 1;
#pragma unroll
            for (int ri = 0; ri < 2; ++ri) {
                const int jt = 2 * (w & 1) + ri, j = 16 * jt + fr;
                const bf16x8 a0 = *(const LAS bf16x8*)(Am + j * LT + 8 * fq), a1 = *(const LAS bf16x8*)(Am + j * LT + 32 + 8 * fq);
#pragma unroll
                for (int ct = 0; ct < 4; ++ct) {
                    f32x4 acc = (f32x4){0.f, 0.f, 0.f, 0.f};
                    acc = mfma16(*(const LAS bf16x8*)(Bm + (16 * ct + fr) * LT + 8 * fq), a0, acc);
                    acc = mfma16(*(const LAS bf16x8*)(Bm + (16 * ct + fr) * LT + 32 + 8 * fq), a1, acc);
                    const int j2b = 16 * ct + 4 * fq;
                    float v[4];
#pragma unroll
                    for (int r = 0; r < 4; ++r) v[r] = (j2b + r < j + incl) ? acc[r] : 0.f;
                    if (blk == 0 && ct == jt) *(LAS f32x4*)(DG + jt * 256 + fr * 16 + 4 * fq) = (f32x4){v[0], v[1], v[2], v[3]};
                    u32x2 ow; ow.x = pk2(v[0], v[1]); ow.y = pk2(v[2], v[3]);
                    *(LAS u32x2*)(Om + j * LT + j2b) = ow;
                }
            }
        }
        LDS_BARRIER();
        f32x4 rhs[4];
        {
            RW_FRESH();
            if (w >= 4) {
#pragma unroll
                for (int bi = 0; bi < 4; ++bi) { f32x4 acc = (f32x4){0.f, 0.f, 0.f, 0.f};
#pragma unroll
                    for (int ks = 0; ks < 2; ++ks) acc = mfma16(*(const LAS bf16x8*)(AAK + (16 * bi + fr) * LT + 32 * ks + 8 * fq), *(const LAS bf16x8*)(VT + (16 * (w - 4) + fr) * LT + 32 * ks + 8 * fq), acc);
                    rhs[bi] = acc; }
            } else {
#pragma unroll
                for (int bi = 0; bi < 4; ++bi)
#pragma unroll
                    for (int r = 0; r < 4; ++r) rhs[bi][r] = bf2f(AL[(16 * bi + 4 * fq + r) * LT + 16 * w + fr]);
            }
            if (w == 0) {
                const int blk = lane >> 4, cc = lane & 15; float x[16];
#pragma unroll
                for (int jl = 0; jl < 16; ++jl) {
                    float s = (jl == cc) ? 1.f : 0.f;
#pragma unroll
                    for (int j2 = 0; j2 < jl; ++j2) s += DG[blk * 256 + jl * 16 + j2] * x[j2];
                    x[jl] = s;
                    TB[blk * 384 + jl * 24 + cc] = (bf16_t)f2bf(s);
                }
            }
        }
        LDS_BARRIER();
        {
            RW_FRESH();
            f32x4 X[4]; const u32x2 z2 = (u32x2){0u, 0u};
#pragma unroll
            for (int bi = 0; bi < 4; ++bi) {
                f32x4 s = rhs[bi];
                if (bi >= 1) {
                    u32x4 bw; bw.x = pk2(X[0][0], X[0][1]); bw.y = pk2(X[0][2], X[0][3]);
                    if (bi >= 2) { bw.z = pk2(X[1][0], X[1][1]); bw.w = pk2(X[1][2], X[1][3]); } else { bw.z = 0u; bw.w = 0u; }
                    const LAS bf16_t* ap = AAB + (16 * bi + fr) * LT + 4 * fq; const u32x2 lo = *(const LAS u32x2*)ap, hi = *(const LAS u32x2*)(ap + 16);
                    const u32x4 aw = (u32x4){lo.x, lo.y, hi.x, hi.y};
                    s = mfma16(__builtin_bit_cast(bf16x8, aw), __builtin_bit_cast(bf16x8, bw), s);
                }
                if (bi == 3) {
                    u32x4 bw; bw.x = pk2(X[2][0], X[2][1]); bw.y = pk2(X[2][2], X[2][3]); bw.z = 0u; bw.w = 0u;
                    const LAS bf16_t* ap = AAB + (48 + fr) * LT + 32 + 4 * fq; const u32x2 lo = *(const LAS u32x2*)ap;
                    const u32x4 aw = (u32x4){lo.x, lo.y, z2.x, z2.y};
                    s = mfma16(__builtin_bit_cast(bf16x8, aw), __builtin_bit_cast(bf16x8, bw), s);
                }
                {
                    u32x4 bw; bw.x = pk2(s[0], s[1]); bw.y = pk2(s[2], s[3]); bw.z = 0u; bw.w = 0u;
                    const u32x2 lo = *(const LAS u32x2*)(TB + bi * 384 + fr * 24 + 4 * fq);
                    const u32x4 aw = (u32x4){lo.x, lo.y, z2.x, z2.y};
                    X[bi] = mfma16(__builtin_bit_cast(bf16x8, aw), __builtin_bit_cast(bf16x8, bw), (f32x4){0.f, 0.f, 0.f, 0.f});
                }
                u32x2 ow; ow.x = pk2(X[bi][0], X[bi][1]); ow.y = pk2(X[bi][2], X[bi][3]);
                *(LAS u32x2*)(XT + (16 * w + fr) * LT + 16 * bi + 4 * fq) = ow;
            }
        }
        LDS_BARRIER();
        {
            RW_FRESH();
            const size_t img = ((size_t)(d * NCH + c) * 16 + h) * 4096;
#pragma unroll
            for (int ti = 0; ti < 2; ++ti) {
                const int tile = 2 * w + ti, rt = tile >> 2, ct = tile & 3;
                {
                    f32x4 acc = (f32x4){0.f, 0.f, 0.f, 0.f};
#pragma unroll
                    for (int ks = 0; ks < 2; ++ks) acc = mfma16(*(const LAS bf16x8*)(XT + (16 * rt + fr) * LT + 32 * ks + 8 * fq), *(const LAS bf16x8*)(ARB + (16 * ct + fr) * LT + 32 * ks + 8 * fq), acc);
                    const int j = 16 * ct + fr, k0 = 16 * rt + 4 * fq;
                    const u32x2 rw = *(const LAS u32x2*)(RT + j * LT + k0);
                    u32x2 ow; ow.x = pk2(acc[0] + __uint_as_float(rw.x << 16), acc[1] + __uint_as_float(rw.x & 0xffff0000u)); ow.y = pk2(acc[2] + __uint_as_float(rw.y << 16), acc[3] + __uint_as_float(rw.y & 0xffff0000u));
                    *(u32x2*)(F.rhi() + img + j * 64 + k0) = ow;
                }
                {
                    f32x4 acc = (f32x4){0.f, 0.f, 0.f, 0.f};
#pragma unroll
                    for (int ks = 0; ks < 2; ++ks) acc = mfma16(*(const LAS bf16x8*)(XT + (16 * rt + fr) * LT + 32 * ks + 8 * fq), *(const LAS bf16x8*)(BBT + (16 * ct + fr) * LT + 32 * ks + 8 * fq), acc);
                    const int k = 16 * ct + fr, kp0 = 16 * rt + 4 * fq; const float pc = PCV[k];
#pragma unroll
                    for (int r = 0; r < 4; ++r) acc[r] += (kp0 + r == k) ? pc : 0.f;
                    u32x2 ow; ow.x = pk2(acc[0], acc[1]); ow.y = pk2(acc[2], acc[3]);
                    *(u32x2*)(F.mi() + img + k * 64 + kp0) = ow;
                }
                {
                    f32x4 acc = (f32x4){0.f, 0.f, 0.f, 0.f};
#pragma unroll
                    for (int ks = 0; ks < 2; ++ks) {
                        acc = mfma16(*(const LAS bf16x8*)(BBT + (16 * rt + fr) * LT + 32 * ks + 8 * fq), *(const LAS bf16x8*)(XT + (64 + 16 * ct + fr) * LT + 32 * ks + 8 * fq), acc);
                        acc = mfma16(*(const LAS bf16x8*)(KBT + (16 * rt + fr) * LT + 32 * ks + 8 * fq), *(const LAS bf16x8*)(VT + (16 * ct + fr) * LT + 32 * ks + 8 * fq), acc);
                    }
                    const int v = 16 * ct + fr, k0 = 16 * rt + 4 * fq;
                    u32x2 ow; ow.x = pk2(acc[0], acc[1]); ow.y = pk2(acc[2], acc[3]);
                    *(u32x2*)(F.ni() + img + v * 64 + k0) = ow;
                }
                {
                    const int tl = 16 * ct + fr, j = d ? 63 - tl : tl;
                    f32x4 acc = (f32x4){0.f, 0.f, 0.f, 0.f};
#pragma unroll
                    for (int ks = 0; ks < 2; ++ks) {
                        acc = mfma16(*(const LAS bf16x8*)(XT + (64 + 16 * rt + fr) * LT + 32 * ks + 8 * fq), *(const LAS bf16x8*)(ARB + j * LT + 32 * ks + 8 * fq), acc);
                        acc = mfma16(*(const LAS bf16x8*)(VT + (16 * rt + fr) * LT + 32 * ks + 8 * fq), *(const LAS bf16x8*)(ARK + j * LT + 32 * ks + 8 * fq), acc);
                    }
                    if (d) { acc = acc + oacc[ti]; u32x2 ow; ow.x = pk2(acc[0], acc[1]); ow.y = pk2(acc[2], acc[3]);
                        *(u32x2*)(F.obuf() + (size_t)(t0 + tl) * YW + 3072 + h * 64 + 16 * rt + 4 * fq) = ow; }
                    else oacc[ti] = acc;
                }
            }
        }
        LDS_BARRIER();
    }
}
#undef RW_FRESH
constexpr int NSEGC = 16, CPSC = NCH / NSEGC;
constexpr int GSEG = 4;
template <int MODE> __device__ __forceinline__ void rwkv_seg_item(const Ctx& F, int h, int seg) {
    LAS bf16_t* ML0 = (LAS bf16_t*)F.lds; LAS bf16_t* ML1 = ML0 + 64 * LT; LAS bf16_t* RL0 = ML1 + 64 * LT; LAS bf16_t* RL1 = RL0 + 64 * LT;
    const int lane = F.lane, w = F.wave, tid = F.tid, fr = lane & 15, fq = lane >> 4;
    f32x4* NSG = (f32x4*)F.cseg(); bf16_t* MSG = F.cmseg();
#define NSG_AT(d_, s_, a_) NSG[((((size_t)(h * 2 + (d_)) * NSEGC + (s_)) * 4 + (a_)) * 4 + (w & 3)) * 64 + lane]
#define MSG_AT(d_, s_) (MSG + ((size_t)(h * 2 + (d_)) * NSEGC + (s_)) * 4096)
    f32x4 X0[4], X1[4];
#pragma unroll
    for (int a = 0; a < 4; ++a) {
        X0[a] = (f32x4){0.f, 0.f, 0.f, 0.f};
        if (MODE == 0 && w >= 4) {
#pragma unroll
            for (int r = 0; r < 4; ++r) X0[a][r] = (16 * a + 4 * fq + r == 16 * (w - 4) + fr) ? 1.f : 0.f;
        }
        X1[a] = X0[a];
    }
#define RW_SF(X, sf) do { _Pragma("unroll") for (int kk = 0; kk < 2; ++kk) { u32x4 pw; pw.x = pk2(X[2 * kk][0], X[2 * kk][1]); pw.y = pk2(X[2 * kk][2], X[2 * kk][3]); pw.z = pk2(X[2 * kk + 1][0], X[2 * kk + 1][1]); pw.w = pk2(X[2 * kk + 1][2], X[2 * kk + 1][3]); sf[kk] = __builtin_bit_cast(bf16x8, pw); } } while (0)
#define RW_UPD(X, ML, init, sf) do { _Pragma("unroll") for (int a = 0; a < 4; ++a) { f32x4 acc = init[a]; _Pragma("unroll") for (int kk = 0; kk < 2; ++kk) { const LAS bf16_t* mp = ML + (16 * a + fr) * LT + 32 * kk + 4 * fq; \
            const u32x2 lo = *(const LAS u32x2*)mp, hi = *(const LAS u32x2*)(mp + 16); const u32x4 aw = (u32x4){lo.x, lo.y, hi.x, hi.y}; acc = mfma16(__builtin_bit_cast(bf16x8, aw), sf[kk], acc); } init[a] = acc; } \
            _Pragma("unroll") for (int a = 0; a < 4; ++a) X[a] = init[a]; } while (0)
    if (MODE == 1) {
        const int g = seg / GSEG, kq = seg % GSEG, NG = NSEGC / GSEG;
        const int nf = g + (kq > 0 ? 1 : 0), nb = (NG - 1 - g) + (kq < GSEG - 1 ? 1 : 0), ns = nf > nb ? nf : nb;
#pragma unroll 1
        for (int i = 0; i < ns; ++i) {
            const bool df = i < nf, db = i < nb;
            const int sf_ = i < g ? GSEG * i + GSEG - 1 : seg - 1, sb_ = i < NG - 1 - g ? GSEG * (NG - 1 - i) : seg + 1;
            if (df) *(LAS u32x4*)(ML0 + (tid >> 3) * LT + (tid & 7) * 8) = *(const u32x4*)(MSG_AT(0, sf_) + (size_t)tid * 8);
            if (db) *(LAS u32x4*)(ML1 + (tid >> 3) * LT + (tid & 7) * 8) = *(const u32x4*)(MSG_AT(1, sb_) + (size_t)tid * 8);
            LDS_BARRIER();
            if (w < 4) {
                if (df) { bf16x8 sf[2]; RW_SF(X0, sf); f32x4 init[4];
#pragma unroll
                    for (int a = 0; a < 4; ++a) init[a] = NSG_AT(0, sf_, a);
                    RW_UPD(X0, ML0, init, sf); }
                if (db) { bf16x8 sf[2]; RW_SF(X1, sf); f32x4 init[4];
#pragma unroll
                    for (int a = 0; a < 4; ++a) init[a] = NSG_AT(1, sb_, a);
                    RW_UPD(X1, ML1, init, sf); }
            }
            LDS_BARRIER();
        }
    }
    u32x4 mreg[2], rreg[2]; u32x2 nreg[2][4];
    constexpr int NIT = MODE == 0 ? GSEG * CPSC : CPSC;
#define RS_ISSUE(i_) do { _Pragma("unroll") for (int d = 0; d < 2; ++d) { const int c__ = d ? seg * CPSC + NIT - 1 - (i_) : seg * CPSC + (i_); const size_t img = ((size_t)(d * NCH + c__) * 16 + h) * 4096; \
            mreg[d] = *(const u32x4*)(F.mi() + img + (size_t)tid * 8); if (MODE == 1) rreg[d] = *(const u32x4*)(F.rhi() + img + (size_t)tid * 8); \
            if (w < 4) { _Pragma("unroll") for (int a = 0; a < 4; ++a) nreg[d][a] = *(const u32x2*)(F.ni() + img + (16 * w + fr) * 64 + 16 * a + 4 * fq); } } } while (0)
    RS_ISSUE(0);
    u32x2 oreg[2][4];
#define RS_OLOAD(i_) do { if (MODE == 1 && w < 4) { const int cf_ = seg * CPSC + (i_), cb_ = seg * CPSC + NIT - 1 - (i_); _Pragma("unroll") for (int tt = 0; tt < 4; ++tt) { \
            oreg[0][tt] = *(const u32x2*)(F.obuf() + (size_t)(cf_ * 64 + 16 * tt + (F.lane & 15)) * YW + 3072 + h * 64 + 16 * w + 4 * (F.lane >> 4)); \
            oreg[1][tt] = *(const u32x2*)(F.obuf() + (size_t)(cb_ * 64 + 16 * tt + (F.lane & 15)) * YW + 3072 + h * 64 + 16 * w + 4 * (F.lane >> 4)); } } } while (0)
    RS_OLOAD(0);
#pragma unroll 1
    for (int it = 0; it < NIT; ++it) {
        const int cf = seg * CPSC + it, cb = seg * CPSC + NIT - 1 - it;
        *(LAS u32x4*)(ML0 + (tid >> 3) * LT + (tid & 7) * 8) = mreg[0]; *(LAS u32x4*)(ML1 + (tid >> 3) * LT + (tid & 7) * 8) = mreg[1];
        if (MODE == 1) { *(LAS u32x4*)(RL0 + (tid >> 3) * LT + (tid & 7) * 8) = rreg[0]; *(LAS u32x4*)(RL1 + (tid >> 3) * LT + (tid & 7) * 8) = rreg[1]; }
        f32x4 nin[2][4];
#pragma unroll
        for (int d = 0; d < 2; ++d)
#pragma unroll
            for (int a = 0; a < 4; ++a) nin[d][a] = (w < 4) ? (f32x4){__uint_as_float(nreg[d][a].x << 16), __uint_as_float(nreg[d][a].x & 0xffff0000u), __uint_as_float(nreg[d][a].y << 16), __uint_as_float(nreg[d][a].y & 0xffff0000u)} : (f32x4){0.f, 0.f, 0.f, 0.f};
        LDS_BARRIER();
        if (it + 1 < NIT) RS_ISSUE(it + 1);
        if (MODE == 0 || w < 4) {
#pragma unroll
            for (int d = 0; d < 2; ++d) {
                f32x4 (&X)[4] = d ? X1 : X0; const LAS bf16_t* ML = d ? ML1 : ML0; const LAS bf16_t* RL = d ? RL1 : RL0; const int t0 = (d ? cb : cf) * 64;
                bf16x8 sf[2]; RW_SF(X, sf);
                if (MODE == 1) {
#pragma unroll
                    for (int tt = 0; tt < 4; ++tt) {
                        const int tl = 16 * tt + fr, j = d ? 63 - tl : tl;
                        f32x4 acc = (f32x4){0.f, 0.f, 0.f, 0.f};
#pragma unroll
                        for (int kk = 0; kk < 2; ++kk) { const LAS bf16_t* qp = RL + j * LT + 32 * kk + 4 * fq; const u32x2 lo = *(const LAS u32x2*)qp, hi = *(const LAS u32x2*)(qp + 16);
                            const u32x4 bw = (u32x4){lo.x, lo.y, hi.x, hi.y}; acc = mfma16(sf[kk], __builtin_bit_cast(bf16x8, bw), acc); }
                        const u32x2 ow = d ? oreg[1][tt] : oreg[0][tt];
                        u32x2 nw; nw.x = pk2(__uint_as_float(ow.x << 16) + acc[0], __uint_as_float(ow.x & 0xffff0000u) + acc[1]); nw.y = pk2(__uint_as_float(ow.y << 16) + acc[2], __uint_as_float(ow.y & 0xffff0000u) + acc[3]);
                        *(u32x2*)(F.obuf() + (size_t)(t0 + tl) * YW + 3072 + h * 64 + 16 * w + 4 * fq) = nw;
                    }
                }
                RW_UPD(X, ML, nin[d], sf);
            }
        }
        if (it + 1 < NIT) RS_OLOAD(it + 1);
        if (MODE == 0 && (it % CPSC) == CPSC - 1) {
            const int sf_ = seg + it / CPSC, sb_ = seg + GSEG - 1 - it / CPSC;
            if (w < 4) {
#pragma unroll
                for (int a = 0; a < 4; ++a) { NSG_AT(0, sf_, a) = X0[a]; NSG_AT(1, sb_, a) = X1[a]; }
            } else {
#pragma unroll
                for (int a = 0; a < 4; ++a)
#pragma unroll
                    for (int r = 0; r < 4; ++r) { const int k = 16 * a + 4 * fq + r, kp = 16 * (w - 4) + fr;
                        MSG_AT(0, sf_)[k * 64 + kp] = (bf16_t)f2bf(X0[a][r]); MSG_AT(1, sb_)[k * 64 + kp] = (bf16_t)f2bf(X1[a][r]); }
            }
        }
        LDS_BARRIER();
    }
#undef RS_OLOAD
#undef RS_ISSUE
#undef RW_SF
#undef RW_UPD
#undef NSG_AT
#undef MSG_AT
}
__device__ __forceinline__ void unpack8(const u32x4 w, float (&v)[8]) {
    v[0] = __uint_as_float(w.x << 16); v[1] = __uint_as_float(w.x & 0xffff0000u); v[2] = __uint_as_float(w.y << 16); v[3] = __uint_as_float(w.y & 0xffff0000u);
    v[4] = __uint_as_float(w.z << 16); v[5] = __uint_as_float(w.z & 0xffff0000u); v[6] = __uint_as_float(w.w << 16); v[7] = __uint_as_float(w.w & 0xffff0000u);
}
__device__ __forceinline__ u32x4 pack8(const float (&v)[8]) { u32x4 w; w.x = pk2(v[0], v[1]); w.y = pk2(v[2], v[3]); w.z = pk2(v[4], v[5]); w.w = pk2(v[6], v[7]); return w; }
template <int NL> __device__ __forceinline__ float group_sum(float v) {
    if (NL == 8) return row_sum8(v);
    v = row_sum16(v);
    if (NL == 32) { const auto r = __builtin_amdgcn_permlane16_swap(__float_as_uint(v), __float_as_uint(v), false, false); v = __uint_as_float(r[0]) + __uint_as_float(r[1]); }
    return v;
}
__device__ __forceinline__ void norm_phase(const Ctx& F, int l) {
    const int gw = blockIdx.x * NWAVES + F.wave, NGW = F.G * NWAVES, lane = F.lane;
    const float* ga = F.in(4) + l * 1024; const float* gb = F.in(5) + l * 2048; const float* bb = F.in(6) + l * 2048; const float* gc = F.in(15) + l * 1024; const float* bc = F.in(16) + l * 1024;
#pragma unroll 1
    for (int t = gw; t < SEQ; t += NGW) {
        bf16_t* orow = F.obuf() + (size_t)t * YW; const bf16_t* prow = F.lbuf() + (size_t)t * LDL;
        float epsA = 1e-6f, epsB = 1e-5f, epsC = 64e-5f; asm volatile("" : "+s"(epsA), "+s"(epsB), "+s"(epsC));
        u32x4 ow[8], gt[8], svw[2]; float bn[2];
#pragma unroll
        for (int j = 0; j < 8; ++j) { ow[j] = *(const u32x4*)(orow + 8 * (64 * j + lane)); gt[j] = *(const u32x4*)(prow + 8 * (64 * j + lane)); }
#pragma unroll
        for (int j = 0; j < 2; ++j) { const int q = 64 * j + lane, hd = q >> 3;
            svw[j] = *(const u32x4*)(F.svb() + (size_t)t * 1024 + 8 * q); bn[j] = F.bons()[(size_t)t * 16 + hd] + F.bons()[((size_t)SEQ + t) * 16 + hd]; }
#pragma unroll
        for (int j = 0; j < 8; ++j) {
            float o[8], g[8], y[8], pg[8], pb[8]; unpack8(ow[j], o); unpack8(gt[j], g);
#pragma unroll
            for (int e = 0; e < 8; ++e) g[e] = siluf_(g[e]);
            {
                const int ch = 8 * (64 * (j < 2 ? j : j < 6 ? j - 2 : j - 6) + lane);
                const float* gsrc = (j < 2 ? ga : j < 6 ? gb : gc) + ch;
                const f32x4 g0 = *(const f32x4*)gsrc, g1 = *(const f32x4*)(gsrc + 4);
                pg[0] = g0.x; pg[1] = g0.y; pg[2] = g0.z; pg[3] = g0.w; pg[4] = g1.x; pg[5] = g1.y; pg[6] = g1.z; pg[7] = g1.w;
                if (j >= 2) { const float* bsrc = (j < 6 ? bb : bc) + ch; const f32x4 b0 = *(const f32x4*)bsrc, b1 = *(const f32x4*)(bsrc + 4);
                    pb[0] = b0.x; pb[1] = b0.y; pb[2] = b0.z; pb[3] = b0.w; pb[4] = b1.x; pb[5] = b1.y; pb[6] = b1.z; pb[7] = b1.w; }
            }
            if (j < 2) {
                float s = 0.f;
#pragma unroll
                for (int e = 0; e < 8; ++e) s += o[e] * o[e];
                const float r = rsqrtf(group_sum<16>(s) * (1.f / 128.f) + epsA);
#pragma unroll
                for (int e = 0; e < 8; ++e) y[e] = o[e] * r * pg[e] * g[e];
            } else if (j < 6) {
                float s = 0.f;
#pragma unroll
                for (int e = 0; e < 8; ++e) s += o[e];
                const float mean = group_sum<32>(s) * (1.f / 256.f); float q = 0.f;
#pragma unroll
                for (int e = 0; e < 8; ++e) { o[e] -= mean; q += o[e] * o[e]; }
                const float r = rsqrtf(group_sum<32>(q) * (1.f / 256.f) + epsB);
#pragma unroll
                for (int e = 0; e < 8; ++e) y[e] = (o[e] * r * pg[e] + pb[e]) * g[e];
            } else {
                float s = 0.f;
#pragma unroll
                for (int e = 0; e < 8; ++e) s += o[e];
                const float mean = group_sum<8>(s) * (1.f / 64.f); float q = 0.f;
#pragma unroll
                for (int e = 0; e < 8; ++e) { o[e] -= mean; q += o[e] * o[e]; }
                const float r = rsqrtf(group_sum<8>(q) * (1.f / 64.f) + epsC);
                float sv[8]; unpack8(svw[j - 6], sv);
#pragma unroll
                for (int e = 0; e < 8; ++e) y[e] = (o[e] * r * pg[e] + pb[e] + bn[j - 6] * sv[e]) * g[e];
            }
            *(u32x4*)(orow + 8 * (64 * j + lane)) = pack8(y);
            if (j & 1) __builtin_amdgcn_sched_barrier(0);
        }
    }
}
constexpr int PB = 9, PH_PER_LAYER = 2 * PB + 2, NPHASE = 1 + 2 * PH_PER_LAYER;

__global__ void __launch_bounds__(NWAVES * 64, 2) fwd_kernel(Args args) {
    extern __shared__ __attribute__((aligned(16))) unsigned char lds_raw[];
    Ctx F;
    F.lds = (LAS unsigned char*)lds_raw;
    const int ph_lo = args.ph_lo, ph_hi = args.ph_hi;
    if (ph_hi < 0) cg::this_grid().sync();
    volatile LAS unsigned* bst = (volatile LAS unsigned*)(F.lds + LDS_BYTES - 64);
    if (threadIdx.x < 16) bst[threadIdx.x] = 0u;
    __syncthreads();
    XcdBarrier gbar = xcd_barrier_post((unsigned*)(args.ws + WS_BAR), bst);
    if (ph_lo == 0) { KArgs* ap = (KArgs*)__builtin_amdgcn_kernarg_segment_ptr(); asm volatile("" : "+s"(ap)); F.ap = ap; F.tid = threadIdx.x; F.G = gridDim.x; rope_table(F); }
#pragma unroll 1
    for (int ph = ph_lo; ph < ph_hi; ++ph) {
        if (ph > ph_lo) { XcdBarrier gb = gbar; asm volatile("" : "+s"(gb.bar), "+s"(gb.x)); xcd_barrier(gb); }
        { KArgs* ap = (KArgs*)__builtin_amdgcn_kernarg_segment_ptr(); asm volatile("" : "+s"(ap)); F.ap = ap;
          int tid = threadIdx.x; asm volatile("" : "+v"(tid)); F.tid = tid; F.lane = tid & 63; F.wave = __builtin_amdgcn_readfirstlane(tid >> 6);
          int G = gridDim.x; asm volatile("" : "+s"(G)); F.G = G; }
        int bid = blockIdx.x; asm volatile("" : "+s"(bid));
        if (ph == 0) { prep_phase(F, 0); continue; }
        const int l = (ph - 1) / PH_PER_LAYER, r = (ph - 1) % PH_PER_LAYER;
        if (r == 2 * PB + 1) { prep_phase(F, l + 1); continue; }
        const int b = r / PB, k = r % PB;
        const bool is_out = (r == 2 * PB);
        if (!is_out) {
            if (k == 1) {
                for (int it = bid; it < NCH * 8; it += F.G) hgrn_local_item(F, l, it >> 3, it & 7);
                { int tid = threadIdx.x; asm volatile("" : "+v"(tid)); F.tid = tid; F.lane = tid & 63; F.wave = __builtin_amdgcn_readfirstlane(tid >> 6); }
                for (int it = bid; it < NCH * 8; it += F.G) ret_local_item(F, it >> 3, it & 7);
            } else if (k == 2) {
                if (bid < 64) chain_seg_item<0, 0>(F, bid >> 3, bid & 7); else if (bid < 192) chain_seg_item<1, 0>(F, (bid - 64) >> 3, (bid - 64) & 7);
                else rwkv_code_pass(F, l, bid - 192, 64);
            } else if (k == 3) {
                for (int it = bid; it < NCH * 16; it += F.G) rwkv_local_item(F, l, it >> 4, it & 15);
            } else if (k == 4) {
                if (bid < 64) chain_seg_item<0, 1>(F, bid >> 3, bid & 7); else if (bid < 192) chain_seg_item<1, 1>(F, (bid - 64) >> 3, (bid - 64) & 7);
                else { rwkv_seg_item<0>(F, (bid - 192) >> 2, GSEG * ((bid - 192) & 3)); __syncthreads(); }
            } else if (k == 5) { if (bid < 16 * NSEGC) rwkv_seg_item<1>(F, bid >> 4, bid & 15); }
            else if (k == 7) norm_phase(F, l);
        }
        const bool xg4 = !is_out && k == 4 && bid >= 192, xg2 = !is_out && k == 2 && bid >= 192 && b == 1;
        const bool is_gemm = is_out || k == 0 || k == 6 || k == 8 || xg4 || xg2;
        if (is_gemm) {
            if (xg2) __syncthreads();
            const int nsub = (!is_out && (k == 8 || (xg4 && b == 0))) ? 2 : 1;
#pragma unroll 1
            for (int sub = 0; sub < nsub; ++sub) {
                pg8::Gemm g; pg8::StaticOrder S; EpiAny E; E.l = l; E.b = b; E.s = 0; E.gcol = 0;
                if (is_out) {
                    g = pg8::Gemm{F.mixbf(), F.WoutT(), 1024, 1024, 1024}; S.init(MTOK, DM, F.G, bid); E.kind = 5;
                } else if (k == 0) {
                    g = pg8::Gemm{F.xg() + (size_t)b * SEQ * DM, F.WinT(), 1024, 1024, 1024}; S.init(SEQ, b == 1 ? 40 * 256 : LDE, F.G, bid); E.kind = 0;
                } else if (k == 6) {
                    g = pg8::Gemm{F.xg() + (size_t)b * SEQ * DM, F.WinT() + (size_t)LDE * DM, 1024, 1024, 1024}; S.init(SEQ, LDL, F.G, bid); E.kind = 1;
                } else if (k == 4 && sub == 0) {
                    g = pg8::Gemm{F.xg() + (size_t)b * SEQ * DM, F.WinT() + (size_t)(LDE + LDL) * DM, 1024, 1024, 1024}; S.init(SEQ, LDLX, 64, bid - 192); E.kind = 6;
                } else if (k == 4) {
                    g = pg8::Gemm{F.xg() + (size_t)(b + 1) * SEQ * DM, F.WinT() + (size_t)(42 * 256) * DM, 1024, 1024, 1024}; S.init(SEQ, 3 * 256, 64, bid - 192); E.kind = 7; E.gcol = 42;
                } else if (k == 2) {
                    g = pg8::Gemm{F.xg() + (size_t)b * SEQ * DM, F.WinT() + (size_t)(40 * 256) * DM, 1024, 1024, 1024}; S.init(SEQ, 2 * 256, 64, bid - 192); E.kind = 7; E.gcol = 40;
                } else {
                    const int sp = bid & 1, seg4 = 2 * sp + sub, koff = 1024 * seg4;
                    g = pg8::Gemm{F.obuf() + koff, F.WcatT() + koff, YW, YW, 1024}; S.init(SEQ, DM, F.G >> 1, bid >> 1); E.kind = 2 + sub; E.s = sp;
                    E.gcol = L_MG + 1024 * (seg4 == 0 ? 0 : (seg4 == 3 ? 2 : 1));
                }
                pg8::gemm_phase<EpiAny, pg8::StaticOrder>(F.lds, g, S, E);
            }
        }
    }
}

extern "C" void kernel_launch(void* const* d_in, const int* in_sizes, int n_in, void* d_out, int out_size, void* d_ws, size_t ws_size, hipStream_t stream) {
    static int grid = 0;
    if (grid == 0) {
        if (n_in != 22 || in_sizes[0] != MTOK * DM || out_size != MTOK * DM || ws_size < WS_END) { fprintf(stderr, "kernel_launch: unexpected problem (n_in %d, in0 %d, out %d, ws %zu)\n", n_in, n_in > 0 ? in_sizes[0] : -1, out_size, ws_size); grid = -1; return; }
        int dev = 0, cus = 0, per_cu = 0;
        if (hipGetDevice(&dev) != hipSuccess || hipDeviceGetAttribute(&cus, hipDeviceAttributeMultiprocessorCount, dev) != hipSuccess) { grid = -1; return; }
        if (hipFuncSetAttribute((const void*)fwd_kernel, hipFuncAttributeMaxDynamicSharedMemorySize, LDS_BYTES) != hipSuccess) { fprintf(stderr, "kernel_launch: hipFuncSetAttribute failed\n"); grid = -1; return; }
        if (hipOccupancyMaxActiveBlocksPerMultiprocessor(&per_cu, (const void*)fwd_kernel, NWAVES * 64, LDS_BYTES) != hipSuccess || per_cu < 1) { fprintf(stderr, "kernel_launch: occupancy query says %d blocks per CU\n", per_cu); (void)hipGetLastError(); grid = -1; return; }
        if (cus < 256) { fprintf(stderr, "kernel_launch: this build deals the segment items one per workgroup and needs 256 CUs (found %d)\n", cus); grid = -1; return; }
        grid = 256;
    }
    if (grid < 0) return;
    if (hipMemsetAsync((char*)d_ws + WS_CTL, 0, CTL_ZERO_BYTES, stream) != hipSuccess) { fprintf(stderr, "kernel_launch: hipMemsetAsync failed\n"); return; }
    Args a{};
    for (int i = 0; i < 22; ++i) a.in[i] = (const float*)d_in[i];
    a.out = (float*)d_out; a.ws = (unsigned char*)d_ws;
    a.ph_lo = 0; a.ph_hi = NPHASE;
    void* kargs[] = {&a};
    hipError_t e = hipLaunchCooperativeKernel((const void*)fwd_kernel, dim3(grid), dim3(NWAVES * 64), kargs, LDS_BYTES, stream);
    if (e != hipSuccess) fprintf(stderr, "kernel_launch: cooperative launch failed: %s (grid %d)\n", hipGetErrorString(e), grid);
}
```

```cpp
#include <hip/hip_runtime.h>
#include <hip/hip_cooperative_groups.h>
#include <cstdio>
#include <cstdint>
namespace cg = cooperative_groups;

#define LAS __attribute__((address_space(3)))
#define GAS __attribute__((address_space(1)))
typedef unsigned short bf16_t;
typedef short bf16x8 __attribute__((ext_vector_type(8)));
typedef float f32x4 __attribute__((ext_vector_type(4)));
typedef float f32x2 __attribute__((ext_vector_type(2)));
typedef unsigned u32x4 __attribute__((ext_vector_type(4)));
typedef unsigned u32x2 __attribute__((ext_vector_type(2)));

constexpr int DM = 1024, NB = 2, SEQ = 8192, MTOK = NB * SEQ, DEPTH = 2;
constexpr int NIN = 18688;
constexpr int LDE = 11520, LDL = 6144, LDLX = 1024;
constexpr int LDEAB = 8192, LDEC = 3328;
constexpr int E_AQ = 0, E_AFF = 1024, E_AFB = 2048, E_AI = 3072, E_BQ = 4096, E_BK = 5120, E_BV = 6144, E_CS = 8192;
constexpr int L_AG = 0, L_BG = 1024, L_CG = 3072, L_MG = 4096;
constexpr int CSHIFT = 3328;
constexpr int YW = 4096;

__device__ __forceinline__ float bf2f(bf16_t h) { return __uint_as_float((unsigned)h << 16); }
typedef __bf16 bf16x2_t __attribute__((ext_vector_type(2)));
__device__ __forceinline__ unsigned pk2(float lo, float hi) { const f32x2 v = {lo, hi}; return __builtin_bit_cast(unsigned, __builtin_convertvector(v, bf16x2_t)); }
__device__ __forceinline__ unsigned f2bf(float f) { return pk2(f, 0.f) & 0xffffu; }
__device__ __forceinline__ float sigmoidf_(float x) { return __builtin_amdgcn_rcpf(1.0f + __builtin_amdgcn_exp2f(-1.4426950408889634f * x)); }
__device__ __forceinline__ float siluf_(float x) { return x * sigmoidf_(x); }
__device__ __forceinline__ float row_sum16(float v) {
    v += __int_as_float(__builtin_amdgcn_update_dpp(0, __float_as_int(v), 0xB1, 0xf, 0xf, false));
    v += __int_as_float(__builtin_amdgcn_update_dpp(0, __float_as_int(v), 0x4E, 0xf, 0xf, false));
    v += __int_as_float(__builtin_amdgcn_update_dpp(0, __float_as_int(v), 0x141, 0xf, 0xf, false));
    v += __int_as_float(__builtin_amdgcn_update_dpp(0, __float_as_int(v), 0x140, 0xf, 0xf, false));
    return v;
}
__device__ __forceinline__ float row_sum8(float v) {
    v += __int_as_float(__builtin_amdgcn_update_dpp(0, __float_as_int(v), 0xB1, 0xf, 0xf, false));
    v += __int_as_float(__builtin_amdgcn_update_dpp(0, __float_as_int(v), 0x4E, 0xf, 0xf, false));
    v += __int_as_float(__builtin_amdgcn_update_dpp(0, __float_as_int(v), 0x141, 0xf, 0xf, false));
    return v;
}
__device__ __forceinline__ float wave_sum(float v) {
    v = row_sum16(v);
    return __uint_as_float((unsigned)__builtin_amdgcn_readlane((int)__float_as_uint(v), 0)) + __uint_as_float((unsigned)__builtin_amdgcn_readlane((int)__float_as_uint(v), 16))
         + __uint_as_float((unsigned)__builtin_amdgcn_readlane((int)__float_as_uint(v), 32)) + __uint_as_float((unsigned)__builtin_amdgcn_readlane((int)__float_as_uint(v), 48));
}
__device__ __forceinline__ float multi_sum8(const float (&v)[8], int lane) {
    const bool sA = ((lane ^ (lane >> 2)) & 1) != 0, sB = (((lane >> 1) ^ (lane >> 2)) & 1) != 0, sC = (lane & 4) != 0;
    float w[4], x[2];
#pragma unroll
    for (int i = 0; i < 4; ++i) { const float keep = sA ? v[2 * i + 1] : v[2 * i], give = sA ? v[2 * i] : v[2 * i + 1];
        w[i] = keep + __int_as_float(__builtin_amdgcn_update_dpp(0, __float_as_int(give), 0xB1, 0xf, 0xf, false)); }
#pragma unroll
    for (int i = 0; i < 2; ++i) { const float keep = sB ? w[2 * i + 1] : w[2 * i], give = sB ? w[2 * i] : w[2 * i + 1];
        x[i] = keep + __int_as_float(__builtin_amdgcn_update_dpp(0, __float_as_int(give), 0x4E, 0xf, 0xf, false)); }
    float y;
    { const float keep = sC ? x[1] : x[0], give = sC ? x[0] : x[1]; y = keep + __int_as_float(__builtin_amdgcn_update_dpp(0, __float_as_int(give), 0x141, 0xf, 0xf, false)); }
    y += __int_as_float(__builtin_amdgcn_update_dpp(0, __float_as_int(y), 0x128, 0xf, 0xf, false));
    { const auto r = __builtin_amdgcn_permlane16_swap(__float_as_uint(y), __float_as_uint(y), false, false); y = __uint_as_float(r[0]) + __uint_as_float(r[1]); }
    { const auto r = __builtin_amdgcn_permlane32_swap(__float_as_uint(y), __float_as_uint(y), false, false); y = __uint_as_float(r[0]) + __uint_as_float(r[1]); }
    return y;
}
__device__ __forceinline__ constexpr int ms8_lane(int i) { return i < 4 ? i : 11 - i; }
__device__ __forceinline__ int ms8_index(int lane) { return (lane & 4) ? 11 - (lane & 7) : (lane & 7); }
__device__ __forceinline__ float rlf(float x, int k) { return __uint_as_float((unsigned)__builtin_amdgcn_readlane((int)__float_as_uint(x), k)); }
__device__ __forceinline__ f32x4 mfma16(bf16x8 a, bf16x8 b, f32x4 c) { return __builtin_amdgcn_mfma_f32_16x16x32_bf16(a, b, c, 0, 0, 0); }
#define LDS_BARRIER() do { asm volatile("s_waitcnt lgkmcnt(0)" ::: "memory"); __builtin_amdgcn_s_barrier(); asm volatile("" ::: "memory"); } while (0)
namespace pg8 {
constexpr int BM = 256, BK = 64, HALF = 128, HTB = HALF * BK * 2  , STAGE_BYTES = 8 * HTB, NXCD = 8, WGM = 8;

__host__ __device__ __forceinline__ int lds_byte(int r, int c) { const int st = (r >> 4) * 2 + (c >> 5), rr = r & 15, cc = c & 31, ob = rr * 64 + cc * 2; return st * 1024 + (ob ^ (((ob >> 9) & 1) << 5)); }
__host__ __device__ __forceinline__ void stage_rc(int b, int& R, int& C) { const int st = b / 1024, sb = b % 1024, swz = sb ^ (((sb >> 9) & 1) << 5); R = (st >> 1) * 16 + swz / 64; C = (st & 1) * 32 + (swz % 64) / 2; }
__host__ __device__ __forceinline__ int perm32(int rho) { const int n = rho >> 4, i = rho & 15; return 8 * (i >> 2) + 4 * n + (i & 3); }

struct Unit { int pm, pn; };
struct Gemm { const bf16_t* A; const bf16_t* Bt; int lda, ldb, K; };

struct StaticOrder {
    int nM, nN, nwg, G, c;
    __host__ __device__ void init(int M, int N, int G_, int c_) { nM = M / BM; nN = N / BM; nwg = nM * nN; G = G_; c = c_; }
    __host__ __device__ bool next(int i, Unit& u) const {
        const long L = (long)i * G + c; if (L >= nwg) return false;
        int wgid = (int)L; { const int q = nwg / NXCD, r = nwg % NXCD, xcd = wgid % NXCD, off = wgid / NXCD; wgid = (xcd < r ? xcd * (q + 1) : r * (q + 1) + (xcd - r) * q) + off; }
        const int nig = WGM * nN, gid = wgid / nig, fm = gid * WGM, gsz = (nM - fm) < WGM ? (nM - fm) : WGM;
        u.pm = fm + ((wgid % nig) % gsz); u.pn = (wgid % nig) / gsz; return true;
    }
};

__device__ __forceinline__ unsigned cvt_pk_bf16(float lo, float hi) { unsigned r; asm volatile("v_cvt_pk_bf16_f32 %0, %1, %2" : "=v"(r) : "v"(lo), "v"(hi)); return r; }

template <class Epi, class Sched>
__device__ __forceinline__ void gemm_phase(LAS unsigned char* lds, const Gemm g, const Sched& S, const Epi& E) {
    int tid = threadIdx.x; asm volatile("" : "+v"(tid));
    const int wid = __builtin_amdgcn_readfirstlane(tid >> 6), lane = tid & 63, wr = wid >> 2, wc = wid & 3, fr = lane & 15, fq = lane >> 4;
    const int nt = g.K / BK;
    unsigned voffA[2], voffB[2];
#pragma unroll
    for (int i = 0; i < 2; ++i) { int R, C; stage_rc(tid * 16 + i * 8192, R, C); const int Rb = (R & ~31) + perm32(R & 31);
        voffA[i] = (unsigned)(R * g.lda + C) * 2u; voffB[i] = (unsigned)(Rb * g.ldb + C) * 2u; }
    const size_t kstep = (size_t)(BK * 2);
    const size_t hsA = (size_t)HALF * g.lda * 2, hsB = (size_t)HALF * g.ldb * 2;
    const size_t tsA = 2 * hsA, tsB = 2 * hsB;
    const unsigned ldsw = (unsigned)wid * 1024u;
    const int aoff = lds_byte(wr * 64 + fr, fq * 8), boff = lds_byte(wc * 32 + fr, fq * 8);
#define PG8_SA(b, h) (((b) * 2 + (h)) * HTB)
#define PG8_SB(b, h) ((4 + (b) * 2 + (h)) * HTB)
#define PG8_STAGE(bufoff, gbase, voff) do { _Pragma("unroll") for (int _i = 0; _i < 2; ++_i) \
        __builtin_amdgcn_global_load_lds((const unsigned*)((const char*)(gbase) + (voff)[_i]), (LAS unsigned*)(lds + (bufoff) + ldsw + _i * 8192), 16, 0, 0); } while (0)
#define PG8_LDA(dst, b, h) do { _Pragma("unroll") for (int m = 0; m < 4; ++m) _Pragma("unroll") for (int k = 0; k < 2; ++k) dst[m][k] = *(const LAS bf16x8*)(lds + PG8_SA(b, h) + aoff + m * 2048 + k * 1024); } while (0)
#define PG8_LDB(dst, b, h) do { _Pragma("unroll") for (int n = 0; n < 2; ++n) _Pragma("unroll") for (int k = 0; k < 2; ++k) dst[n][k] = *(const LAS bf16x8*)(lds + PG8_SB(b, h) + boff + n * 2048 + k * 1024); } while (0)
#define PG8_MMA(ai, bj, At, Bt) do { __builtin_amdgcn_s_setprio(1); _Pragma("unroll") for (int m = 0; m < 4; ++m) _Pragma("unroll") for (int n = 0; n < 2; ++n) _Pragma("unroll") for (int k = 0; k < 2; ++k) \
        acc[ai][bj][m][n] = __builtin_amdgcn_mfma_f32_16x16x32_bf16(Bt[n][k], At[m][k], acc[ai][bj][m][n], 0, 0, 0); __builtin_amdgcn_s_setprio(0); } while (0)
#define PG8_WAIT_V(n) asm volatile("s_waitcnt vmcnt(" #n ")" ::: "memory")
#define PG8_WAIT_L(n) asm volatile("s_waitcnt lgkmcnt(" #n ")" ::: "memory")
#define PG8_BAR __builtin_amdgcn_s_barrier()
#define PG8_SCHED __builtin_amdgcn_sched_barrier(0)
    Unit cur, nxt; int ui = 0;
    if (!S.next(0, cur)) return;
    f32x4 acc[2][2][4][2];
#pragma unroll
    for (int a = 0; a < 2; ++a)
#pragma unroll
        for (int b = 0; b < 2; ++b)
#pragma unroll
            for (int m = 0; m < 4; ++m)
#pragma unroll
                for (int n = 0; n < 2; ++n) acc[a][b][m][n] = (f32x4){0.f, 0.f, 0.f, 0.f};
    bf16x8 At[4][2], B0[2][2], B1[2][2];
    const char* cA = (const char*)g.A + (size_t)cur.pm * tsA; const char* cB = (const char*)g.Bt + (size_t)cur.pn * tsB;
    PG8_STAGE(PG8_SB(0, 0), cB, voffB); PG8_STAGE(PG8_SB(0, 1), cB + hsB, voffB); PG8_STAGE(PG8_SA(0, 0), cA, voffA); PG8_STAGE(PG8_SA(0, 1), cA + hsA, voffA);
    if (wr == 1) PG8_BAR;
    PG8_WAIT_V(2); PG8_BAR;
    PG8_STAGE(PG8_SB(1, 0), cB + kstep, voffB); PG8_STAGE(PG8_SA(1, 0), cA + kstep, voffA); PG8_STAGE(PG8_SB(1, 1), cB + hsB + kstep, voffB);
    PG8_WAIT_V(6); PG8_BAR;
    for (;;) {
        const bool has_next = S.next(ui + 1, nxt);
        const char* nA = has_next ? (const char*)g.A + (size_t)nxt.pm * tsA : cA; const char* nB = has_next ? (const char*)g.Bt + (size_t)nxt.pn * tsB : cB;
        for (int t = 0; t < nt; t += 2) {
            const bool last = (t == nt - 2);
            const char* a1 = cA + (size_t)(t + 1) * kstep;
            const char* a2 = last ? nA : cA + (size_t)(t + 2) * kstep; const char* b2 = last ? nB : cB + (size_t)(t + 2) * kstep;
            const char* a3 = a2 + kstep; const char* b3 = b2 + kstep;
            PG8_LDB(B0, 0, 0); PG8_LDB(B1, 0, 1); PG8_SCHED; PG8_LDA(At, 0, 0); PG8_STAGE(PG8_SA(1, 1), a1 + hsA, voffA);
            PG8_WAIT_V(8); PG8_WAIT_L(0); PG8_BAR; PG8_MMA(0, 0, At, B0); PG8_MMA(0, 1, At, B1); PG8_BAR; PG8_SCHED;
            PG8_LDA(At, 0, 1); PG8_STAGE(PG8_SB(0, 0), b2, voffB); PG8_STAGE(PG8_SB(0, 1), b2 + hsB, voffB); PG8_STAGE(PG8_SA(0, 0), a2, voffA);
            PG8_WAIT_V(8); PG8_WAIT_L(0); PG8_BAR; PG8_MMA(1, 0, At, B0); PG8_MMA(1, 1, At, B1); PG8_BAR; PG8_SCHED;
            PG8_LDB(B0, 1, 0); PG8_LDB(B1, 1, 1); PG8_SCHED; PG8_LDA(At, 1, 0); PG8_STAGE(PG8_SA(0, 1), a2 + hsA, voffA);
            PG8_WAIT_V(8); PG8_WAIT_L(0); PG8_BAR; PG8_MMA(0, 0, At, B0); PG8_MMA(0, 1, At, B1); PG8_BAR; PG8_SCHED;
            PG8_LDA(At, 1, 1); PG8_STAGE(PG8_SB(1, 0), b3, voffB); PG8_STAGE(PG8_SB(1, 1), b3 + hsB, voffB); PG8_STAGE(PG8_SA(1, 0), a3, voffA);
            PG8_WAIT_V(8); PG8_WAIT_L(0); PG8_BAR; PG8_MMA(1, 0, At, B0); PG8_MMA(1, 1, At, B1); PG8_BAR; PG8_SCHED;
        }
        if (wr == 0) PG8_BAR;
        E(acc, cur, wr, wc, fr, fq);
        if (!has_next) break;
#pragma unroll
        for (int a = 0; a < 2; ++a)
#pragma unroll
            for (int b = 0; b < 2; ++b)
#pragma unroll
                for (int m = 0; m < 4; ++m)
#pragma unroll
                    for (int n = 0; n < 2; ++n) acc[a][b][m][n] = (f32x4){0.f, 0.f, 0.f, 0.f};
        cur = nxt; cA = nA; cB = nB; ++ui;
        if (wr == 1) PG8_BAR;
    }
    PG8_WAIT_V(0);
    PG8_BAR;
#undef PG8_SA
#undef PG8_SB
#undef PG8_STAGE
#undef PG8_LDA
#undef PG8_LDB
#undef PG8_MMA
#undef PG8_WAIT_V
#undef PG8_WAIT_L
#undef PG8_BAR
#undef PG8_SCHED
}
}
struct EpiProj {
    bf16_t* O; int ldc; int silu_lo, silu_hi, sig_lo;
    __device__ __forceinline__ void operator()(const f32x4 (&acc)[2][2][4][2], const pg8::Unit& u, int wr, int wc, int fr, int fq) const {
        const int pn = u.pn;
        const int act = (pn >= silu_lo && pn < silu_hi) ? 1 : (pn >= sig_lo ? 2 : 0);
        const int row0 = u.pm * 256 + wr * 64 + fr, col0 = pn * 256 + wc * 32 + 8 * fq;
#pragma unroll
        for (int ai = 0; ai < 2; ++ai)
#pragma unroll
            for (int m = 0; m < 4; ++m) {
                const int row = row0 + ai * 128 + m * 16; bf16_t* rowp = O + (size_t)row * ldc + col0;
#pragma unroll
                for (int bj = 0; bj < 2; ++bj) {
                    float v[8];
#pragma unroll
                    for (int j = 0; j < 4; ++j) { v[j] = acc[ai][bj][m][0][j]; v[4 + j] = acc[ai][bj][m][1][j]; }
                    if (act == 1) {
#pragma unroll
                        for (int j = 0; j < 8; ++j) v[j] = siluf_(v[j]);
                    } else if (act == 2) {
#pragma unroll
                        for (int j = 0; j < 8; ++j) v[j] = sigmoidf_(v[j]);
                    }
                    u32x4 w; w.x = pg8::cvt_pk_bf16(v[0], v[1]); w.y = pg8::cvt_pk_bf16(v[2], v[3]); w.z = pg8::cvt_pk_bf16(v[4], v[5]); w.w = pg8::cvt_pk_bf16(v[6], v[7]);
                    *(u32x4*)(rowp + bj * 128) = w;
                }
            }
    }
};
template <int KIND> struct EpiMix {
    const bf16_t* gate; int ldg; float* part; bf16_t* outbf;
    __device__ __forceinline__ void operator()(const f32x4 (&acc)[2][2][4][2], const pg8::Unit& u, int wr, int wc, int fr, int fq) const {
        const int row0 = u.pm * 256 + wr * 64 + fr, col0 = u.pn * 256 + wc * 32 + 8 * fq;
#pragma unroll
        for (int ai = 0; ai < 2; ++ai)
#pragma unroll
            for (int m = 0; m < 4; ++m) {
                const int row = row0 + ai * 128 + m * 16;
#pragma unroll
                for (int bj = 0; bj < 2; ++bj) {
                    const int col = col0 + bj * 128;
                    const u32x4 gw = *(const u32x4*)(gate + (size_t)row * ldg + col);
                    float gv[8]; gv[0] = __uint_as_float(gw.x << 16); gv[1] = __uint_as_float(gw.x & 0xffff0000u); gv[2] = __uint_as_float(gw.y << 16); gv[3] = __uint_as_float(gw.y & 0xffff0000u);
                    gv[4] = __uint_as_float(gw.z << 16); gv[5] = __uint_as_float(gw.z & 0xffff0000u); gv[6] = __uint_as_float(gw.w << 16); gv[7] = __uint_as_float(gw.w & 0xffff0000u);
                    float* pp = part + (size_t)row * 1024 + col;
                    f32x4 p0 = (f32x4){0.f, 0.f, 0.f, 0.f}, p1 = p0;
                    if (KIND != 0) { p0 = *(const f32x4*)pp; p1 = *(const f32x4*)(pp + 4); }
#pragma unroll
                    for (int j = 0; j < 4; ++j) { p0[j] += gv[j] * acc[ai][bj][m][0][j]; p1[j] += gv[4 + j] * acc[ai][bj][m][1][j]; }
                    if (KIND != 2) { *(f32x4*)pp = p0; *(f32x4*)(pp + 4) = p1; }
                    else { u32x4 w; w.x = pg8::cvt_pk_bf16(p0[0], p0[1]); w.y = pg8::cvt_pk_bf16(p0[2], p0[3]); w.z = pg8::cvt_pk_bf16(p1[0], p1[1]); w.w = pg8::cvt_pk_bf16(p1[2], p1[3]);
                        *(u32x4*)(outbf + (size_t)row * 1024 + col) = w; }
                }
            }
    }
};
struct EpiOut {
    const float* base; float* out;
    __device__ __forceinline__ void operator()(const f32x4 (&acc)[2][2][4][2], const pg8::Unit& u, int wr, int wc, int fr, int fq) const {
        const int row0 = u.pm * 256 + wr * 64 + fr, col0 = u.pn * 256 + wc * 32 + 8 * fq;
#pragma unroll
        for (int ai = 0; ai < 2; ++ai)
#pragma unroll
            for (int mp = 0; mp < 2; ++mp) {
                f32x4 bv[2][2][2];
#pragma unroll
                for (int mi = 0; mi < 2; ++mi)
#pragma unroll
                    for (int bj = 0; bj < 2; ++bj) { const size_t off = (size_t)(row0 + ai * 128 + (2 * mp + mi) * 16) * 1024 + col0 + bj * 128;
                        bv[mi][bj][0] = *(const f32x4*)(base + off); bv[mi][bj][1] = *(const f32x4*)(base + off + 4); }
#pragma unroll
                for (int mi = 0; mi < 2; ++mi)
#pragma unroll
                    for (int bj = 0; bj < 2; ++bj) { const int m = 2 * mp + mi; const size_t off = (size_t)(row0 + ai * 128 + m * 16) * 1024 + col0 + bj * 128;
                        *(f32x4*)(out + off) = bv[mi][bj][0] + acc[ai][bj][m][0]; *(f32x4*)(out + off + 4) = bv[mi][bj][1] + acc[ai][bj][m][1]; }
            }
    }
};

constexpr size_t MiB = 1u << 20;
constexpr size_t WS_CTL = 0, WS_ROPE = 1 * MiB, WS_RSTD = 5 * MiB, WS_LWT = 5 * MiB + 128 * 1024  , WS_WIN = 6 * MiB, WS_WCAT = 43 * MiB, WS_WOUT = 51 * MiB, WS_XG = 53 * MiB, WS_MIXBF = 85 * MiB,
                 WS_EAB = 117 * MiB, WS_EC = 245 * MiB, WS_L = 117 * MiB  , WS_OBUF = 297 * MiB,
                 WS_QTA = 361 * MiB, WS_KTA = 393 * MiB, WS_VTA = 425 * MiB, WS_DA = 441 * MiB, WS_QTB = 442 * MiB, WS_KTB = 474 * MiB, WS_VTB = 506 * MiB, WS_SLOC = 538 * MiB, WS_DSEG = 562 * MiB, WS_CSEG = 563 * MiB, WS_CMSEG = 571 * MiB, WS_END = 583 * MiB,
                 WS_RH = 117 * MiB, WS_MI = 149 * MiB, WS_NI = 181 * MiB  ,
                 WS_SV = 458 * MiB, WS_BONS = 490 * MiB  , WS_LX = 213 * MiB  , WS_CODE = 213 * MiB  , WS_PIA = 491 * MiB, WS_PIB = 575 * MiB  , WS_PART = 361 * MiB;
static_assert(WS_WIN + (size_t)NIN * DM * 2 <= WS_WCAT && WS_EAB + (size_t)SEQ * LDEAB * 2 <= WS_EC && WS_EC + (size_t)SEQ * LDEC * 2 <= WS_OBUF && WS_NI + 32 * MiB <= WS_EC && WS_END <= 584 * MiB, "d_ws map");
constexpr size_t WS_BAR = 4096, CTL_ZERO_BYTES = 65536;
constexpr int LDS_BYTES = 147456;
constexpr int NWAVES = 8;

struct Args {
    const float* in[22]; float* out; unsigned char* ws; int ph_lo, ph_hi;
};
typedef const __attribute__((address_space(4))) Args KArgs;
struct Ctx {
    LAS unsigned char* lds; int tid, lane, wave, G; KArgs* ap;
    __device__ __forceinline__ const float* in(int i) const { return ap->in[i]; }
    __device__ __forceinline__ float* out() const { return ap->out; }
    __device__ __forceinline__ unsigned char* ws() const { return ap->ws; }
    __device__ __forceinline__ f32x2* rope() const { return (f32x2*)(ap->ws + WS_ROPE); }
    __device__ __forceinline__ bf16_t* lwt() const { return (bf16_t*)(ap->ws + WS_LWT); }
    __device__ __forceinline__ float* rstd() const { return (float*)(ap->ws + WS_RSTD); }
    __device__ __forceinline__ float* part() const { return (float*)(ap->ws + WS_PART); }
    __device__ __forceinline__ bf16_t* WinT() const { return (bf16_t*)(ap->ws + WS_WIN); }
    __device__ __forceinline__ bf16_t* WcatT() const { return (bf16_t*)(ap->ws + WS_WCAT); }
    __device__ __forceinline__ bf16_t* WoutT() const { return (bf16_t*)(ap->ws + WS_WOUT); }
    __device__ __forceinline__ bf16_t* xg() const { return (bf16_t*)(ap->ws + WS_XG); }
    __device__ __forceinline__ bf16_t* mixbf() const { return (bf16_t*)(ap->ws + WS_MIXBF); }
    __device__ __forceinline__ bf16_t* eab() const { return (bf16_t*)(ap->ws + WS_EAB); }
    __device__ __forceinline__ bf16_t* ecb() const { return (bf16_t*)(ap->ws + WS_EC); }
    __device__ __forceinline__ bf16_t* lbuf() const { return (bf16_t*)(ap->ws + WS_L); }
    __device__ __forceinline__ bf16_t* lxbuf() const { return (bf16_t*)(ap->ws + WS_LX); }
    __device__ __forceinline__ bf16_t* qta() const { return (bf16_t*)(ap->ws + WS_QTA); }
    __device__ __forceinline__ bf16_t* kta() const { return (bf16_t*)(ap->ws + WS_KTA); }
    __device__ __forceinline__ bf16_t* vta() const { return (bf16_t*)(ap->ws + WS_VTA); }
    __device__ __forceinline__ float* da() const { return (float*)(ap->ws + WS_DA); }
    __device__ __forceinline__ bf16_t* qtb() const { return (bf16_t*)(ap->ws + WS_QTB); }
    __device__ __forceinline__ bf16_t* ktb() const { return (bf16_t*)(ap->ws + WS_KTB); }
    __device__ __forceinline__ bf16_t* vtb() const { return (bf16_t*)(ap->ws + WS_VTB); }
    __device__ __forceinline__ bf16_t* obuf() const { return (bf16_t*)(ap->ws + WS_OBUF); }
    __device__ __forceinline__ float* sloc() const { return (float*)(ap->ws + WS_SLOC); }
    __device__ __forceinline__ float* dseg() const { return (float*)(ap->ws + WS_DSEG); }
    __device__ __forceinline__ float* cseg() const { return (float*)(ap->ws + WS_CSEG); }
    __device__ __forceinline__ bf16_t* cmseg() const { return (bf16_t*)(ap->ws + WS_CMSEG); }
    __device__ __forceinline__ bf16_t* codeb() const { return (bf16_t*)(ap->ws + WS_CODE); }
    __device__ __forceinline__ bf16_t* pia() const { return (bf16_t*)(ap->ws + WS_PIA); }
    __device__ __forceinline__ bf16_t* pib() const { return (bf16_t*)(ap->ws + WS_PIB); }
    __device__ __forceinline__ bf16_t* rhi() const { return (bf16_t*)(ap->ws + WS_RH); }
    __device__ __forceinline__ bf16_t* mi() const { return (bf16_t*)(ap->ws + WS_MI); }
    __device__ __forceinline__ bf16_t* ni() const { return (bf16_t*)(ap->ws + WS_NI); }
    __device__ __forceinline__ bf16_t* svb() const { return (bf16_t*)(ap->ws + WS_SV); }
    __device__ __forceinline__ float* bons() const { return (float*)(ap->ws + WS_BONS); }
};
#define LDS_WAIT() asm volatile("s_waitcnt lgkmcnt(0)" ::: "memory")

__device__ __forceinline__ int win_row(int n) { return n < 4096 ? n : n < 5120 ? 11520 + (n - 4096) : n < 9216 ? 4096 + (n - 5120) : n < 11264 ? 11520 + 1024 + (n - 9216) : n < 14592 ? 8192 + (n - 11264) : n < 15616 ? 11520 + 3072 + (n - 14592) : 11520 + 4096 + (n - 15616); }
__device__ __forceinline__ void transpose_item(const float* W, int N, bf16_t* WT, int ldt, int koff, LAS float* scr, int item, int lane, bool permin = false) {
    const int nblk = N / 64, kb = item / nblk, nb = item % nblk, k0 = 64 * kb, n0 = 64 * nb; const int r0 = permin ? win_row(n0) : n0;
#pragma unroll
    for (int ih = 0; ih < 2; ++ih) {
        float wv[32];
#pragma unroll
        for (int i = 0; i < 32; ++i) wv[i] = W[(size_t)(k0 + 32 * ih + i) * N + n0 + lane];
#pragma unroll
        for (int i = 0; i < 32; ++i) scr[(32 * ih + i) * 65 + lane] = wv[i];
    }
    LDS_WAIT(); asm volatile("" ::: "memory");
    const int c = lane & 7;
#pragma unroll
    for (int j = 0; j < 8; ++j) { const int n = (lane >> 3) + 8 * j; const LAS float* s = scr + (8 * c) * 65 + n;
        u32x4 o; o.x = pk2(s[0 * 65], s[1 * 65]); o.y = pk2(s[2 * 65], s[3 * 65]); o.z = pk2(s[4 * 65], s[5 * 65]); o.w = pk2(s[6 * 65], s[7 * 65]);
        *(u32x4*)(WT + (size_t)(r0 + n) * ldt + koff + k0 + 8 * c) = o; }
    LDS_WAIT(); asm volatile("" ::: "memory");
}

__device__ __forceinline__ void prep_phase(const Ctx& F, int l) {
    const int gw = blockIdx.x * NWAVES + F.wave, NGW = F.G * NWAVES;
    if (l < 2) {
        LAS float* scr = (LAS float*)(F.lds + F.wave * 16640);
        const float* Win = F.in(2) + (size_t)l * DM * NIN;
        const float* Wa = F.in(17) + (size_t)l * 1024 * 1024; const float* Wb = F.in(18) + (size_t)l * 2048 * 1024; const float* Wc = F.in(19) + (size_t)l * 1024 * 1024; const float* Wo = F.in(20) + (size_t)l * 1024 * 1024;
        constexpr int I_IN = 16 * (NIN / 64), I_A = 16 * 16, I_B = 32 * 16, I_C = 16 * 16, I_O = 16 * 16, I_L = 4 * 16;
        for (int it = gw; it < I_IN + I_A + I_B + I_C + I_O + I_L; it += NGW) {
            int r = it;
            if (r < I_L) { const int gi = r >> 4, kind = gi >> 1, d = gi & 1;
                transpose_item((kind == 0 ? F.in(9) : F.in(11)) + (size_t)(l * 2 + d) * 65536, 1024, F.lwt() + (size_t)gi * 65536, 64, 0, scr, r & 15, F.lane); continue; } r -= I_L;
            if (r < I_IN) { transpose_item(Win, NIN, F.WinT(), 1024, 0, scr, r, F.lane, true); continue; } r -= I_IN;
            if (r < I_A) { transpose_item(Wa, 1024, F.WcatT(), 4096, 0, scr, r, F.lane); continue; } r -= I_A;
            if (r < I_B) { transpose_item(Wb, 1024, F.WcatT(), 4096, 1024, scr, r, F.lane); continue; } r -= I_B;
            if (r < I_C) { transpose_item(Wc, 1024, F.WcatT(), 4096, 3072, scr, r, F.lane); continue; } r -= I_C;
            transpose_item(Wo, 1024, F.WoutT(), 1024, 0, scr, r, F.lane);
        }
    }
    const float* xsrc = (l == 0) ? F.in(0) : F.out();
    const float* gsrc = (l < 2) ? F.in(1) + l * DM : F.in(21);
    f32x4 g4[4];
#pragma unroll
    for (int j = 0; j < 4; ++j) g4[j] = *((const f32x4*)gsrc + F.lane + 64 * j);
    f32x4 v[4];
#pragma unroll
    for (int j = 0; j < 4; ++j) v[j] = *((const f32x4*)(xsrc + (size_t)gw * DM) + F.lane + 64 * j);
    for (int m = gw; m < MTOK; m += NGW) {
        const int mn = m + NGW < MTOK ? m + NGW : m;
        f32x4 nv[4];
#pragma unroll
        for (int j = 0; j < 4; ++j) nv[j] = *((const f32x4*)(xsrc + (size_t)mn * DM) + F.lane + 64 * j);
        float s = 0.f;
#pragma unroll
        for (int j = 0; j < 4; ++j) s += (v[j].x * v[j].x + v[j].y * v[j].y) + (v[j].z * v[j].z + v[j].w * v[j].w);
        float eps_ = 1e-6f; asm volatile("" : "+s"(eps_));
        const float rs = rsqrtf(wave_sum(s) * (1.f / DM) + eps_);
        if (l < 2) {
            unsigned long long* o8 = (unsigned long long*)(F.xg() + (size_t)m * DM) + F.lane;
#pragma unroll
            for (int j = 0; j < 4; ++j) { const f32x4 gg = g4[j] * rs;
                o8[64 * j] = (unsigned long long)pk2(v[j].x * gg.x, v[j].y * gg.y) | ((unsigned long long)pk2(v[j].z * gg.z, v[j].w * gg.w) << 32); }
        } else {
            f32x4* orow = (f32x4*)(F.out() + (size_t)m * DM) + F.lane;
#pragma unroll
            for (int j = 0; j < 4; ++j) orow[64 * j] = v[j] * rs * g4[j];
        }
#pragma unroll
        for (int j = 0; j < 4; ++j) v[j] = nv[j];
    }
}

__device__ __forceinline__ void rope_table(const Ctx& F) {
    for (int idx = blockIdx.x * 512 + F.tid; idx < SEQ * 64; idx += F.G * 512) {
        const int t = idx >> 6, j = idx & 63;
        const float inv = (float)exp2(-(double)(2 * j) * (13.287712379549449 / 128.0));
        const float ang = (float)t * inv;
        const double rev = (double)ang * 0.15915494309189535; const double fr = rev - rint(rev);
        const float x = (float)(fr * 6.283185307179586);
        F.rope()[idx] = (f32x2){cosf(x), sinf(x)};
    }
}
constexpr size_t WS_MIXCNT = 32768;
struct EpiAny {
    int kind, l, b, s, gcol;
    __device__ __forceinline__ bool stores16() const { return kind <= 1; }
    __device__ __forceinline__ void operator()(const f32x4 (&acc)[2][2][4][2], const pg8::Unit& u, int wr, int wc, int fr, int fq) const {
        Ctx F; { KArgs* ap = (KArgs*)__builtin_amdgcn_kernarg_segment_ptr(); asm volatile("" : "+s"(ap)); F.ap = ap; }
        if (kind == 0) {
            if (u.pn < 32) { EpiProj e{F.eab(), LDEAB, 0, 4, 1 << 30}; e(acc, u, wr, wc, fr, fq); }
            else { EpiProj e{F.ecb() - 32 * 256, LDEC, 0, 0, 1 << 30}; e(acc, u, wr, wc, fr, fq); }
        }
        else if (kind == 1) { EpiProj e{F.lbuf(), LDL, 0, 0, 16};     e(acc, u, wr, wc, fr, fq); }
        else if (kind == 7) { EpiProj e{F.ecb() + (gcol - 32) * 256, LDEC, 0, 0, 1 << 30}; e(acc, u, wr, wc, fr, fq); }
        else if (kind == 6) { EpiProj e{F.lxbuf(), LDLX, 0, 0, 0}; e(acc, u, wr, wc, fr, fq); }
        else if (kind == 5) { EpiOut e{l == 0 ? F.in(0) : F.out(), F.out()}; e(acc, u, wr, wc, fr, fq); }
        else {
            const bool gx = gcol >= LDL;
            const bf16_t* gate = gx ? F.lxbuf() : F.lbuf() + gcol; const int ldg = gx ? LDLX : LDL; bf16_t* mine = (bf16_t*)F.part() + (size_t)s * SEQ * DM;
            const int row0 = u.pm * 256 + wr * 64 + fr, col0 = u.pn * 256 + wc * 32 + 8 * fq;
#pragma unroll
            for (int ai = 0; ai < 2; ++ai)
#pragma unroll
                for (int mp = 0; mp < 2; ++mp) {
                    u32x4 gwv[2][2], pwv[2][2];
#pragma unroll
                    for (int mi = 0; mi < 2; ++mi)
#pragma unroll
                        for (int bj = 0; bj < 2; ++bj) { const int row = row0 + ai * 128 + (2 * mp + mi) * 16, col = col0 + bj * 128;
                            gwv[mi][bj] = *(const u32x4*)(gate + (size_t)row * ldg + col);
                            if (kind == 3) pwv[mi][bj] = *(const u32x4*)(mine + (size_t)row * 1024 + col); else pwv[mi][bj] = (u32x4){0u, 0u, 0u, 0u}; }
#pragma unroll
                    for (int mi = 0; mi < 2; ++mi)
#pragma unroll
                        for (int bj = 0; bj < 2; ++bj) { const int m = 2 * mp + mi; const int row = row0 + ai * 128 + m * 16, col = col0 + bj * 128;
                            const u32x4 gw = gwv[mi][bj], pw = pwv[mi][bj];
                            const f32x4 g0 = (f32x4){__uint_as_float(gw.x << 16), __uint_as_float(gw.x & 0xffff0000u), __uint_as_float(gw.y << 16), __uint_as_float(gw.y & 0xffff0000u)};
                            const f32x4 g1 = (f32x4){__uint_as_float(gw.z << 16), __uint_as_float(gw.z & 0xffff0000u), __uint_as_float(gw.w << 16), __uint_as_float(gw.w & 0xffff0000u)};
                            f32x4 p0 = g0 * acc[ai][bj][m][0], p1 = g1 * acc[ai][bj][m][1];
                            p0 += (f32x4){__uint_as_float(pw.x << 16), __uint_as_float(pw.x & 0xffff0000u), __uint_as_float(pw.y << 16), __uint_as_float(pw.y & 0xffff0000u)};
                            p1 += (f32x4){__uint_as_float(pw.z << 16), __uint_as_float(pw.z & 0xffff0000u), __uint_as_float(pw.w << 16), __uint_as_float(pw.w & 0xffff0000u)};
                            u32x4 w; w.x = pg8::cvt_pk_bf16(p0[0], p0[1]); w.y = pg8::cvt_pk_bf16(p0[2], p0[3]); w.z = pg8::cvt_pk_bf16(p1[0], p1[1]); w.w = pg8::cvt_pk_bf16(p1[2], p1[3]);
                            *(u32x4*)(mine + (size_t)row * 1024 + col) = w; }
                }
            if (kind == 3) {
                extern __shared__ __attribute__((aligned(16))) unsigned char lds_dyn[];
                volatile LAS unsigned* flag = (volatile LAS unsigned*)((LAS unsigned char*)lds_dyn + LDS_BYTES - 32);
                asm volatile("s_waitcnt vmcnt(0)" ::: "memory");
                __syncthreads();
                if (threadIdx.x == 0) {
                    unsigned* cnt = (unsigned*)(F.ws() + WS_MIXCNT) + 64 * (u.pm * 4 + u.pn);
                    __builtin_amdgcn_fence(__ATOMIC_RELEASE, "agent");
                    asm volatile("s_waitcnt vmcnt(0)" ::: "memory");
                    const unsigned old = __hip_atomic_fetch_add(cnt, 1u, __ATOMIC_RELAXED, __HIP_MEMORY_SCOPE_AGENT);
                    if (old & 1u) { __builtin_amdgcn_fence(__ATOMIC_ACQUIRE, "agent"); asm volatile("s_waitcnt vmcnt(0)" ::: "memory"); }
                    flag[0] = old & 1u;
                }
                __syncthreads();
                if (flag[0]) {
                    const bf16_t* other = (const bf16_t*)F.part() + (size_t)(1 - s) * SEQ * DM; bf16_t* outbf = F.mixbf() + (size_t)b * SEQ * DM;
#pragma unroll
                    for (int ai = 0; ai < 2; ++ai)
#pragma unroll
                        for (int mp = 0; mp < 2; ++mp) {
                            u32x4 pwv[2][2], qwv[2][2];
#pragma unroll
                            for (int mi = 0; mi < 2; ++mi)
#pragma unroll
                                for (int bj = 0; bj < 2; ++bj) { const size_t off = (size_t)(row0 + ai * 128 + (2 * mp + mi) * 16) * 1024 + col0 + bj * 128; pwv[mi][bj] = *(const u32x4*)(other + off); qwv[mi][bj] = *(const u32x4*)(mine + off); }
#pragma unroll
                            for (int mi = 0; mi < 2; ++mi)
#pragma unroll
                                for (int bj = 0; bj < 2; ++bj) { const size_t off = (size_t)(row0 + ai * 128 + (2 * mp + mi) * 16) * 1024 + col0 + bj * 128; const u32x4 pw = pwv[mi][bj], qw = qwv[mi][bj];
                                    const f32x4 a0 = (f32x4){__uint_as_float(qw.x << 16), __uint_as_float(qw.x & 0xffff0000u), __uint_as_float(qw.y << 16), __uint_as_float(qw.y & 0xffff0000u)} + (f32x4){__uint_as_float(pw.x << 16), __uint_as_float(pw.x & 0xffff0000u), __uint_as_float(pw.y << 16), __uint_as_float(pw.y & 0xffff0000u)};
                                    const f32x4 a1 = (f32x4){__uint_as_float(qw.z << 16), __uint_as_float(qw.z & 0xffff0000u), __uint_as_float(qw.w << 16), __uint_as_float(qw.w & 0xffff0000u)} + (f32x4){__uint_as_float(pw.z << 16), __uint_as_float(pw.z & 0xffff0000u), __uint_as_float(pw.w << 16), __uint_as_float(pw.w & 0xffff0000u)};
                                    u32x4 w; w.x = pg8::cvt_pk_bf16(a0[0], a0[1]); w.y = pg8::cvt_pk_bf16(a0[2], a0[3]); w.z = pg8::cvt_pk_bf16(a1[0], a1[1]); w.w = pg8::cvt_pk_bf16(a1[2], a1[3]);
                                    *(u32x4*)(outbf + off) = w; }
                        }
                }
                __syncthreads();
            }
        }
    }
};
#define XB_TMO      128
#define XB_XCNT(j)  (256  + 64 * (j))
#define XB_XSUB(j)  (1280 + 64 * (j))
#define XB_XGEN(j)  (2304 + 64 * (j))
#define XB_TOP      3328
#define XB_TOPGEN   3392
#define XCD_BAR_WORDS 3456
#define XB_SPIN_CAP (1u << 18)

__device__ __forceinline__ unsigned xb_ld(unsigned* p)              { return __hip_atomic_load(p, __ATOMIC_RELAXED, __HIP_MEMORY_SCOPE_AGENT); }
__device__ __forceinline__ unsigned xb_add(unsigned* p, unsigned v) { return __hip_atomic_fetch_add(p, v, __ATOMIC_RELAXED, __HIP_MEMORY_SCOPE_AGENT); }
__device__ __forceinline__ unsigned xb_xcc_id() { return (unsigned)__builtin_amdgcn_s_getreg((3 << 11) | 20) & 0xFu; }
#define XB_SPIN(cond, bar) do { unsigned _sp = 0; while (cond) { __builtin_amdgcn_s_sleep(1); \
    if ((++_sp & 255u) == 0u) { if (xb_ld(&(bar)[XB_TMO])) break; if (_sp > XB_SPIN_CAP) { atomicAdd(&(bar)[XB_TMO], 1u); break; } } } } while (0)

struct XcdBarrier {
    unsigned* bar; unsigned x;
    volatile LAS unsigned* st;
};

__device__ __forceinline__ XcdBarrier xcd_barrier_post(unsigned* bar, volatile LAS unsigned* st) {
    XcdBarrier b; b.bar = bar; b.x = xb_xcc_id(); b.st = st;
    if (threadIdx.x == 0) (void)xb_add(&bar[XB_XCNT(b.x)], 1u);
    return b;
}
__device__ __forceinline__ void xcd_barrier_complete(unsigned* bar, unsigned x, unsigned& nloc, unsigned& nx) {
    const unsigned G = gridDim.x * gridDim.y * gridDim.z;
    unsigned sum, cnt, mine, sp = 0u;
    for (;;) {
        sum = 0u; cnt = 0u; mine = 0u;
#pragma unroll
        for (unsigned j = 0; j < 16; ++j) { const unsigned c = xb_ld(&bar[XB_XCNT(j)]); sum += c; cnt += (c > 0u) ? 1u : 0u; mine = (j == x) ? c : mine; }
        if (sum == G) break;
        __builtin_amdgcn_s_sleep(1);
        if ((++sp & 255u) == 0u) { if (xb_ld(&bar[XB_TMO])) break; if (sp > XB_SPIN_CAP) { atomicAdd(&bar[XB_TMO], 1u); break; } }
    }
    nloc = mine > 0u ? mine : 1u; nx = cnt > 0u ? cnt : 1u;
}

__device__ __forceinline__ void xcd_barrier(const XcdBarrier& b) {
    asm volatile("s_waitcnt vmcnt(0)" ::: "memory");
    __syncthreads();
    if (threadIdx.x == 0) {
        unsigned* bar = b.bar;
        __builtin_amdgcn_s_waitcnt(0);
        unsigned nloc = b.st[0], nx = b.st[1];
        if (nloc == 0u) { xcd_barrier_complete(bar, b.x, nloc, nx); b.st[0] = nloc; b.st[1] = nx; }
        const unsigned old = xb_add(&bar[XB_XSUB(b.x)], 1u);
        const unsigned gen = old / nloc;
        if (old + 1u == (gen + 1u) * nloc) {
            __builtin_amdgcn_fence(__ATOMIC_RELEASE, "agent");
            asm volatile("s_waitcnt vmcnt(0)" ::: "memory");
            const unsigned og = xb_add(&bar[XB_TOP], 1u);
            const unsigned tg = og / nx;
            if (og + 1u == (tg + 1u) * nx) xb_add(&bar[XB_TOPGEN], 1u);
            else XB_SPIN(xb_ld(&bar[XB_TOPGEN]) == tg, bar);
            __builtin_amdgcn_fence(__ATOMIC_ACQUIRE, "agent");
            xb_add(&bar[XB_XGEN(b.x)], 1u);
            asm volatile("s_waitcnt vmcnt(0)" ::: "memory");
        } else {
            XB_SPIN(xb_ld(&bar[XB_XGEN(b.x)]) == gen, bar);
            __builtin_amdgcn_fence(__ATOMIC_ACQUIRE, "agent");
            asm volatile("s_waitcnt vmcnt(0)" ::: "memory");
        }
    }
    __syncthreads();
}


constexpr int LQ = 136, LT = 72;
constexpr int NCH = SEQ / 64;
constexpr float LOG2E = 1.4426950408889634f;

__device__ __forceinline__ void hgrn_gate(float x, float lb, float& lf2, float& kv) {
    x = fminf(fmaxf(x, -30.f), 30.f);
    const float e = __builtin_amdgcn_exp2f(-LOG2E * x), r = __builtin_amdgcn_rcpf(1.f + e);
    const float f = fmaxf(lb + (1.f - lb) * r, 1e-6f);
    kv = (1.f - lb) * (e * r); lf2 = __builtin_amdgcn_logf(f);
}
__device__ __forceinline__ float ex2c(float x) { return __builtin_amdgcn_exp2f(fminf(x, 115.f)); }
__device__ __forceinline__ void hgrn_local_item(const Ctx& F, int l, int c, int h) {
    LAS bf16_t* QHF = (LAS bf16_t*)F.lds; LAS bf16_t* KHF = QHF + 64 * LQ; LAS bf16_t* QHB = KHF + 64 * LQ; LAS bf16_t* KHB = QHB + 64 * LQ;
    LAS bf16_t* VTL = KHB + 64 * LQ; LAS bf16_t* PL = VTL + 128 * LT; LAS float* TOT = (LAS float*)(PL + 64 * LT);
    const int lane = F.lane, g = F.wave, ch0 = 2 * lane, t0 = c * 64;
    const bf16_t* rp = F.eab() + (size_t)(t0 + 8 * g) * LDEAB + h * 128 + ch0;
    unsigned qw[8], iw[8]; float lff[8][2], lfb[8][2], kf[8][2], kb[8][2];
    float lbf[2] = {0.f, 0.f}, lbb[2] = {0.f, 0.f};
    {
        unsigned fw[8], bw[8];
#pragma unroll
        for (int jj = 0; jj < 8; ++jj) { const bf16_t* r = rp + (size_t)jj * LDEAB; qw[jj] = *(const unsigned*)(r); fw[jj] = *(const unsigned*)(r + 1024); bw[jj] = *(const unsigned*)(r + 2048); iw[jj] = *(const unsigned*)(r + 3072); }
        { const float* lg = F.in(3); const int c0 = h * 128 + ch0;
          const f32x2 g0 = *(const f32x2*)(lg + c0), g1 = *(const f32x2*)(lg + 1024 + c0), g2 = *(const f32x2*)(lg + 2048 + c0), g3 = *(const f32x2*)(lg + 3072 + c0);
          if (l == 1) { lbf[0] = sigmoidf_(g2.x - g0.x); lbf[1] = sigmoidf_(g2.y - g0.y); lbb[0] = sigmoidf_(g3.x - g1.x); lbb[1] = sigmoidf_(g3.y - g1.y); } }
#pragma unroll
        for (int jj = 0; jj < 8; ++jj) {
            hgrn_gate(__uint_as_float(fw[jj] << 16), lbf[0], lff[jj][0], kf[jj][0]); hgrn_gate(__uint_as_float(fw[jj] & 0xffff0000u), lbf[1], lff[jj][1], kf[jj][1]);
            hgrn_gate(__uint_as_float(bw[jj] << 16), lbb[0], lfb[jj][0], kb[jj][0]); hgrn_gate(__uint_as_float(bw[jj] & 0xffff0000u), lbb[1], lfb[jj][1], kb[jj][1]);
        }
    }
    {
        float sf0 = 0.f, sf1 = 0.f, sb0 = 0.f, sb1 = 0.f;
#pragma unroll
        for (int jj = 0; jj < 8; ++jj) { sf0 += lff[jj][0]; sf1 += lff[jj][1]; sb0 += lfb[jj][0]; sb1 += lfb[jj][1]; }
        *(LAS f32x2*)(TOT + g * 128 + ch0) = (f32x2){sf0, sf1}; *(LAS f32x2*)(TOT + 1024 + g * 128 + ch0) = (f32x2){sb0, sb1};
    }
    LDS_BARRIER();
    float offf[2] = {0.f, 0.f}, b31[2] = {0.f, 0.f}, b63[2] = {0.f, 0.f}, offb[2] = {0.f, 0.f}, pb32[2] = {0.f, 0.f}, totb[2] = {0.f, 0.f};
#pragma unroll
    for (int gg = 0; gg < 8; ++gg) {
        const f32x2 tf = *(const LAS f32x2*)(TOT + gg * 128 + ch0), tb = *(const LAS f32x2*)(TOT + 1024 + gg * 128 + ch0);
#pragma unroll
        for (int e = 0; e < 2; ++e) { const float a = e ? tf.y : tf.x, b = e ? tb.y : tb.x;
            offf[e] += gg < g ? a : 0.f; offb[e] += gg < g ? b : 0.f; if (gg < 4) { b31[e] += a; pb32[e] += b; } b63[e] += a; totb[e] += b; }
    }
    const size_t imgF = ((size_t)(0 * NCH + c) * 8 + h) * 8192, imgB = ((size_t)(1 * NCH + c) * 8 + h) * 8192;
    bf16_t* QTg = F.qta(); bf16_t* KTg = F.kta();
    float runf[2] = {offf[0], offf[1]}, runb[2] = {offb[0], offb[1]};
    unsigned ktf[2][4], ktb[2][4], vtw[2][4];
#pragma unroll
    for (int jj = 0; jj < 8; ++jj) {
        const int t = 8 * g + jj;
        const float q[2] = {__uint_as_float(qw[jj] << 16), __uint_as_float(qw[jj] & 0xffff0000u)};
        float qhf[2], khf[2], qtf[2], ktfv[2], qhb[2], khb[2], qtb[2], ktbv[2];
#pragma unroll
        for (int e = 0; e < 2; ++e) {
            runf[e] += lff[jj][e];
            const float bf = runf[e], xf = bf - b31[e];
            qhf[e] = q[e] * ex2c(xf); khf[e] = kf[jj][e] * ex2c(-xf); qtf[e] = q[e] * __builtin_amdgcn_exp2f(bf); ktfv[e] = kf[jj][e] * __builtin_amdgcn_exp2f(b63[e] - bf);
            const float sb = totb[e] - runb[e];
            runb[e] += lfb[jj][e];
            const float xb = sb - (totb[e] - pb32[e]);
            qhb[e] = q[e] * ex2c(xb); khb[e] = kb[jj][e] * ex2c(-xb); qtb[e] = q[e] * __builtin_amdgcn_exp2f(sb); ktbv[e] = kb[jj][e] * __builtin_amdgcn_exp2f(totb[e] - sb);
        }
        *(LAS unsigned*)(QHF + t * LQ + ch0) = pk2(qhf[0], qhf[1]); *(LAS unsigned*)(KHF + t * LQ + ch0) = pk2(khf[0], khf[1]);
        *(LAS unsigned*)(QHB + t * LQ + ch0) = pk2(qhb[0], qhb[1]); *(LAS unsigned*)(KHB + t * LQ + ch0) = pk2(khb[0], khb[1]);
        *(unsigned*)(QTg + imgF + t * 128 + ch0) = pk2(qtf[0], qtf[1]); *(unsigned*)(QTg + imgB + t * 128 + ch0) = pk2(qtb[0], qtb[1]);
#pragma unroll
        for (int e = 0; e < 2; ++e) {
            const unsigned kfb = f2bf(ktfv[e]), kbb = f2bf(ktbv[e]), vb = e ? (iw[jj] >> 16) : (iw[jj] & 0xffffu);
            if (jj & 1) { ktf[e][jj >> 1] |= kfb << 16; ktb[e][jj >> 1] |= kbb << 16; vtw[e][jj >> 1] |= vb << 16; }
            else { ktf[e][jj >> 1] = kfb; ktb[e][jj >> 1] = kbb; vtw[e][jj >> 1] = vb; }
        }
    }
#pragma unroll
    for (int e = 0; e < 2; ++e) {
        const int ch = ch0 + e;
        *(u32x4*)(KTg + imgF + ch * 64 + 8 * g) = (u32x4){ktf[e][0], ktf[e][1], ktf[e][2], ktf[e][3]};
        *(u32x4*)(KTg + imgB + ch * 64 + 8 * g) = (u32x4){ktb[e][0], ktb[e][1], ktb[e][2], ktb[e][3]};
        const u32x4 vv = (u32x4){vtw[e][0], vtw[e][1], vtw[e][2], vtw[e][3]};
        *(u32x4*)(F.vta() + ((size_t)(c * 8 + h) * 128 + ch) * 64 + 8 * g) = vv;
    }
    if (g == 0) {
        *(f32x2*)(F.da() + ((size_t)(0 * NCH + c) * 8 + h) * 128 + ch0) = (f32x2){__builtin_amdgcn_exp2f(b63[0]), __builtin_amdgcn_exp2f(b63[1])};
        *(f32x2*)(F.da() + ((size_t)(1 * NCH + c) * 8 + h) * 128 + ch0) = (f32x2){__builtin_amdgcn_exp2f(totb[0]), __builtin_amdgcn_exp2f(totb[1])};
    }
    LDS_BARRIER();
    {
        const int fr = lane & 15, fq = lane >> 4, jt = g >> 1, n0 = 2 * (g & 1), t = 16 * jt + fr;
        f32x4 af[2] = {(f32x4){0.f, 0.f, 0.f, 0.f}, (f32x4){0.f, 0.f, 0.f, 0.f}}, ab[2] = {af[0], af[0]};
#pragma unroll
        for (int kk = 0; kk < 4; ++kk) {
            const bf16x8 a_f = *(const LAS bf16x8*)(QHF + t * LQ + 32 * kk + 8 * fq), a_b = *(const LAS bf16x8*)(QHB + t * LQ + 32 * kk + 8 * fq);
#pragma unroll
            for (int n = 0; n < 2; ++n) {
                const bf16x8 b_f = *(const LAS bf16x8*)(KHF + (16 * (n0 + n) + fr) * LQ + 32 * kk + 8 * fq), b_b = *(const LAS bf16x8*)(KHB + (16 * (n0 + n) + fr) * LQ + 32 * kk + 8 * fq);
                af[n] = mfma16(b_f, a_f, af[n]); ab[n] = mfma16(b_b, a_b, ab[n]);
            }
        }
#pragma unroll
        for (int n = 0; n < 2; ++n) { const int t2b = 16 * (n0 + n) + 4 * fq; float p[4];
#pragma unroll
            for (int r = 0; r < 4; ++r) p[r] = (t2b + r <= t ? af[n][r] : 0.f) + (t2b + r >= t ? ab[n][r] : 0.f);
            u32x2 ow; ow.x = pk2(p[0], p[1]); ow.y = pk2(p[2], p[3]);
            *(LAS u32x2*)(PL + t * LT + t2b) = ow; }
    }
    LDS_BARRIER();
    *(u32x4*)(F.pia() + ((size_t)(c * 8 + h) * 64 + (F.tid >> 3)) * 64 + (F.tid & 7) * 8) = *(const LAS u32x4*)(PL + (F.tid >> 3) * LT + (F.tid & 7) * 8);
    LDS_BARRIER();
}

__device__ __forceinline__ void ret_local_item(const Ctx& F, int c, int h) {
    LAS bf16_t* QH = (LAS bf16_t*)F.lds; LAS bf16_t* KH = QH + 64 * LQ; LAS bf16_t* VTL = KH + 64 * LQ; LAS bf16_t* PL = VTL + 256 * LT;
    const int lane = F.lane, w = F.wave, t0 = c * 64;
    const float lg2 = __builtin_amdgcn_logf(1.f - __builtin_amdgcn_exp2f((float)(-5 - h)));
    const float scale = 0.08838834764831845f;
    const size_t imgF = ((size_t)(0 * NCH + c) * 8 + h) * 8192, imgB = ((size_t)(1 * NCH + c) * 8 + h) * 8192;
    u32x2 vw_[8];
    {
        const int cq = lane & 31, tg = w * 2 + (lane >> 5), c1 = 2 * cq;
        unsigned kf[4][2];
        unsigned qa_[4], qb_[4], ka_[4], kb_[4]; f32x4 cs_[4];
#pragma unroll
        for (int jj = 0; jj < 4; ++jj) { const int t = 4 * tg + jj; const bf16_t* row = F.eab() + (size_t)(t0 + t) * LDEAB + h * 128 + c1;
            qa_[jj] = *(const unsigned*)(row + E_BQ); qb_[jj] = *(const unsigned*)(row + E_BQ + 64); ka_[jj] = *(const unsigned*)(row + E_BK); kb_[jj] = *(const unsigned*)(row + E_BK + 64);
            cs_[jj] = *(const f32x4*)(F.rope() + (size_t)(t0 + t) * 64 + c1); }
#pragma unroll
        for (int jj = 0; jj < 8; ++jj) vw_[jj] = *(const u32x2*)(F.eab() + (size_t)(t0 + 8 * w + jj) * LDEAB + E_BV + h * 256 + 4 * lane);
#pragma unroll
        for (int jj = 0; jj < 4; ++jj) {
            const int t = 4 * tg + jj;
            const unsigned qa = qa_[jj], qb = qb_[jj], ka = ka_[jj], kbw = kb_[jj];
            const f32x4 cs = cs_[jj];
            const float q1[2] = {__uint_as_float(qa << 16), __uint_as_float(qa & 0xffff0000u)}, q2[2] = {__uint_as_float(qb << 16), __uint_as_float(qb & 0xffff0000u)};
            const float k1[2] = {__uint_as_float(ka << 16), __uint_as_float(ka & 0xffff0000u)}, k2[2] = {__uint_as_float(kbw << 16), __uint_as_float(kbw & 0xffff0000u)};
            const float co[2] = {cs.x, cs.z}, si[2] = {cs.y, cs.w};
            float qh[4], kh[4];
#pragma unroll
            for (int e = 0; e < 2; ++e) { qh[e] = q1[e] * co[e] - q2[e] * si[e]; qh[2 + e] = q2[e] * co[e] + q1[e] * si[e];
                kh[e] = (k1[e] * co[e] - k2[e] * si[e]) * scale; kh[2 + e] = (k2[e] * co[e] + k1[e] * si[e]) * scale; }
            *(LAS unsigned*)(QH + t * LQ + c1) = pk2(qh[0], qh[1]); *(LAS unsigned*)(QH + t * LQ + 64 + c1) = pk2(qh[2], qh[3]);
            *(LAS unsigned*)(KH + t * LQ + c1) = pk2(kh[0], kh[1]); *(LAS unsigned*)(KH + t * LQ + 64 + c1) = pk2(kh[2], kh[3]);
            bf16_t* qf = F.qtb() + imgF + t * 128 + c1;
            *(unsigned*)qf = pk2(qh[0], qh[1]); *(unsigned*)(qf + 64) = pk2(qh[2], qh[3]);
#pragma unroll
            for (int e = 0; e < 4; ++e) { const unsigned a = f2bf(kh[e]);
                if (jj & 1) kf[e][jj >> 1] |= a << 16; else kf[e][jj >> 1] = a; }
        }
#pragma unroll
        for (int e = 0; e < 4; ++e) { const int ch = c1 + (e & 1) + 64 * (e >> 1);
            *(u32x2*)(F.ktb() + imgF + ch * 64 + 4 * tg) = (u32x2){kf[e][0], kf[e][1]}; }
    }
    {
        const int g = w; unsigned vt[4][4];
#pragma unroll
        for (int jj = 0; jj < 8; ++jj) {
            const u32x2 vw = vw_[jj];
            const unsigned v4[4] = {vw.x & 0xffffu, vw.x >> 16, vw.y & 0xffffu, vw.y >> 16};
#pragma unroll
            for (int e = 0; e < 4; ++e) { if (jj & 1) vt[e][jj >> 1] |= v4[e] << 16; else vt[e][jj >> 1] = v4[e]; }
        }
#pragma unroll
        for (int e = 0; e < 4; ++e) { const int ch = 4 * lane + e; const u32x4 vv = (u32x4){vt[e][0], vt[e][1], vt[e][2], vt[e][3]};
            *(u32x4*)(F.vtb() + ((size_t)(c * 8 + h) * 256 + ch) * 64 + 8 * g) = vv; }
    }
    LDS_BARRIER();
    {
        const int fr = lane & 15, fq = lane >> 4, jt = w >> 1, n0 = 2 * (w & 1), t = 16 * jt + fr;
        f32x4 ac[2] = {(f32x4){0.f, 0.f, 0.f, 0.f}, (f32x4){0.f, 0.f, 0.f, 0.f}};
#pragma unroll
        for (int kk = 0; kk < 4; ++kk) {
            const bf16x8 a = *(const LAS bf16x8*)(QH + t * LQ + 32 * kk + 8 * fq);
#pragma unroll
            for (int n = 0; n < 2; ++n) ac[n] = mfma16(*(const LAS bf16x8*)(KH + (16 * (n0 + n) + fr) * LQ + 32 * kk + 8 * fq), a, ac[n]);
        }
#pragma unroll
        for (int n = 0; n < 2; ++n) { const int t2b = 16 * (n0 + n) + 4 * fq; float p[4];
#pragma unroll
            for (int r = 0; r < 4; ++r) { const int dd = t > t2b + r ? t - (t2b + r) : (t2b + r) - t; p[r] = ac[n][r] * __builtin_amdgcn_exp2f((float)dd * lg2); }
            u32x2 ow; ow.x = pk2(p[0], p[1]); ow.y = pk2(p[2], p[3]);
            *(LAS u32x2*)(PL + t * LT + t2b) = ow; }
    }
    LDS_BARRIER();
    *(u32x4*)(F.pib() + ((size_t)(c * 8 + h) * 64 + (F.tid >> 3)) * 64 + (F.tid & 7) * 8) = *(const LAS u32x4*)(PL + (F.tid >> 3) * LT + (F.tid & 7) * 8);
    LDS_BARRIER();
}

constexpr int NSEG = 8, CPS = NCH / NSEG;
template <int MIX, int MODE> __device__ __forceinline__ void chain_seg_item(const Ctx& F, int item, int seg) {
    LAS bf16_t* QL0 = (LAS bf16_t*)F.lds; LAS bf16_t* KL0 = QL0 + 64 * LQ; LAS bf16_t* QL1 = KL0 + 128 * LT; LAS bf16_t* KL1 = QL1 + 64 * LQ; LAS float* DL = (LAS float*)(KL1 + 128 * LT);
    LAS bf16_t* PL0 = (LAS bf16_t*)(DL + 256); LAS bf16_t* PL1 = PL0 + 64 * LT;
    const bf16_t* PI = MIX == 0 ? F.pia() : F.pib();
    const int lane = F.lane, w = F.wave, tid = F.tid, fr = lane & 15, fq = lane >> 4;
    const int h = MIX == 0 ? item : (item >> 1), vhalf = MIX == 0 ? 0 : (item & 1), sitem = MIX == 0 ? item : 8 + item;
    const int ocol = (MIX == 0 ? h * 128 : 1024 + h * 256 + vhalf * 128) + 16 * w + 4 * fq;
    const bf16_t* QT = MIX == 0 ? F.qta() : F.qtb(); const bf16_t* KT = MIX == 0 ? F.kta() : F.ktb(); const bf16_t* VT = MIX == 0 ? F.vta() : F.vtb();
    const int vrow = (MIX == 0 ? 0 : vhalf * 128) + 16 * w + fr, VW = MIX == 0 ? 128 : 256;
    const float g64 = MIX == 1 ? __builtin_amdgcn_exp2f(64.f * __builtin_amdgcn_logf(1.f - __builtin_amdgcn_exp2f((float)(-5 - h)))) : 1.f;
    f32x4* SLOC = (f32x4*)F.sloc(); float* DSEG = F.dseg();
#define SLOC_AT(d_, s_, a_) SLOC[((((size_t)(sitem * 2 + (d_)) * NSEG + (s_)) * 8 + (a_)) * 8 + w) * 64 + lane]
    const float lg2g = MIX == 1 ? __builtin_amdgcn_logf(1.f - __builtin_amdgcn_exp2f((float)(-5 - h))) : 0.f;
    const float gam = 1.f - __builtin_amdgcn_exp2f((float)(-5 - h)), gami = __builtin_amdgcn_rcpf(gam); (void)gam; (void)gami;
    f32x4 S0[8], S1[8];
#pragma unroll
    for (int a = 0; a < 8; ++a) { S0[a] = (f32x4){0.f, 0.f, 0.f, 0.f}; S1[a] = S0[a]; }
    if (MODE == 1) {
        const float gseg = MIX == 1 ? __builtin_amdgcn_exp2f((float)(64 * CPS) * __builtin_amdgcn_logf(1.f - __builtin_amdgcn_exp2f((float)(-5 - h)))) : 1.f;
#pragma unroll 1
        for (int i = 0; i < NSEG - 1; ++i) {
            const bool fw = i < seg; const int s = fw ? i : NSEG - 1 - (i - seg), dI = fw ? 0 : 1;
            f32x4 ld[8], dvv[8];
#pragma unroll
            for (int a = 0; a < 8; ++a) { ld[a] = SLOC_AT(dI, s, a);
                dvv[a] = MIX == 0 ? *(const f32x4*)(DSEG + ((size_t)(h * 2 + dI) * NSEG + s) * 128 + 16 * a + 4 * fq) : (f32x4){gseg, gseg, gseg, gseg}; }
            __builtin_amdgcn_sched_barrier(0);
            if (fw) {
#pragma unroll
                for (int a = 0; a < 8; ++a) S0[a] = S0[a] * dvv[a] + ld[a];
            } else {
#pragma unroll
                for (int a = 0; a < 8; ++a) S1[a] = S1[a] * dvv[a] + ld[a];
            }
        }
    }
    float one_ = 1.f; asm volatile("" : "+v"(one_));
    u32x4 qreg[2][2], kreg[2][2], preg[2]; bf16x8 vreg[2][2]; f32x4 dreg = (f32x4){one_, one_, one_, one_}, dprod = dreg;
#define CS_ISSUE(i_) do { _Pragma("unroll") for (int d = 0; d < 2; ++d) { const int c__ = d ? seg * CPS + CPS - 1 - (i_) : seg * CPS + (i_); const size_t img = ((size_t)((MIX == 1 ? 0 : d) * NCH + c__) * 8 + h) * 8192; \
            _Pragma("unroll") for (int i = 0; i < 2; ++i) { if (MODE == 1) qreg[d][i] = *(const u32x4*)(QT + img + (size_t)(tid + 512 * i) * 8); kreg[d][i] = *(const u32x4*)(KT + img + (size_t)(tid + 512 * i) * 8); } \
            _Pragma("unroll") for (int ks = 0; ks < 2; ++ks) vreg[d][ks] = *(const bf16x8*)(VT + ((size_t)(c__ * 8 + h) * VW + vrow) * 64 + 32 * ks + 8 * fq); \
            if (MODE == 1 && (i_) < CPS / 2) preg[d] = *(const u32x4*)(PI + (size_t)(c__ * 8 + h) * 4096 + (size_t)tid * 8); } \
            if (MIX == 0 && tid < 64) { const int d = tid >> 5; const int c__ = d ? seg * CPS + CPS - 1 - (i_) : seg * CPS + (i_); dreg = *(const f32x4*)(F.da() + ((size_t)(d * NCH + c__) * 8 + h) * 128 + 4 * (tid & 31)); } } while (0)
    CS_ISSUE(0);
    u32x2 oreg[2][4];
#define CS_OLOAD(i_) do { if (MODE == 1) { const int cf_ = seg * CPS + (i_), cb_ = seg * CPS + CPS - 1 - (i_); _Pragma("unroll") for (int tt = 0; tt < 4; ++tt) { \
            oreg[0][tt] = *(const u32x2*)(F.obuf() + (size_t)(cf_ * 64 + 16 * tt + (F.lane & 15)) * YW + ocol); oreg[1][tt] = *(const u32x2*)(F.obuf() + (size_t)(cb_ * 64 + 16 * tt + (F.lane & 15)) * YW + ocol); } } } while (0)
#pragma unroll 1
    for (int it = 0; it < CPS; ++it) {
        const int cf = seg * CPS + it, cb = seg * CPS + CPS - 1 - it;
        int tid_l = F.tid; asm volatile("" : "+v"(tid_l)); const int tid = tid_l, lane = tid_l & 63, fr = lane & 15, fq = lane >> 4; (void)lane;
#pragma unroll
        for (int i = 0; i < 2; ++i) { const int p = tid + 512 * i;
            if (MODE == 1 && MIX == 1) {
                const int tq = p >> 4;
#pragma unroll
                for (int d2 = 0; d2 < 2; ++d2) { u32x4 qw = qreg[d2][i]; const float sc = __builtin_amdgcn_exp2f((float)(d2 ? 64 - tq : tq + 1) * lg2g);
#pragma unroll
                    for (int e2 = 0; e2 < 4; ++e2) qw[e2] = pk2(__uint_as_float(qw[e2] << 16) * sc, __uint_as_float(qw[e2] & 0xffff0000u) * sc);
                    qreg[d2][i] = qw; }
            }
            if (MODE == 1) { *(LAS u32x4*)(QL0 + (p >> 4) * LQ + (p & 15) * 8) = qreg[0][i]; *(LAS u32x4*)(QL1 + (p >> 4) * LQ + (p & 15) * 8) = qreg[1][i]; }
            if (MIX == 1) {
                const int tq0 = (p & 7) * 8;
#pragma unroll
                for (int d2 = 0; d2 < 2; ++d2) { u32x4 kw = kreg[d2][i];
                    float sc = __builtin_amdgcn_exp2f((float)(d2 ? tq0 : 63 - tq0) * lg2g); const float st = d2 ? gam : gami;
#pragma unroll
                    for (int e2 = 0; e2 < 4; ++e2) { const float s0 = sc, s1 = sc * st; sc = s1 * st;
                        kw[e2] = pk2(__uint_as_float(kw[e2] << 16) * s0, __uint_as_float(kw[e2] & 0xffff0000u) * s1); }
                    kreg[d2][i] = kw; __builtin_amdgcn_sched_barrier(0); }
            }
            *(LAS u32x4*)(KL0 + (p >> 3) * LT + (p & 7) * 8) = kreg[0][i]; *(LAS u32x4*)(KL1 + (p >> 3) * LT + (p & 7) * 8) = kreg[1][i]; }
        if (MIX == 0 && tid < 64) { *(LAS f32x4*)(DL + 4 * tid) = dreg; dprod = dprod * dreg; }
        const bool first = MODE == 1 && it < CPS / 2;
        if (first) { *(LAS u32x4*)(PL0 + (tid >> 3) * LT + (tid & 7) * 8) = preg[0]; *(LAS u32x4*)(PL1 + (tid >> 3) * LT + (tid & 7) * 8) = preg[1]; }
        const bf16x8 vf00 = vreg[0][0], vf01 = vreg[0][1], vf10 = vreg[1][0], vf11 = vreg[1][1];
        if (it + 1 < CPS) CS_ISSUE(it + 1);
        LDS_BARRIER();
#pragma unroll
        for (int d = 0; d < 2; ++d) {
            f32x4 (&S)[8] = d ? S1 : S0; const LAS bf16_t* QL = d ? QL1 : QL0; const LAS bf16_t* KL = d ? KL1 : KL0; const int t0 = (d ? cb : cf) * 64;
            if (MODE == 1) {
                bf16x8 sf[4];
#pragma unroll
                for (int kk = 0; kk < 4; ++kk) { u32x4 pw; pw.x = pk2(S[2 * kk][0], S[2 * kk][1]); pw.y = pk2(S[2 * kk][2], S[2 * kk][3]); pw.z = pk2(S[2 * kk + 1][0], S[2 * kk + 1][1]); pw.w = pk2(S[2 * kk + 1][2], S[2 * kk + 1][3]);
                    sf[kk] = __builtin_bit_cast(bf16x8, pw); }
                const LAS bf16_t* PLd = d ? PL1 : PL0; const bf16x8 va0 = d ? vf10 : vf00, va1 = d ? vf11 : vf01;
#pragma unroll
                for (int tt = 0; tt < 4; ++tt) {
                    f32x4 acc = (f32x4){0.f, 0.f, 0.f, 0.f};
                    if (first) {
                        acc = mfma16(va0, *(const LAS bf16x8*)(PLd + (16 * tt + fr) * LT + 8 * fq), acc);
                        acc = mfma16(va1, *(const LAS bf16x8*)(PLd + (16 * tt + fr) * LT + 32 + 8 * fq), acc);
                    }
#pragma unroll
                    for (int kk = 0; kk < 4; ++kk) {
                        const LAS bf16_t* qp = QL + (16 * tt + fr) * LQ + 32 * kk + 4 * fq;
                        const u32x2 lo = *(const LAS u32x2*)qp, hi = *(const LAS u32x2*)(qp + 16);
                        const u32x4 bw = (u32x4){lo.x, lo.y, hi.x, hi.y};
                        acc = mfma16(sf[kk], __builtin_bit_cast(bf16x8, bw), acc);
                    }
                    const u32x2 ow = first ? (u32x2){0u, 0u} : (d ? oreg[1][tt] : oreg[0][tt]);
                    u32x2 nw; nw.x = pk2(__uint_as_float(ow.x << 16) + acc[0], __uint_as_float(ow.x & 0xffff0000u) + acc[1]); nw.y = pk2(__uint_as_float(ow.y << 16) + acc[2], __uint_as_float(ow.y & 0xffff0000u) + acc[3]);
                    *(u32x2*)(F.obuf() + (size_t)(t0 + 16 * tt + fr) * YW + ocol) = nw;
                }
            }
            const bf16x8 vf0 = d ? vf10 : vf00, vf1 = d ? vf11 : vf01;
#pragma unroll
            for (int a = 0; a < 8; ++a) {
                if (MIX == 0) S[a] = S[a] * *(const LAS f32x4*)(DL + d * 128 + 16 * a + 4 * fq); else S[a] = S[a] * g64;
                S[a] = mfma16(*(const LAS bf16x8*)(KL + (16 * a + fr) * LT + 8 * fq), vf0, S[a]);
                S[a] = mfma16(*(const LAS bf16x8*)(KL + (16 * a + fr) * LT + 32 + 8 * fq), vf1, S[a]);
            }
        }
        if (it + 1 < CPS && it + 1 >= CPS / 2) CS_OLOAD(it + 1);
        LDS_BARRIER();
    }
#undef CS_OLOAD
    if (MODE == 0) {
#pragma unroll
        for (int a = 0; a < 8; ++a) { SLOC_AT(0, seg, a) = S0[a]; SLOC_AT(1, seg, a) = S1[a]; }
        if (MIX == 0 && tid < 64) *(f32x4*)(DSEG + ((size_t)(h * 2 + (tid >> 5)) * NSEG + seg) * 128 + 4 * (tid & 31)) = dprod;
    }
#undef CS_ISSUE
#undef SLOC_AT
}
__device__ __forceinline__ void rwkv_code_pass(const Ctx& F, int l, int part, int nparts) {
    const float* mu = F.in(7) + (size_t)l * 2 * CSHIFT + 3072;
    for (int idx = part * 512 + F.tid; idx < SEQ * 32; idx += nparts * 512) {
        const int t = idx >> 5, pc = idx & 31;
        const int tm = t > 0 ? t - 1 : t, tn = t < SEQ - 1 ? t + 1 : t;
        const bf16_t* cb0 = F.ecb() + 3072 + 8 * pc;
        const u32x4 pw = *(const u32x4*)(cb0 + (size_t)t * LDEC);
        const u32x4 mw = *(const u32x4*)(cb0 + (size_t)tm * LDEC) & (t > 0 ? 0xffffffffu : 0u);
        const u32x4 nw = *(const u32x4*)(cb0 + (size_t)tn * LDEC) & (t < SEQ - 1 ? 0xffffffffu : 0u);
        const f32x4 m0a = *(const f32x4*)(mu + 8 * pc), m0b = *(const f32x4*)(mu + 8 * pc + 4), m1a = *(const f32x4*)(mu + CSHIFT + 8 * pc), m1b = *(const f32x4*)(mu + CSHIFT + 8 * pc + 4);
        float o[8];
#pragma unroll
        for (int e2 = 0; e2 < 4; ++e2) {
#pragma unroll
            for (int hl = 0; hl < 2; ++hl) { const int e = 2 * e2 + hl;
                const float p = hl ? __uint_as_float(pw[e2] & 0xffff0000u) : __uint_as_float(pw[e2] << 16), pm = hl ? __uint_as_float(mw[e2] & 0xffff0000u) : __uint_as_float(mw[e2] << 16), pn = hl ? __uint_as_float(nw[e2] & 0xffff0000u) : __uint_as_float(nw[e2] << 16);
                const float m0 = e < 4 ? m0a[e & 3] : m0b[e & 3], m1 = e < 4 ? m1a[e & 3] : m1b[e & 3];
                float s = p + m0 * (pm - p) + m1 * (pn - p);
                if (pc < 16) s = 1.f - 2.f * __builtin_amdgcn_rcpf(1.f + __builtin_amdgcn_exp2f(2.8853900817779268f * s));
                o[e] = s; } }
        u32x4 ow; ow.x = pk2(o[0], o[1]); ow.y = pk2(o[2], o[3]); ow.z = pk2(o[4], o[5]); ow.w = pk2(o[6], o[7]);
        *(u32x4*)(F.codeb() + (size_t)t * 256 + 8 * pc) = ow;
    }
}
__device__ __forceinline__ void rwkv_local_item(const Ctx& F, int l, int c, int h) {
    LAS bf16_t* AL = (LAS bf16_t*)F.lds; LAS bf16_t* BE = AL + 64 * LT; LAS bf16_t* KTL = BE + 64 * LT; LAS bf16_t* RT = KTL + 64 * LT; LAS bf16_t* VT = RT + 64 * LT;
    LAS bf16_t* BBT = VT + 64 * LT; LAS bf16_t* KBT = BBT + 64 * LT; LAS bf16_t* AAB = KBT + 64 * LT; LAS bf16_t* AAK = AAB + 64 * LT; LAS bf16_t* ARB = AAK + 64 * LT; LAS bf16_t* ARK = ARB + 64 * LT;
    LAS bf16_t* XT = ARK + 64 * LT;
    LAS float* DG = (LAS float*)(XT + 128 * LT);
    LAS bf16_t* TB = (LAS bf16_t*)(DG + 1024);
    LAS bf16_t* RKVS = (LAS bf16_t*)(F.lds + 103424);
    LAS float* TOT = (LAS float*)(F.lds + 129024);
    LAS float* PCV = TOT + 1024;
#define RW_FRESH() int tid_l = F.tid; asm volatile("" : "+v"(tid_l)); const int tid = tid_l, lane = tid_l & 63, fr = lane & 15, fq = lane >> 4; (void)tid; (void)fr; (void)fq
    const int w = F.wave, t0 = c * 64; const int lane = F.lane, col = h * 64 + lane;
    const float* mu = F.in(7) + (size_t)l * 2 * CSHIFT;
    const float mr0 = mu[col], mr1 = mu[CSHIFT + col], mk0 = mu[1024 + col], mk1 = mu[CSHIFT + 1024 + col], mv0 = mu[2048 + col], mv1 = mu[CSHIFT + 2048 + col];
    const float kkw = F.in(12)[l * 1024 + col], kaw = F.in(13)[l * 1024 + col], rkw = F.in(14)[l * 1024 + col];
    float sr[8], sk[8], sv[8], kkn[8];
    float lw2r[2][8], ar[2][8];
    bf16_t pr[10], pk[10], pv[10];
    {
        constexpr int LC = 264, LO = 68;
        LAS bf16_t* CODE = (LAS bf16_t*)F.lds; LAS float* LOUT = (LAS float*)(F.lds + 64 * LC * 2);
        bf16x8 la[2][2]; f32x4 lb[2];
        {
            const int gi = w >> 1, kind = gi >> 1, dd = gi & 1, fr0 = lane & 15, fq0 = lane >> 4;
            const bf16_t* A = F.lwt() + ((size_t)gi * 1024 + h * 64) * 64;
            const float* bias = (kind == 0 ? F.in(8) : F.in(10)) + (l * 2 + dd) * 1024 + h * 64;
#pragma unroll
            for (int ci = 0; ci < 2; ++ci) { const int ct = 2 * (w & 1) + ci;
                la[ci][0] = *(const bf16x8*)(A + (size_t)(16 * ct + fr0) * 64 + 8 * fq0); la[ci][1] = *(const bf16x8*)(A + (size_t)(16 * ct + fr0) * 64 + 32 + 8 * fq0);
                lb[ci] = *(const f32x4*)(bias + 16 * ct + 4 * fq0); }
        }
        u32x4 rkvw[4];
#pragma unroll
        for (int i = 0; i < 4; ++i) { int pp = F.tid + 512 * i; pp = pp < 1584 ? pp : 1583; const int kind = pp >= 1056 ? 2 : (pp >= 528 ? 1 : 0), rem = pp - 528 * kind; int t = t0 - 1 + (rem >> 3); t = t < 0 ? 0 : (t >= SEQ ? SEQ - 1 : t);
            rkvw[i] = *(const u32x4*)(F.ecb() + (size_t)t * LDEC + kind * 1024 + h * 64 + (rem & 7) * 8); }
        u32x4 cpw[4];
#pragma unroll
        for (int hh = 0; hh < 4; ++hh) cpw[hh] = *(const u32x4*)(F.codeb() + (size_t)(t0 + (F.tid >> 3)) * 256 + 32 * (F.tid & 7) + 8 * hh);
        {
            RW_FRESH();
            const int tok = tid >> 3, cg = tid & 7;
#pragma unroll
            for (int hh = 0; hh < 4; ++hh) *(LAS u32x4*)(CODE + tok * LC + 32 * cg + 8 * hh) = cpw[hh];
#pragma unroll
            for (int i = 0; i < 4; ++i) { const int pp = tid + 512 * i; const int kind = pp >= 1056 ? 2 : (pp >= 528 ? 1 : 0), rem = pp - 528 * kind; const int tt = t0 - 1 + (rem >> 3);
                const unsigned okm = (tt >= 0 && tt < SEQ) ? 0xffffffffu : 0u;
                if (pp < 1584) *(LAS u32x4*)(RKVS + (kind * 66 + (rem >> 3)) * 64 + (rem & 7) * 8) = rkvw[i] & okm; }
        }
        LDS_BARRIER();
        {
            RW_FRESH();
            const int gi = w >> 1, kind = gi >> 1;
#pragma unroll
            for (int ci = 0; ci < 2; ++ci) {
                const int ct = 2 * (w & 1) + ci;
                const bf16x8 a0 = la[ci][0], a1 = la[ci][1];
                const f32x4 bv = lb[ci];
#pragma unroll
                for (int tt = 0; tt < 4; ++tt) {
                    f32x4 acc = bv;
                    acc = mfma16(a0, *(const LAS bf16x8*)(CODE + (16 * tt + fr) * LC + gi * 64 + 8 * fq), acc);
                    acc = mfma16(a1, *(const LAS bf16x8*)(CODE + (16 * tt + fr) * LC + gi * 64 + 32 + 8 * fq), acc);
                    f32x4 y;
#pragma unroll
                    for (int r = 0; r < 4; ++r) { const float sg = sigmoidf_(acc[r]); y[r] = kind == 0 ? (-0.6065306597126334f * LOG2E) * sg : sg; }
                    *(LAS f32x4*)(LOUT + (gi * 64 + 16 * tt + fr) * LO + 16 * ct + 4 * fq) = y;
                }
            }
        }
        LDS_BARRIER();
#pragma unroll
        for (int dd = 0; dd < 2; ++dd)
#pragma unroll
            for (int jj = 0; jj < 8; ++jj) { lw2r[dd][jj] = LOUT[(dd * 64 + 8 * w + jj) * LO + lane]; ar[dd][jj] = LOUT[((2 + dd) * 64 + 8 * w + jj) * LO + lane]; }
        LDS_BARRIER();
    }
    {
#pragma unroll
        for (int i = 0; i < 10; ++i) { pr[i] = RKVS[(8 * w + i) * 64 + lane]; pk[i] = RKVS[(66 + 8 * w + i) * 64 + lane]; pv[i] = RKVS[(132 + 8 * w + i) * 64 + lane]; }
#pragma unroll
        for (int jj = 0; jj < 8; ++jj) {
            sr[jj] = bf2f(pr[jj + 1]) + mr0 * (bf2f(pr[jj]) - bf2f(pr[jj + 1])) + mr1 * (bf2f(pr[jj + 2]) - bf2f(pr[jj + 1]));
            sk[jj] = bf2f(pk[jj + 1]) + mk0 * (bf2f(pk[jj]) - bf2f(pk[jj + 1])) + mk1 * (bf2f(pk[jj + 2]) - bf2f(pk[jj + 1]));
            sv[jj] = bf2f(pv[jj + 1]) + mv0 * (bf2f(pv[jj]) - bf2f(pv[jj + 1])) + mv1 * (bf2f(pv[jj + 2]) - bf2f(pv[jj + 1]));
            F.svb()[(size_t)(t0 + 8 * w + jj) * 1024 + col] = (bf16_t)f2bf(sv[jj]);
        }
        float kq[8];
#pragma unroll
        for (int jj = 0; jj < 8; ++jj) { const float kkr = sk[jj] * kkw; kq[jj] = kkr * kkr; }
        const float ksum = multi_sum8(kq, lane);
#pragma unroll
        for (int jj = 0; jj < 8; ++jj) kkn[jj] = sk[jj] * kkw * __builtin_amdgcn_rsqf(rlf(ksum, ms8_lane(jj)) + 1e-12f);
    }
    {
        float t0s = 0.f, t1s = 0.f;
#pragma unroll
        for (int jj = 0; jj < 8; ++jj) { t0s += lw2r[0][jj]; t1s += lw2r[1][jj]; }
        TOT[w * 64 + lane] = t0s; TOT[512 + w * 64 + lane] = t1s;
    }
    LDS_BARRIER();
    f32x4 oacc[2] = {(f32x4){0.f, 0.f, 0.f, 0.f}, (f32x4){0.f, 0.f, 0.f, 0.f}};
#pragma unroll 1
    for (int d = 0; d < 2; ++d) {
        {
            float lw2[8], av[8], kd[8];
            float bq[8];
#pragma unroll
            for (int jj = 0; jj < 8; ++jj) { lw2[jj] = d ? lw2r[1][jj] : lw2r[0][jj]; av[jj] = d ? ar[1][jj] : ar[0][jj]; kd[jj] = sk[jj] * (1.f + (av[jj] - 1.f) * kaw);
                bq[jj] = sr[jj] * kd[jj] * rkw; }
            const float bonl = multi_sum8(bq, lane);
            if (lane < 8) F.bons()[((size_t)d * SEQ + t0 + 8 * w + ms8_index(lane)) * 16 + h] = bonl;
            unsigned bbp[4] = {0u, 0u, 0u, 0u}, kbp[4] = {0u, 0u, 0u, 0u}, vtp[4] = {0u, 0u, 0u, 0u};
            const int j0 = d ? 63 - (8 * w + 7) : 8 * w;
            float off = 0.f, l63 = 0.f;
#pragma unroll
            for (int gg = 0; gg < 8; ++gg) { const float tg = TOT[d * 512 + gg * 64 + lane]; l63 += tg; const bool bef = d == 0 ? gg < w : gg > w; off += bef ? tg : 0.f; }
            if (w == 0) PCV[lane] = __builtin_amdgcn_exp2f(l63);
            float lam[8];
            if (d == 0) { float run = off;
#pragma unroll
                for (int jj = 0; jj < 8; ++jj) { run += lw2[jj]; lam[jj] = run; } }
            else { float run = off;
#pragma unroll
                for (int jj = 7; jj >= 0; --jj) { run += lw2[jj]; lam[jj] = run; } }
#pragma unroll
            for (int jj = 0; jj < 8; ++jj) {
                const int tl = 8 * w + jj, j = d ? 63 - tl : tl;
                const float ep = __builtin_amdgcn_exp2f(lam[jj]), en = __builtin_amdgcn_exp2f(-lam[jj]), eb = __builtin_amdgcn_exp2f(l63 - lam[jj]);
                const float bet = kkn[jj] * av[jj];
                AL[j * LT + lane] = (bf16_t)f2bf(-kkn[jj] * __builtin_amdgcn_exp2f(lam[jj] - lw2[jj]));
                BE[j * LT + lane] = (bf16_t)f2bf(bet * en); KTL[j * LT + lane] = (bf16_t)f2bf(kd[jj] * en); RT[j * LT + lane] = (bf16_t)f2bf(sr[jj] * ep);
                const unsigned bb = f2bf(bet * eb), kb = f2bf(kd[jj] * eb), vb = f2bf(sv[jj]);
                bbp[jj >> 1] |= bb << (16 * (jj & 1)); kbp[jj >> 1] |= kb << (16 * (jj & 1)); vtp[jj >> 1] |= vb << (16 * (jj & 1));
                if ((jj & 3) == 3) __builtin_amdgcn_sched_barrier(0);
            }
            if (d) {
#pragma unroll
                for (int q = 0; q < 2; ++q) { unsigned a, b;
                    a = bbp[q]; b = bbp[3 - q]; bbp[q] = (b >> 16) | (b << 16); bbp[3 - q] = (a >> 16) | (a << 16);
                    a = kbp[q]; b = kbp[3 - q]; kbp[q] = (b >> 16) | (b << 16); kbp[3 - q] = (a >> 16) | (a << 16);
                    a = vtp[q]; b = vtp[3 - q]; vtp[q] = (b >> 16) | (b << 16); vtp[3 - q] = (a >> 16) | (a << 16); }
            }
            *(LAS u32x4*)(VT + lane * LT + j0) = (u32x4){vtp[0], vtp[1], vtp[2], vtp[3]};
            *(LAS u32x4*)(BBT + lane * LT + j0) = (u32x4){bbp[0], bbp[1], bbp[2], bbp[3]};
            *(LAS u32x4*)(KBT + lane * LT + j0) = (u32x4){kbp[0], kbp[1], kbp[2], kbp[3]};
        }
        LDS_BARRIER();
        {
            RW_FRESH(); const int blk = w >> 1;
            const LAS bf16_t* Am = blk < 2 ? AL : RT; const LAS bf16_t* Bm = (blk & 1) ? KTL : BE;
            LAS bf16_t* Om = blk == 0 ? AAB : (blk == 1 ? AAK : (blk == 2 ? ARB : ARK));
            const int incl = blk >> 1;
#pragma unroll
            for (int ri = 0; ri < 2; ++ri) {
                const int jt = 2 * (w & 1) + ri, j = 16 * jt + fr;
                const bf16x8 a0 = *(const LAS bf16x8*)(Am + j * LT + 8 * fq), a1 = *(const LAS bf16x8*)(Am + j * LT + 32 + 8 * fq);
#pragma unroll
                for (int ct = 0; ct < 4; ++ct) {
                    f32x4 acc = (f32x4){0.f, 0.f, 0.f, 0.f};
                    acc = mfma16(*(const LAS bf16x8*)(Bm + (16 * ct + fr) * LT + 8 * fq), a0, acc);
                    acc = mfma16(*(const LAS bf16x8*)(Bm + (16 * ct + fr) * LT + 32 + 8 * fq), a1, acc);
                    const int j2b = 16 * ct + 4 * fq;
                    float v[4];
#pragma unroll
                    for (int r = 0; r < 4; ++r) v[r] = (j2b + r < j + incl) ? acc[r] : 0.f;
                    if (blk == 0 && ct == jt) *(LAS f32x4*)(DG + jt * 256 + fr * 16 + 4 * fq) = (f32x4){v[0], v[1], v[2], v[3]};
                    u32x2 ow; ow.x = pk2(v[0], v[1]); ow.y = pk2(v[2], v[3]);
                    *(LAS u32x2*)(Om + j * LT + j2b) = ow;
                }
            }
        }
        LDS_BARRIER();
        f32x4 rhs[4];
        {
            RW_FRESH();
            if (w >= 4) {
#pragma unroll
                for (int bi = 0; bi < 4; ++bi) { f32x4 acc = (f32x4){0.f, 0.f, 0.f, 0.f};
#pragma unroll
                    for (int ks = 0; ks < 2; ++ks) acc = mfma16(*(const LAS bf16x8*)(AAK + (16 * bi + fr) * LT + 32 * ks + 8 * fq), *(const LAS bf16x8*)(VT + (16 * (w - 4) + fr) * LT + 32 * ks + 8 * fq), acc);
                    rhs[bi] = acc; }
            } else {
#pragma unroll
                for (int bi = 0; bi < 4; ++bi)
#pragma unroll
                    for (int r = 0; r < 4; ++r) rhs[bi][r] = bf2f(AL[(16 * bi + 4 * fq + r) * LT + 16 * w + fr]);
            }
            if (w == 0) {
                const int blk = lane >> 4, cc = lane & 15; float x[16];
#pragma unroll
                for (int jl = 0; jl < 16; ++jl) {
                    float s = (jl == cc) ? 1.f : 0.f;
#pragma unroll
                    for (int j2 = 0; j2 < jl; ++j2) s += DG[blk * 256 + jl * 16 + j2] * x[j2];
                    x[jl] = s;
                    TB[blk * 384 + jl * 24 + cc] = (bf16_t)f2bf(s);
                }
            }
        }
        LDS_BARRIER();
        {
            RW_FRESH();
            f32x4 X[4]; const u32x2 z2 = (u32x2){0u, 0u};
#pragma unroll
            for (int bi = 0; bi < 4; ++bi) {
                f32x4 s = rhs[bi];
                if (bi >= 1) {
                    u32x4 bw; bw.x = pk2(X[0][0], X[0][1]); bw.y = pk2(X[0][2], X[0][3]);
                    if (bi >= 2) { bw.z = pk2(X[1][0], X[1][1]); bw.w = pk2(X[1][2], X[1][3]); } else { bw.z = 0u; bw.w = 0u; }
                    const LAS bf16_t* ap = AAB + (16 * bi + fr) * LT + 4 * fq; const u32x2 lo = *(const LAS u32x2*)ap, hi = *(const LAS u32x2*)(ap + 16);
                    const u32x4 aw = (u32x4){lo.x, lo.y, hi.x, hi.y};
                    s = mfma16(__builtin_bit_cast(bf16x8, aw), __builtin_bit_cast(bf16x8, bw), s);
                }
                if (bi == 3) {
                    u32x4 bw; bw.x = pk2(X[2][0], X[2][1]); bw.y = pk2(X[2][2], X[2][3]); bw.z = 0u; bw.w = 0u;
                    const LAS bf16_t* ap = AAB + (48 + fr) * LT + 32 + 4 * fq; const u32x2 lo = *(const LAS u32x2*)ap;
                    const u32x4 aw = (u32x4){lo.x, lo.y, z2.x, z2.y};
                    s = mfma16(__builtin_bit_cast(bf16x8, aw), __builtin_bit_cast(bf16x8, bw), s);
                }
                {
                    u32x4 bw; bw.x = pk2(s[0], s[1]); bw.y = pk2(s[2], s[3]); bw.z = 0u; bw.w = 0u;
                    const u32x2 lo = *(const LAS u32x2*)(TB + bi * 384 + fr * 24 + 4 * fq);
                    const u32x4 aw = (u32x4){lo.x, lo.y, z2.x, z2.y};
                    X[bi] = mfma16(__builtin_bit_cast(bf16x8, aw), __builtin_bit_cast(bf16x8, bw), (f32x4){0.f, 0.f, 0.f, 0.f});
                }
                u32x2 ow; ow.x = pk2(X[bi][0], X[bi][1]); ow.y = pk2(X[bi][2], X[bi][3]);
                *(LAS u32x2*)(XT + (16 * w + fr) * LT + 16 * bi + 4 * fq) = ow;
            }
        }
        LDS_BARRIER();
        {
            RW_FRESH();
            const size_t img = ((size_t)(d * NCH + c) * 16 + h) * 4096;
#pragma unroll
            for (int ti = 0; ti < 2; ++ti) {
                const int tile = 2 * w + ti, rt = tile >> 2, ct = tile & 3;
                {
                    f32x4 acc = (f32x4){0.f, 0.f, 0.f, 0.f};
#pragma unroll
                    for (int ks = 0; ks < 2; ++ks) acc = mfma16(*(const LAS bf16x8*)(XT + (16 * rt + fr) * LT + 32 * ks + 8 * fq), *(const LAS bf16x8*)(ARB + (16 * ct + fr) * LT + 32 * ks + 8 * fq), acc);
                    const int j = 16 * ct + fr, k0 = 16 * rt + 4 * fq;
                    const u32x2 rw = *(const LAS u32x2*)(RT + j * LT + k0);
                    u32x2 ow; ow.x = pk2(acc[0] + __uint_as_float(rw.x << 16), acc[1] + __uint_as_float(rw.x & 0xffff0000u)); ow.y = pk2(acc[2] + __uint_as_float(rw.y << 16), acc[3] + __uint_as_float(rw.y & 0xffff0000u));
                    *(u32x2*)(F.rhi() + img + j * 64 + k0) = ow;
                }
                {
                    f32x4 acc = (f32x4){0.f, 0.f, 0.f, 0.f};
#pragma unroll
                    for (int ks = 0; ks < 2; ++ks) acc = mfma16(*(const LAS bf16x8*)(XT + (16 * rt + fr) * LT + 32 * ks + 8 * fq), *(const LAS bf16x8*)(BBT + (16 * ct + fr) * LT + 32 * ks + 8 * fq), acc);
                    const int k = 16 * ct + fr, kp0 = 16 * rt + 4 * fq; const float pc = PCV[k];
#pragma unroll
                    for (int r = 0; r < 4; ++r) acc[r] += (kp0 + r == k) ? pc : 0.f;
                    u32x2 ow; ow.x = pk2(acc[0], acc[1]); ow.y = pk2(acc[2], acc[3]);
                    *(u32x2*)(F.mi() + img + k * 64 + kp0) = ow;
                }
                {
                    f32x4 acc = (f32x4){0.f, 0.f, 0.f, 0.f};
#pragma unroll
                    for (int ks = 0; ks < 2; ++ks) {
                        acc = mfma16(*(const LAS bf16x8*)(BBT + (16 * rt + fr) * LT + 32 * ks + 8 * fq), *(const LAS bf16x8*)(XT + (64 + 16 * ct + fr) * LT + 32 * ks + 8 * fq), acc);
                        acc = mfma16(*(const LAS bf16x8*)(KBT + (16 * rt + fr) * LT + 32 * ks + 8 * fq), *(const LAS bf16x8*)(VT + (16 * ct + fr) * LT + 32 * ks + 8 * fq), acc);
                    }
                    const int v = 16 * ct + fr, k0 = 16 * rt + 4 * fq;
                    u32x2 ow; ow.x = pk2(acc[0], acc[1]); ow.y = pk2(acc[2], acc[3]);
                    *(u32x2*)(F.ni() + img + v * 64 + k0) = ow;
                }
                {
                    const int tl = 16 * ct + fr, j = d ? 63 - tl : tl;
                    f32x4 acc = (f32x4){0.f, 0.f, 0.f, 0.f};
#pragma unroll
                    for (int ks = 0; ks < 2; ++ks) {
                        acc = mfma16(*(const LAS bf16x8*)(XT + (64 + 16 * rt + fr) * LT + 32 * ks + 8 * fq), *(const LAS bf16x8*)(ARB + j * LT + 32 * ks + 8 * fq), acc);
                        acc = mfma16(*(const LAS bf16x8*)(VT + (16 * rt + fr) * LT + 32 * ks + 8 * fq), *(const LAS bf16x8*)(ARK + j * LT + 32 * ks + 8 * fq), acc);
                    }
                    if (d) { acc = acc + oacc[ti]; u32x2 ow; ow.x = pk2(acc[0], acc[1]); ow.y = pk2(acc[2], acc[3]);
                        *(u32x2*)(F.obuf() + (size_t)(t0 + tl) * YW + 3072 + h * 64 + 16 * rt + 4 * fq) = ow; }
                    else oacc[ti] = acc;
                }
            }
        }
        LDS_BARRIER();
    }
}
#undef RW_FRESH
constexpr int NSEGC = 16, CPSC = NCH / NSEGC;
constexpr int GSEG = 4;
template <int MODE> __device__ __forceinline__ void rwkv_seg_item(const Ctx& F, int h, int seg) {
    LAS bf16_t* ML0 = (LAS bf16_t*)F.lds; LAS bf16_t* ML1 = ML0 + 64 * LT; LAS bf16_t* RL0 = ML1 + 64 * LT; LAS bf16_t* RL1 = RL0 + 64 * LT;
    const int lane = F.lane, w = F.wave, tid = F.tid, fr = lane & 15, fq = lane >> 4;
    f32x4* NSG = (f32x4*)F.cseg(); bf16_t* MSG = F.cmseg();
#define NSG_AT(d_, s_, a_) NSG[((((size_t)(h * 2 + (d_)) * NSEGC + (s_)) * 4 + (a_)) * 4 + (w & 3)) * 64 + lane]
#define MSG_AT(d_, s_) (MSG + ((size_t)(h * 2 + (d_)) * NSEGC + (s_)) * 4096)
    f32x4 X0[4], X1[4];
#pragma unroll
    for (int a = 0; a < 4; ++a) {
        X0[a] = (f32x4){0.f, 0.f, 0.f, 0.f};
        if (MODE == 0 && w >= 4) {
#pragma unroll
            for (int r = 0; r < 4; ++r) X0[a][r] = (16 * a + 4 * fq + r == 16 * (w - 4) + fr) ? 1.f : 0.f;
        }
        X1[a] = X0[a];
    }
#define RW_SF(X, sf) do { _Pragma("unroll") for (int kk = 0; kk < 2; ++kk) { u32x4 pw; pw.x = pk2(X[2 * kk][0], X[2 * kk][1]); pw.y = pk2(X[2 * kk][2], X[2 * kk][3]); pw.z = pk2(X[2 * kk + 1][0], X[2 * kk + 1][1]); pw.w = pk2(X[2 * kk + 1][2], X[2 * kk + 1][3]); sf[kk] = __builtin_bit_cast(bf16x8, pw); } } while (0)
#define RW_UPD(X, ML, init, sf) do { _Pragma("unroll") for (int a = 0; a < 4; ++a) { f32x4 acc = init[a]; _Pragma("unroll") for (int kk = 0; kk < 2; ++kk) { const LAS bf16_t* mp = ML + (16 * a + fr) * LT + 32 * kk + 4 * fq; \
            const u32x2 lo = *(const LAS u32x2*)mp, hi = *(const LAS u32x2*)(mp + 16); const u32x4 aw = (u32x4){lo.x, lo.y, hi.x, hi.y}; acc = mfma16(__builtin_bit_cast(bf16x8, aw), sf[kk], acc); } init[a] = acc; } \
            _Pragma("unroll") for (int a = 0; a < 4; ++a) X[a] = init[a]; } while (0)
    if (MODE == 1) {
        const int g = seg / GSEG, kq = seg % GSEG, NG = NSEGC / GSEG;
        const int nf = g + (kq > 0 ? 1 : 0), nb = (NG - 1 - g) + (kq < GSEG - 1 ? 1 : 0), ns = nf > nb ? nf : nb;
#pragma unroll 1
        for (int i = 0; i < ns; ++i) {
            const bool df = i < nf, db = i < nb;
            const int sf_ = i < g ? GSEG * i + GSEG - 1 : seg - 1, sb_ = i < NG - 1 - g ? GSEG * (NG - 1 - i) : seg + 1;
            if (df) *(LAS u32x4*)(ML0 + (tid >> 3) * LT + (tid & 7) * 8) = *(const u32x4*)(MSG_AT(0, sf_) + (size_t)tid * 8);
            if (db) *(LAS u32x4*)(ML1 + (tid >> 3) * LT + (tid & 7) * 8) = *(const u32x4*)(MSG_AT(1, sb_) + (size_t)tid * 8);
            LDS_BARRIER();
            if (w < 4) {
                if (df) { bf16x8 sf[2]; RW_SF(X0, sf); f32x4 init[4];
#pragma unroll
                    for (int a = 0; a < 4; ++a) init[a] = NSG_AT(0, sf_, a);
                    RW_UPD(X0, ML0, init, sf); }
                if (db) { bf16x8 sf[2]; RW_SF(X1, sf); f32x4 init[4];
#pragma unroll
                    for (int a = 0; a < 4; ++a) init[a] = NSG_AT(1, sb_, a);
                    RW_UPD(X1, ML1, init, sf); }
            }
            LDS_BARRIER();
        }
    }
    u32x4 mreg[2], rreg[2]; u32x2 nreg[2][4];
    constexpr int NIT = MODE == 0 ? GSEG * CPSC : CPSC;
#define RS_ISSUE(i_) do { _Pragma("unroll") for (int d = 0; d < 2; ++d) { const int c__ = d ? seg * CPSC + NIT - 1 - (i_) : seg * CPSC + (i_); const size_t img = ((size_t)(d * NCH + c__) * 16 + h) * 4096; \
            mreg[d] = *(const u32x4*)(F.mi() + img + (size_t)tid * 8); if (MODE == 1) rreg[d] = *(const u32x4*)(F.rhi() + img + (size_t)tid * 8); \
            if (w < 4) { _Pragma("unroll") for (int a = 0; a < 4; ++a) nreg[d][a] = *(const u32x2*)(F.ni() + img + (16 * w + fr) * 64 + 16 * a + 4 * fq); } } } while (0)
    RS_ISSUE(0);
    u32x2 oreg[2][4];
#define RS_OLOAD(i_) do { if (MODE == 1 && w < 4) { const int cf_ = seg * CPSC + (i_), cb_ = seg * CPSC + NIT - 1 - (i_); _Pragma("unroll") for (int tt = 0; tt < 4; ++tt) { \
            oreg[0][tt] = *(const u32x2*)(F.obuf() + (size_t)(cf_ * 64 + 16 * tt + (F.lane & 15)) * YW + 3072 + h * 64 + 16 * w + 4 * (F.lane >> 4)); \
            oreg[1][tt] = *(const u32x2*)(F.obuf() + (size_t)(cb_ * 64 + 16 * tt + (F.lane & 15)) * YW + 3072 + h * 64 + 16 * w + 4 * (F.lane >> 4)); } } } while (0)
    RS_OLOAD(0);
#pragma unroll 1
    for (int it = 0; it < NIT; ++it) {
        const int cf = seg * CPSC + it, cb = seg * CPSC + NIT - 1 - it;
        *(LAS u32x4*)(ML0 + (tid >> 3) * LT + (tid & 7) * 8) = mreg[0]; *(LAS u32x4*)(ML1 + (tid >> 3) * LT + (tid & 7) * 8) = mreg[1];
        if (MODE == 1) { *(LAS u32x4*)(RL0 + (tid >> 3) * LT + (tid & 7) * 8) = rreg[0]; *(LAS u32x4*)(RL1 + (tid >> 3) * LT + (tid & 7) * 8) = rreg[1]; }
        f32x4 nin[2][4];
#pragma unroll
        for (int d = 0; d < 2; ++d)
#pragma unroll
            for (int a = 0; a < 4; ++a) nin[d][a] = (w < 4) ? (f32x4){__uint_as_float(nreg[d][a].x << 16), __uint_as_float(nreg[d][a].x & 0xffff0000u), __uint_as_float(nreg[d][a].y << 16), __uint_as_float(nreg[d][a].y & 0xffff0000u)} : (f32x4){0.f, 0.f, 0.f, 0.f};
        if (it + 1 < NIT) RS_ISSUE(it + 1);
        LDS_BARRIER();
        if (MODE == 0 || w < 4) {
#pragma unroll
            for (int d = 0; d < 2; ++d) {
                f32x4 (&X)[4] = d ? X1 : X0; const LAS bf16_t* ML = d ? ML1 : ML0; const LAS bf16_t* RL = d ? RL1 : RL0; const int t0 = (d ? cb : cf) * 64;
                bf16x8 sf[2]; RW_SF(X, sf);
                if (MODE == 1) {
#pragma unroll
                    for (int tt = 0; tt < 4; ++tt) {
                        const int tl = 16 * tt + fr, j = d ? 63 - tl : tl;
                        f32x4 acc = (f32x4){0.f, 0.f, 0.f, 0.f};
#pragma unroll
                        for (int kk = 0; kk < 2; ++kk) { const LAS bf16_t* qp = RL + j * LT + 32 * kk + 4 * fq; const u32x2 lo = *(const LAS u32x2*)qp, hi = *(const LAS u32x2*)(qp + 16);
                            const u32x4 bw = (u32x4){lo.x, lo.y, hi.x, hi.y}; acc = mfma16(sf[kk], __builtin_bit_cast(bf16x8, bw), acc); }
                        const u32x2 ow = d ? oreg[1][tt] : oreg[0][tt];
                        u32x2 nw; nw.x = pk2(__uint_as_float(ow.x << 16) + acc[0], __uint_as_float(ow.x & 0xffff0000u) + acc[1]); nw.y = pk2(__uint_as_float(ow.y << 16) + acc[2], __uint_as_float(ow.y & 0xffff0000u) + acc[3]);
                        *(u32x2*)(F.obuf() + (size_t)(t0 + tl) * YW + 3072 + h * 64 + 16 * w + 4 * fq) = nw;
                    }
                }
                RW_UPD(X, ML, nin[d], sf);
            }
        }
        if (it + 1 < NIT) RS_OLOAD(it + 1);
        if (MODE == 0 && (it % CPSC) == CPSC - 1) {
            const int sf_ = seg + it / CPSC, sb_ = seg + GSEG - 1 - it / CPSC;
            if (w < 4) {
#pragma unroll
                for (int a = 0; a < 4; ++a) { NSG_AT(0, sf_, a) = X0[a]; NSG_AT(1, sb_, a) = X1[a]; }
            } else {
#pragma unroll
                for (int a = 0; a < 4; ++a)
#pragma unroll
                    for (int r = 0; r < 4; ++r) { const int k = 16 * a + 4 * fq + r, kp = 16 * (w - 4) + fr;
                        MSG_AT(0, sf_)[k * 64 + kp] = (bf16_t)f2bf(X0[a][r]); MSG_AT(1, sb_)[k * 64 + kp] = (bf16_t)f2bf(X1[a][r]); }
            }
        }
        LDS_BARRIER();
    }
#undef RS_OLOAD
#undef RS_ISSUE
#undef RW_SF
#undef RW_UPD
#undef NSG_AT
#undef MSG_AT
}
__device__ __forceinline__ void unpack8(const u32x4 w, float (&v)[8]) {
    v[0] = __uint_as_float(w.x << 16); v[1] = __uint_as_float(w.x & 0xffff0000u); v[2] = __uint_as_float(w.y << 16); v[3] = __uint_as_float(w.y & 0xffff0000u);
    v[4] = __uint_as_float(w.z << 16); v[5] = __uint_as_float(w.z & 0xffff0000u); v[6] = __uint_as_float(w.w << 16); v[7] = __uint_as_float(w.w & 0xffff0000u);
}
__device__ __forceinline__ u32x4 pack8(const float (&v)[8]) { u32x4 w; w.x = pk2(v[0], v[1]); w.y = pk2(v[2], v[3]); w.z = pk2(v[4], v[5]); w.w = pk2(v[6], v[7]); return w; }
template <int NL> __device__ __forceinline__ float group_sum(float v) {
    if (NL == 8) return row_sum8(v);
    v = row_sum16(v);
    if (NL == 32) { const auto r = __builtin_amdgcn_permlane16_swap(__float_as_uint(v), __float_as_uint(v), false, false); v = __uint_as_float(r[0]) + __uint_as_float(r[1]); }
    return v;
}
__device__ __forceinline__ void norm_phase(const Ctx& F, int l) {
    const int gw = blockIdx.x * NWAVES + F.wave, NGW = F.G * NWAVES, lane = F.lane;
    const float* ga = F.in(4) + l * 1024; const float* gb = F.in(5) + l * 2048; const float* bb = F.in(6) + l * 2048; const float* gc = F.in(15) + l * 1024; const float* bc = F.in(16) + l * 1024;
#pragma unroll 1
    for (int t = gw; t < SEQ; t += NGW) {
        bf16_t* orow = F.obuf() + (size_t)t * YW; const bf16_t* prow = F.lbuf() + (size_t)t * LDL;
        float epsA = 1e-6f, epsB = 1e-5f, epsC = 64e-5f; asm volatile("" : "+s"(epsA), "+s"(epsB), "+s"(epsC));
        u32x4 ow[8], gt[8], svw[2]; float bn[2];
#pragma unroll
        for (int j = 0; j < 8; ++j) { ow[j] = *(const u32x4*)(orow + 8 * (64 * j + lane)); gt[j] = *(const u32x4*)(prow + 8 * (64 * j + lane)); }
#pragma unroll
        for (int j = 0; j < 2; ++j) { const int q = 64 * j + lane, hd = q >> 3;
            svw[j] = *(const u32x4*)(F.svb() + (size_t)t * 1024 + 8 * q); bn[j] = F.bons()[(size_t)t * 16 + hd] + F.bons()[((size_t)SEQ + t) * 16 + hd]; }
#pragma unroll
        for (int j = 0; j < 8; ++j) {
            float o[8], g[8], y[8], pg[8], pb[8]; unpack8(ow[j], o); unpack8(gt[j], g);
#pragma unroll
            for (int e = 0; e < 8; ++e) g[e] = siluf_(g[e]);
            {
                const int ch = 8 * (64 * (j < 2 ? j : j < 6 ? j - 2 : j - 6) + lane);
                const float* gsrc = (j < 2 ? ga : j < 6 ? gb : gc) + ch;
                const f32x4 g0 = *(const f32x4*)gsrc, g1 = *(const f32x4*)(gsrc + 4);
                pg[0] = g0.x; pg[1] = g0.y; pg[2] = g0.z; pg[3] = g0.w; pg[4] = g1.x; pg[5] = g1.y; pg[6] = g1.z; pg[7] = g1.w;
                if (j >= 2) { const float* bsrc = (j < 6 ? bb : bc) + ch; const f32x4 b0 = *(const f32x4*)bsrc, b1 = *(const f32x4*)(bsrc + 4);
                    pb[0] = b0.x; pb[1] = b0.y; pb[2] = b0.z; pb[3] = b0.w; pb[4] = b1.x; pb[5] = b1.y; pb[6] = b1.z; pb[7] = b1.w; }
            }
            if (j < 2) {
                float s = 0.f;
#pragma unroll
                for (int e = 0; e < 8; ++e) s += o[e] * o[e];
                const float r = rsqrtf(group_sum<16>(s) * (1.f / 128.f) + epsA);
#pragma unroll
                for (int e = 0; e < 8; ++e) y[e] = o[e] * r * pg[e] * g[e];
            } else if (j < 6) {
                float s = 0.f;
#pragma unroll
                for (int e = 0; e < 8; ++e) s += o[e];
                const float mean = group_sum<32>(s) * (1.f / 256.f); float q = 0.f;
#pragma unroll
                for (int e = 0; e < 8; ++e) { o[e] -= mean; q += o[e] * o[e]; }
                const float r = rsqrtf(group_sum<32>(q) * (1.f / 256.f) + epsB);
#pragma unroll
                for (int e = 0; e < 8; ++e) y[e] = (o[e] * r * pg[e] + pb[e]) * g[e];
            } else {
                float s = 0.f;
#pragma unroll
                for (int e = 0; e < 8; ++e) s += o[e];
                const float mean = group_sum<8>(s) * (1.f / 64.f); float q = 0.f;
#pragma unroll
                for (int e = 0; e < 8; ++e) { o[e] -= mean; q += o[e] * o[e]; }
                const float r = rsqrtf(group_sum<8>(q) * (1.f / 64.f) + epsC);
                float sv[8]; unpack8(svw[j - 6], sv);
#pragma unroll
                for (int e = 0; e < 8; ++e) y[e] = (o[e] * r * pg[e] + pb[e] + bn[j - 6] * sv[e]) * g[e];
            }
            *(u32x4*)(orow + 8 * (64 * j + lane)) = pack8(y);
            if (j & 1) __builtin_amdgcn_sched_barrier(0);
        }
    }
}
constexpr int PB = 9, PH_PER_LAYER = 2 * PB + 2, NPHASE = 1 + 2 * PH_PER_LAYER;

__global__ void __launch_bounds__(NWAVES * 64, 2) fwd_kernel(Args args) {
    extern __shared__ __attribute__((aligned(16))) unsigned char lds_raw[];
    Ctx F;
    F.lds = (LAS unsigned char*)lds_raw;
    const int ph_lo = args.ph_lo, ph_hi = args.ph_hi;
    if (ph_hi < 0) cg::this_grid().sync();
    volatile LAS unsigned* bst = (volatile LAS unsigned*)(F.lds + LDS_BYTES - 64);
    if (threadIdx.x < 16) bst[threadIdx.x] = 0u;
    __syncthreads();
    XcdBarrier gbar = xcd_barrier_post((unsigned*)(args.ws + WS_BAR), bst);
    if (ph_lo == 0) { KArgs* ap = (KArgs*)__builtin_amdgcn_kernarg_segment_ptr(); asm volatile("" : "+s"(ap)); F.ap = ap; F.tid = threadIdx.x; F.G = gridDim.x; rope_table(F); }
#pragma unroll 1
    for (int ph = ph_lo; ph < ph_hi; ++ph) {
        if (ph > ph_lo) { XcdBarrier gb = gbar; asm volatile("" : "+s"(gb.bar), "+s"(gb.x)); xcd_barrier(gb); }
        { KArgs* ap = (KArgs*)__builtin_amdgcn_kernarg_segment_ptr(); asm volatile("" : "+s"(ap)); F.ap = ap;
          int tid = threadIdx.x; asm volatile("" : "+v"(tid)); F.tid = tid; F.lane = tid & 63; F.wave = __builtin_amdgcn_readfirstlane(tid >> 6);
          int G = gridDim.x; asm volatile("" : "+s"(G)); F.G = G; }
        int bid = blockIdx.x; asm volatile("" : "+s"(bid));
        if (ph == 0) { prep_phase(F, 0); continue; }
        const int l = (ph - 1) / PH_PER_LAYER, r = (ph - 1) % PH_PER_LAYER;
        if (r == 2 * PB + 1) { prep_phase(F, l + 1); continue; }
        const int b = r / PB, k = r % PB;
        const bool is_out = (r == 2 * PB);
        if (!is_out) {
            if (k == 1) {
                for (int it = bid; it < NCH * 8; it += F.G) hgrn_local_item(F, l, it >> 3, it & 7);
                { int tid = threadIdx.x; asm volatile("" : "+v"(tid)); F.tid = tid; F.lane = tid & 63; F.wave = __builtin_amdgcn_readfirstlane(tid >> 6); }
                for (int it = bid; it < NCH * 8; it += F.G) ret_local_item(F, it >> 3, it & 7);
            } else if (k == 2) {
                if (bid < 64) chain_seg_item<0, 0>(F, bid >> 3, bid & 7); else if (bid < 192) chain_seg_item<1, 0>(F, (bid - 64) >> 3, (bid - 64) & 7);
                else rwkv_code_pass(F, l, bid - 192, 64);
            } else if (k == 3) {
                for (int it = bid; it < NCH * 16; it += F.G) rwkv_local_item(F, l, it >> 4, it & 15);
            } else if (k == 4) {
                if (bid < 64) chain_seg_item<0, 1>(F, bid >> 3, bid & 7); else if (bid < 192) chain_seg_item<1, 1>(F, (bid - 64) >> 3, (bid - 64) & 7);
                else { rwkv_seg_item<0>(F, (bid - 192) >> 2, GSEG * ((bid - 192) & 3)); __syncthreads(); }
            } else if (k == 5) { if (bid < 16 * NSEGC) rwkv_seg_item<1>(F, bid >> 4, bid & 15); }
            else if (k == 7) norm_phase(F, l);
        }
        const bool xg4 = !is_out && k == 4 && bid >= 192, xg2 = !is_out && k == 2 && bid >= 192 && b == 1;
        const bool is_gemm = is_out || k == 0 || k == 6 || k == 8 || xg4 || xg2;
        if (is_gemm) {
            if (xg2) __syncthreads();
            const int nsub = (!is_out && (k == 8 || (xg4 && b == 0))) ? 2 : 1;
#pragma unroll 1
            for (int sub = 0; sub < nsub; ++sub) {
                pg8::Gemm g; pg8::StaticOrder S; EpiAny E; E.l = l; E.b = b; E.s = 0; E.gcol = 0;
                if (is_out) {
                    g = pg8::Gemm{F.mixbf(), F.WoutT(), 1024, 1024, 1024}; S.init(MTOK, DM, F.G, bid); E.kind = 5;
                } else if (k == 0) {
                    g = pg8::Gemm{F.xg() + (size_t)b * SEQ * DM, F.WinT(), 1024, 1024, 1024}; S.init(SEQ, b == 1 ? 40 * 256 : LDE, F.G, bid); E.kind = 0;
                } else if (k == 6) {
                    g = pg8::Gemm{F.xg() + (size_t)b * SEQ * DM, F.WinT() + (size_t)LDE * DM, 1024, 1024, 1024}; S.init(SEQ, LDL, F.G, bid); E.kind = 1;
                } else if (k == 4 && sub == 0) {
                    g = pg8::Gemm{F.xg() + (size_t)b * SEQ * DM, F.WinT() + (size_t)(LDE + LDL) * DM, 1024, 1024, 1024}; S.init(SEQ, LDLX, 64, bid - 192); E.kind = 6;
                } else if (k == 4) {
                    g = pg8::Gemm{F.xg() + (size_t)(b + 1) * SEQ * DM, F.WinT() + (size_t)(42 * 256) * DM, 1024, 1024, 1024}; S.init(SEQ, 3 * 256, 64, bid - 192); E.kind = 7; E.gcol = 42;
                } else if (k == 2) {
                    g = pg8::Gemm{F.xg() + (size_t)b * SEQ * DM, F.WinT() + (size_t)(40 * 256) * DM, 1024, 1024, 1024}; S.init(SEQ, 2 * 256, 64, bid - 192); E.kind = 7; E.gcol = 40;
                } else {
                    const int sp = bid & 1, seg4 = 2 * sp + sub, koff = 1024 * seg4;
                    g = pg8::Gemm{F.obuf() + koff, F.WcatT() + koff, YW, YW, 1024}; S.init(SEQ, DM, F.G >> 1, bid >> 1); E.kind = 2 + sub; E.s = sp;
                    E.gcol = L_MG + 1024 * (seg4 == 0 ? 0 : (seg4 == 3 ? 2 : 1));
                }
                pg8::gemm_phase<EpiAny, pg8::StaticOrder>(F.lds, g, S, E);
            }
        }
    }
}

extern "C" void kernel_launch(void* const* d_in, const int* in_sizes, int n_in, void* d_out, int out_size, void* d_ws, size_t ws_size, hipStream_t stream) {
    static int grid = 0;
    if (grid == 0) {
        if (n_in != 22 || in_sizes[0] != MTOK * DM || out_size != MTOK * DM || ws_size < WS_END) { fprintf(stderr, "kernel_launch: unexpected problem (n_in %d, in0 %d, out %d, ws %zu)\n", n_in, n_in > 0 ? in_sizes[0] : -1, out_size, ws_size); grid = -1; return; }
        int dev = 0, cus = 0, per_cu = 0;
        if (hipGetDevice(&dev) != hipSuccess || hipDeviceGetAttribute(&cus, hipDeviceAttributeMultiprocessorCount, dev) != hipSuccess) { grid = -1; return; }
        if (hipFuncSetAttribute((const void*)fwd_kernel, hipFuncAttributeMaxDynamicSharedMemorySize, LDS_BYTES) != hipSuccess) { fprintf(stderr, "kernel_launch: hipFuncSetAttribute failed\n"); grid = -1; return; }
        if (hipOccupancyMaxActiveBlocksPerMultiprocessor(&per_cu, (const void*)fwd_kernel, NWAVES * 64, LDS_BYTES) != hipSuccess || per_cu < 1) { fprintf(stderr, "kernel_launch: occupancy query says %d blocks per CU\n", per_cu); (void)hipGetLastError(); grid = -1; return; }
        if (cus < 256) { fprintf(stderr, "kernel_launch: this build deals the segment items one per workgroup and needs 256 CUs (found %d)\n", cus); grid = -1; return; }
        grid = 256;
    }
    if (grid < 0) return;
    if (hipMemsetAsync((char*)d_ws + WS_CTL, 0, CTL_ZERO_BYTES, stream) != hipSuccess) { fprintf(stderr, "kernel_launch: hipMemsetAsync failed\n"); return; }
    Args a{};
    for (int i = 0; i < 22; ++i) a.in[i] = (const float*)d_in[i];
    a.out = (float*)d_out; a.ws = (unsigned char*)d_ws;
    a.ph_lo = 0; a.ph_hi = NPHASE;
    void* kargs[] = {&a};
    hipError_t e = hipLaunchCooperativeKernel((const void*)fwd_kernel, dim3(grid), dim3(NWAVES * 64), kargs, LDS_BYTES, stream);
    if (e != hipSuccess) fprintf(stderr, "kernel_launch: cooperative launch failed: %s (grid %d)\n", hipGetErrorString(e), grid);
}
```

```cpp
#include <hip/hip_runtime.h>
#include <hip/hip_cooperative_groups.h>
#include <cstdio>
#include <cstdint>
namespace cg = cooperative_groups;

#define LAS __attribute__((address_space(3)))
#define GAS __attribute__((address_space(1)))
typedef unsigned short bf16_t;
typedef short bf16x8 __attribute__((ext_vector_type(8)));
typedef float f32x4 __attribute__((ext_vector_type(4)));
typedef float f32x2 __attribute__((ext_vector_type(2)));
typedef unsigned u32x4 __attribute__((ext_vector_type(4)));
typedef unsigned u32x2 __attribute__((ext_vector_type(2)));

constexpr int DM = 1024, NB = 2, SEQ = 8192, MTOK = NB * SEQ, DEPTH = 2;
constexpr int NIN = 18688;
constexpr int LDE = 11520, LDL = 6144, LDLX = 1024;
constexpr int LDEAB = 8192, LDEC = 3328;
constexpr int E_AQ = 0, E_AFF = 1024, E_AFB = 2048, E_AI = 3072, E_BQ = 4096, E_BK = 5120, E_BV = 6144, E_CS = 8192;
constexpr int L_AG = 0, L_BG = 1024, L_CG = 3072, L_MG = 4096;
constexpr int CSHIFT = 3328;
constexpr int YW = 4096;

__device__ __forceinline__ float bf2f(bf16_t h) { return __uint_as_float((unsigned)h << 16); }
typedef __bf16 bf16x2_t __attribute__((ext_vector_type(2)));
__device__ __forceinline__ unsigned pk2(float lo, float hi) { const f32x2 v = {lo, hi}; return __builtin_bit_cast(unsigned, __builtin_convertvector(v, bf16x2_t)); }
__device__ __forceinline__ unsigned f2bf(float f) { return pk2(f, 0.f) & 0xffffu; }
__device__ __forceinline__ float sigmoidf_(float x) { return __builtin_amdgcn_rcpf(1.0f + __builtin_amdgcn_exp2f(-1.4426950408889634f * x)); }
__device__ __forceinline__ float siluf_(float x) { return x * sigmoidf_(x); }
__device__ __forceinline__ float row_sum16(float v) {
    v += __int_as_float(__builtin_amdgcn_update_dpp(0, __float_as_int(v), 0xB1, 0xf, 0xf, false));
    v += __int_as_float(__builtin_amdgcn_update_dpp(0, __float_as_int(v), 0x4E, 0xf, 0xf, false));
    v += __int_as_float(__builtin_amdgcn_update_dpp(0, __float_as_int(v), 0x141, 0xf, 0xf, false));
    v += __int_as_float(__builtin_amdgcn_update_dpp(0, __float_as_int(v), 0x140, 0xf, 0xf, false));
    return v;
}
__device__ __forceinline__ float row_sum8(float v) {
    v += __int_as_float(__builtin_amdgcn_update_dpp(0, __float_as_int(v), 0xB1, 0xf, 0xf, false));
    v += __int_as_float(__builtin_amdgcn_update_dpp(0, __float_as_int(v), 0x4E, 0xf, 0xf, false));
    v += __int_as_float(__builtin_amdgcn_update_dpp(0, __float_as_int(v), 0x141, 0xf, 0xf, false));
    return v;
}
__device__ __forceinline__ float wave_sum(float v) {
    v = row_sum16(v);
    return __uint_as_float((unsigned)__builtin_amdgcn_readlane((int)__float_as_uint(v), 0)) + __uint_as_float((unsigned)__builtin_amdgcn_readlane((int)__float_as_uint(v), 16))
         + __uint_as_float((unsigned)__builtin_amdgcn_readlane((int)__float_as_uint(v), 32)) + __uint_as_float((unsigned)__builtin_amdgcn_readlane((int)__float_as_uint(v), 48));
}
__device__ __forceinline__ float multi_sum8(const float (&v)[8], int lane) {
    const bool sA = ((lane ^ (lane >> 2)) & 1) != 0, sB = (((lane >> 1) ^ (lane >> 2)) & 1) != 0, sC = (lane & 4) != 0;
    float w[4], x[2];
#pragma unroll
    for (int i = 0; i < 4; ++i) { const float keep = sA ? v[2 * i + 1] : v[2 * i], give = sA ? v[2 * i] : v[2 * i + 1];
        w[i] = keep + __int_as_float(__builtin_amdgcn_update_dpp(0, __float_as_int(give), 0xB1, 0xf, 0xf, false)); }
#pragma unroll
    for (int i = 0; i < 2; ++i) { const float keep = sB ? w[2 * i + 1] : w[2 * i], give = sB ? w[2 * i] : w[2 * i + 1];
        x[i] = keep + __int_as_float(__builtin_amdgcn_update_dpp(0, __float_as_int(give), 0x4E, 0xf, 0xf, false)); }
    float y;
    { const float keep = sC ? x[1] : x[0], give = sC ? x[0] : x[1]; y = keep + __int_as_float(__builtin_amdgcn_update_dpp(0, __float_as_int(give), 0x141, 0xf, 0xf, false)); }
    y += __int_as_float(__builtin_amdgcn_update_dpp(0, __float_as_int(y), 0x128, 0xf, 0xf, false));
    { const auto r = __builtin_amdgcn_permlane16_swap(__float_as_uint(y), __float_as_uint(y), false, false); y = __uint_as_float(r[0]) + __uint_as_float(r[1]); }
    { const auto r = __builtin_amdgcn_permlane32_swap(__float_as_uint(y), __float_as_uint(y), false, false); y = __uint_as_float(r[0]) + __uint_as_float(r[1]); }
    return y;
}
__device__ __forceinline__ constexpr int ms8_lane(int i) { return i < 4 ? i : 11 - i; }
__device__ __forceinline__ int ms8_index(int lane) { return (lane & 4) ? 11 - (lane & 7) : (lane & 7); }
__device__ __forceinline__ float rlf(float x, int k) { return __uint_as_float((unsigned)__builtin_amdgcn_readlane((int)__float_as_uint(x), k)); }
__device__ __forceinline__ f32x4 mfma16(bf16x8 a, bf16x8 b, f32x4 c) { return __builtin_amdgcn_mfma_f32_16x16x32_bf16(a, b, c, 0, 0, 0); }
#define LDS_BARRIER() do { asm volatile("s_waitcnt lgkmcnt(0)" ::: "memory"); __builtin_amdgcn_s_barrier(); asm volatile("" ::: "memory"); } while (0)
namespace pg8 {
constexpr int BM = 256, BK = 64, HALF = 128, HTB = HALF * BK * 2  , STAGE_BYTES = 8 * HTB, NXCD = 8, WGM = 8;

__host__ __device__ __forceinline__ int lds_byte(int r, int c) { const int st = (r >> 4) * 2 + (c >> 5), rr = r & 15, cc = c & 31, ob = rr * 64 + cc * 2; return st * 1024 + (ob ^ (((ob >> 9) & 1) << 5)); }
__host__ __device__ __forceinline__ void stage_rc(int b, int& R, int& C) { const int st = b / 1024, sb = b % 1024, swz = sb ^ (((sb >> 9) & 1) << 5); R = (st >> 1) * 16 + swz / 64; C = (st & 1) * 32 + (swz % 64) / 2; }
__host__ __device__ __forceinline__ int perm32(int rho) { const int n = rho >> 4, i = rho & 15; return 8 * (i >> 2) + 4 * n + (i & 3); }

struct Unit { int pm, pn; };
struct Gemm { const bf16_t* A; const bf16_t* Bt; int lda, ldb, K; };

struct StaticOrder {
    int nM, nN, nwg, G, c;
    __host__ __device__ void init(int M, int N, int G_, int c_) { nM = M / BM; nN = N / BM; nwg = nM * nN; G = G_; c = c_; }
    __host__ __device__ bool next(int i, Unit& u) const {
        const long L = (long)i * G + c; if (L >= nwg) return false;
        int wgid = (int)L; { const int q = nwg / NXCD, r = nwg % NXCD, xcd = wgid % NXCD, off = wgid / NXCD; wgid = (xcd < r ? xcd * (q + 1) : r * (q + 1) + (xcd - r) * q) + off; }
        const int nig = WGM * nN, gid = wgid / nig, fm = gid * WGM, gsz = (nM - fm) < WGM ? (nM - fm) : WGM;
        u.pm = fm + ((wgid % nig) % gsz); u.pn = (wgid % nig) / gsz; return true;
    }
};

__device__ __forceinline__ unsigned cvt_pk_bf16(float lo, float hi) { unsigned r; asm volatile("v_cvt_pk_bf16_f32 %0, %1, %2" : "=v"(r) : "v"(lo), "v"(hi)); return r; }

template <class Epi, class Sched>
__device__ __forceinline__ void gemm_phase(LAS unsigned char* lds, const Gemm g, const Sched& S, const Epi& E) {
    int tid = threadIdx.x; asm volatile("" : "+v"(tid));
    const int wid = __builtin_amdgcn_readfirstlane(tid >> 6), lane = tid & 63, wr = wid >> 2, wc = wid & 3, fr = lane & 15, fq = lane >> 4;
    const int nt = g.K / BK;
    unsigned voffA[2], voffB[2];
#pragma unroll
    for (int i = 0; i < 2; ++i) { int R, C; stage_rc(tid * 16 + i * 8192, R, C); const int Rb = (R & ~31) + perm32(R & 31);
        voffA[i] = (unsigned)(R * g.lda + C) * 2u; voffB[i] = (unsigned)(Rb * g.ldb + C) * 2u; }
    const size_t kstep = (size_t)(BK * 2);
    const size_t hsA = (size_t)HALF * g.lda * 2, hsB = (size_t)HALF * g.ldb * 2;
    const size_t tsA = 2 * hsA, tsB = 2 * hsB;
    const unsigned ldsw = (unsigned)wid * 1024u;
    const int aoff = lds_byte(wr * 64 + fr, fq * 8), boff = lds_byte(wc * 32 + fr, fq * 8);
#define PG8_SA(b, h) (((b) * 2 + (h)) * HTB)
#define PG8_SB(b, h) ((4 + (b) * 2 + (h)) * HTB)
#define PG8_STAGE(bufoff, gbase, voff) do { _Pragma("unroll") for (int _i = 0; _i < 2; ++_i) \
        __builtin_amdgcn_global_load_lds((const unsigned*)((const char*)(gbase) + (voff)[_i]), (LAS unsigned*)(lds + (bufoff) + ldsw + _i * 8192), 16, 0, 0); } while (0)
#define PG8_LDA(dst, b, h) do { _Pragma("unroll") for (int m = 0; m < 4; ++m) _Pragma("unroll") for (int k = 0; k < 2; ++k) dst[m][k] = *(const LAS bf16x8*)(lds + PG8_SA(b, h) + aoff + m * 2048 + k * 1024); } while (0)
#define PG8_LDB(dst, b, h) do { _Pragma("unroll") for (int n = 0; n < 2; ++n) _Pragma("unroll") for (int k = 0; k < 2; ++k) dst[n][k] = *(const LAS bf16x8*)(lds + PG8_SB(b, h) + boff + n * 2048 + k * 1024); } while (0)
#define PG8_MMA(ai, bj, At, Bt) do { __builtin_amdgcn_s_setprio(1); _Pragma("unroll") for (int m = 0; m < 4; ++m) _Pragma("unroll") for (int n = 0; n < 2; ++n) _Pragma("unroll") for (int k = 0; k < 2; ++k) \
        acc[ai][bj][m][n] = __builtin_amdgcn_mfma_f32_16x16x32_bf16(Bt[n][k], At[m][k], acc[ai][bj][m][n], 0, 0, 0); __builtin_amdgcn_s_setprio(0); } while (0)
#define PG8_WAIT_V(n) asm volatile("s_waitcnt vmcnt(" #n ")" ::: "memory")
#define PG8_WAIT_L(n) asm volatile("s_waitcnt lgkmcnt(" #n ")" ::: "memory")
#define PG8_BAR __builtin_amdgcn_s_barrier()
#define PG8_SCHED __builtin_amdgcn_sched_barrier(0)
    Unit cur, nxt; int ui = 0;
    if (!S.next(0, cur)) return;
    f32x4 acc[2][2][4][2];
#pragma unroll
    for (int a = 0; a < 2; ++a)
#pragma unroll
        for (int b = 0; b < 2; ++b)
#pragma unroll
            for (int m = 0; m < 4; ++m)
#pragma unroll
                for (int n = 0; n < 2; ++n) acc[a][b][m][n] = (f32x4){0.f, 0.f, 0.f, 0.f};
    bf16x8 At[4][2], B0[2][2], B1[2][2];
    const char* cA = (const char*)g.A + (size_t)cur.pm * tsA; const char* cB = (const char*)g.Bt + (size_t)cur.pn * tsB;
    PG8_STAGE(PG8_SB(0, 0), cB, voffB); PG8_STAGE(PG8_SB(0, 1), cB + hsB, voffB); PG8_STAGE(PG8_SA(0, 0), cA, voffA); PG8_STAGE(PG8_SA(0, 1), cA + hsA, voffA);
    if (wr == 1) PG8_BAR;
    PG8_WAIT_V(2); PG8_BAR;
    PG8_STAGE(PG8_SB(1, 0), cB + kstep, voffB); PG8_STAGE(PG8_SA(1, 0), cA + kstep, voffA); PG8_STAGE(PG8_SB(1, 1), cB + hsB + kstep, voffB);
    PG8_WAIT_V(6); PG8_BAR;
    for (;;) {
        const bool has_next = S.next(ui + 1, nxt);
        const char* nA = has_next ? (const char*)g.A + (size_t)nxt.pm * tsA : cA; const char* nB = has_next ? (const char*)g.Bt + (size_t)nxt.pn * tsB : cB;
        for (int t = 0; t < nt; t += 2) {
            const bool last = (t == nt - 2);
            const char* a1 = cA + (size_t)(t + 1) * kstep;
            const char* a2 = last ? nA : cA + (size_t)(t + 2) * kstep; const char* b2 = last ? nB : cB + (size_t)(t + 2) * kstep;
            const char* a3 = a2 + kstep; const char* b3 = b2 + kstep;
            PG8_LDB(B0, 0, 0); PG8_LDB(B1, 0, 1); PG8_SCHED; PG8_LDA(At, 0, 0); PG8_STAGE(PG8_SA(1, 1), a1 + hsA, voffA);
            PG8_WAIT_V(8); PG8_WAIT_L(0); PG8_BAR; PG8_MMA(0, 0, At, B0); PG8_MMA(0, 1, At, B1); PG8_BAR; PG8_SCHED;
            PG8_LDA(At, 0, 1); PG8_STAGE(PG8_SB(0, 0), b2, voffB); PG8_STAGE(PG8_SB(0, 1), b2 + hsB, voffB); PG8_STAGE(PG8_SA(0, 0), a2, voffA);
            PG8_WAIT_V(8); PG8_WAIT_L(0); PG8_BAR; PG8_MMA(1, 0, At, B0); PG8_MMA(1, 1, At, B1); PG8_BAR; PG8_SCHED;
            PG8_LDB(B0, 1, 0); PG8_LDB(B1, 1, 1); PG8_SCHED; PG8_LDA(At, 1, 0); PG8_STAGE(PG8_SA(0, 1), a2 + hsA, voffA);
            PG8_WAIT_V(8); PG8_WAIT_L(0); PG8_BAR; PG8_MMA(0, 0, At, B0); PG8_MMA(0, 1, At, B1); PG8_BAR; PG8_SCHED;
            PG8_LDA(At, 1, 1); PG8_STAGE(PG8_SB(1, 0), b3, voffB); PG8_STAGE(PG8_SB(1, 1), b3 + hsB, voffB); PG8_STAGE(PG8_SA(1, 0), a3, voffA);
            PG8_WAIT_V(8); PG8_WAIT_L(0); PG8_BAR; PG8_MMA(1, 0, At, B0); PG8_MMA(1, 1, At, B1); PG8_BAR; PG8_SCHED;
        }
        if (wr == 0) PG8_BAR;
        E(acc, cur, wr, wc, fr, fq);
        if (!has_next) break;
#pragma unroll
        for (int a = 0; a < 2; ++a)
#pragma unroll
            for (int b = 0; b < 2; ++b)
#pragma unroll
                for (int m = 0; m < 4; ++m)
#pragma unroll
                    for (int n = 0; n < 2; ++n) acc[a][b][m][n] = (f32x4){0.f, 0.f, 0.f, 0.f};
        cur = nxt; cA = nA; cB = nB; ++ui;
        if (wr == 1) PG8_BAR;
    }
    PG8_WAIT_V(0);
    PG8_BAR;
#undef PG8_SA
#undef PG8_SB
#undef PG8_STAGE
#undef PG8_LDA
#undef PG8_LDB
#undef PG8_MMA
#undef PG8_WAIT_V
#undef PG8_WAIT_L
#undef PG8_BAR
#undef PG8_SCHED
}
}
struct EpiProj {
    bf16_t* O; int ldc; int silu_lo, silu_hi, sig_lo;
    __device__ __forceinline__ void operator()(const f32x4 (&acc)[2][2][4][2], const pg8::Unit& u, int wr, int wc, int fr, int fq) const {
        const int pn = u.pn;
        const int act = (pn >= silu_lo && pn < silu_hi) ? 1 : (pn >= sig_lo ? 2 : 0);
        const int row0 = u.pm * 256 + wr * 64 + fr, col0 = pn * 256 + wc * 32 + 8 * fq;
#pragma unroll
        for (int ai = 0; ai < 2; ++ai)
#pragma unroll
            for (int m = 0; m < 4; ++m) {
                const int row = row0 + ai * 128 + m * 16; bf16_t* rowp = O + (size_t)row * ldc + col0;
#pragma unroll
                for (int bj = 0; bj < 2; ++bj) {
                    float v[8];
#pragma unroll
                    for (int j = 0; j < 4; ++j) { v[j] = acc[ai][bj][m][0][j]; v[4 + j] = acc[ai][bj][m][1][j]; }
                    if (act == 1) {
#pragma unroll
                        for (int j = 0; j < 8; ++j) v[j] = siluf_(v[j]);
                    } else if (act == 2) {
#pragma unroll
                        for (int j = 0; j < 8; ++j) v[j] = sigmoidf_(v[j]);
                    }
                    u32x4 w; w.x = pg8::cvt_pk_bf16(v[0], v[1]); w.y = pg8::cvt_pk_bf16(v[2], v[3]); w.z = pg8::cvt_pk_bf16(v[4], v[5]); w.w = pg8::cvt_pk_bf16(v[6], v[7]);
                    *(u32x4*)(rowp + bj * 128) = w;
                }
            }
    }
};
template <int KIND> struct EpiMix {
    const bf16_t* gate; int ldg; float* part; bf16_t* outbf;
    __device__ __forceinline__ void operator()(const f32x4 (&acc)[2][2][4][2], const pg8::Unit& u, int wr, int wc, int fr, int fq) const {
        const int row0 = u.pm * 256 + wr * 64 + fr, col0 = u.pn * 256 + wc * 32 + 8 * fq;
#pragma unroll
        for (int ai = 0; ai < 2; ++ai)
#pragma unroll
            for (int m = 0; m < 4; ++m) {
                const int row = row0 + ai * 128 + m * 16;
#pragma unroll
                for (int bj = 0; bj < 2; ++bj) {
                    const int col = col0 + bj * 128;
                    const u32x4 gw = *(const u32x4*)(gate + (size_t)row * ldg + col);
                    float gv[8]; gv[0] = __uint_as_float(gw.x << 16); gv[1] = __uint_as_float(gw.x & 0xffff0000u); gv[2] = __uint_as_float(gw.y << 16); gv[3] = __uint_as_float(gw.y & 0xffff0000u);
                    gv[4] = __uint_as_float(gw.z << 16); gv[5] = __uint_as_float(gw.z & 0xffff0000u); gv[6] = __uint_as_float(gw.w << 16); gv[7] = __uint_as_float(gw.w & 0xffff0000u);
                    float* pp = part + (size_t)row * 1024 + col;
                    f32x4 p0 = (f32x4){0.f, 0.f, 0.f, 0.f}, p1 = p0;
                    if (KIND != 0) { p0 = *(const f32x4*)pp; p1 = *(const f32x4*)(pp + 4); }
#pragma unroll
                    for (int j = 0; j < 4; ++j) { p0[j] += gv[j] * acc[ai][bj][m][0][j]; p1[j] += gv[4 + j] * acc[ai][bj][m][1][j]; }
                    if (KIND != 2) { *(f32x4*)pp = p0; *(f32x4*)(pp + 4) = p1; }
                    else { u32x4 w; w.x = pg8::cvt_pk_bf16(p0[0], p0[1]); w.y = pg8::cvt_pk_bf16(p0[2], p0[3]); w.z = pg8::cvt_pk_bf16(p1[0], p1[1]); w.w = pg8::cvt_pk_bf16(p1[2], p1[3]);
                        *(u32x4*)(outbf + (size_t)row * 1024 + col) = w; }
                }
            }
    }
};
struct EpiOut {
    const float* base; float* out;
    __device__ __forceinline__ void operator()(const f32x4 (&acc)[2][2][4][2], const pg8::Unit& u, int wr, int wc, int fr, int fq) const {
        const int row0 = u.pm * 256 + wr * 64 + fr, col0 = u.pn * 256 + wc * 32 + 8 * fq;
#pragma unroll
        for (int ai = 0; ai < 2; ++ai)
#pragma unroll
            for (int mp = 0; mp < 2; ++mp) {
                f32x4 bv[2][2][2];
#pragma unroll
                for (int mi = 0; mi < 2; ++mi)
#pragma unroll
                    for (int bj = 0; bj < 2; ++bj) { const size_t off = (size_t)(row0 + ai * 128 + (2 * mp + mi) * 16) * 1024 + col0 + bj * 128;
                        bv[mi][bj][0] = *(const f32x4*)(base + off); bv[mi][bj][1] = *(const f32x4*)(base + off + 4); }
#pragma unroll
                for (int mi = 0; mi < 2; ++mi)
#pragma unroll
                    for (int bj = 0; bj < 2; ++bj) { const int m = 2 * mp + mi; const size_t off = (size_t)(row0 + ai * 128 + m * 16) * 1024 + col0 + bj * 128;
                        *(f32x4*)(out + off) = bv[mi][bj][0] + acc[ai][bj][m][0]; *(f32x4*)(out + off + 4) = bv[mi][bj][1] + acc[ai][bj][m][1]; }
            }
    }
};

constexpr size_t MiB = 1u << 20;
constexpr size_t WS_CTL = 0, WS_ROPE = 1 * MiB, WS_RSTD = 5 * MiB, WS_LWT = 5 * MiB + 128 * 1024  , WS_WIN = 6 * MiB, WS_WCAT = 43 * MiB, WS_WOUT = 51 * MiB, WS_XG = 53 * MiB, WS_MIXBF = 85 * MiB,
                 WS_EAB = 117 * MiB, WS_EC = 245 * MiB, WS_L = 117 * MiB  , WS_OBUF = 297 * MiB,
                 WS_QTA = 361 * MiB, WS_KTA = 393 * MiB, WS_VTA = 425 * MiB, WS_DA = 441 * MiB, WS_QTB = 442 * MiB, WS_KTB = 474 * MiB, WS_VTB = 506 * MiB, WS_SLOC = 538 * MiB, WS_DSEG = 562 * MiB, WS_CSEG = 563 * MiB, WS_CMSEG = 571 * MiB, WS_END = 583 * MiB,
                 WS_RH = 117 * MiB, WS_MI = 149 * MiB, WS_NI = 181 * MiB  ,
                 WS_SV = 458 * MiB, WS_BONS = 490 * MiB  , WS_LX = 213 * MiB  , WS_CODE = 213 * MiB  , WS_PIA = 491 * MiB, WS_PIB = 575 * MiB  , WS_PART = 361 * MiB;
static_assert(WS_WIN + (size_t)NIN * DM * 2 <= WS_WCAT && WS_EAB + (size_t)SEQ * LDEAB * 2 <= WS_EC && WS_EC + (size_t)SEQ * LDEC * 2 <= WS_OBUF && WS_NI + 32 * MiB <= WS_EC && WS_END <= 584 * MiB, "d_ws map");
constexpr size_t WS_BAR = 4096, CTL_ZERO_BYTES = 65536;
constexpr int LDS_BYTES = 147456;
constexpr int NWAVES = 8;

struct Args {
    const float* in[22]; float* out; unsigned char* ws; int ph_lo, ph_hi;
};
typedef const __attribute__((address_space(4))) Args KArgs;
struct Ctx {
    LAS unsigned char* lds; int tid, lane, wave, G; KArgs* ap;
    __device__ __forceinline__ const float* in(int i) const { return ap->in[i]; }
    __device__ __forceinline__ float* out() const { return ap->out; }
    __device__ __forceinline__ unsigned char* ws() const { return ap->ws; }
    __device__ __forceinline__ f32x2* rope() const { return (f32x2*)(ap->ws + WS_ROPE); }
    __device__ __forceinline__ bf16_t* lwt() const { return (bf16_t*)(ap->ws + WS_LWT); }
    __device__ __forceinline__ float* rstd() const { return (float*)(ap->ws + WS_RSTD); }
    __device__ __forceinline__ float* part() const { return (float*)(ap->ws + WS_PART); }
    __device__ __forceinline__ bf16_t* WinT() const { return (bf16_t*)(ap->ws + WS_WIN); }
    __device__ __forceinline__ bf16_t* WcatT() const { return (bf16_t*)(ap->ws + WS_WCAT); }
    __device__ __forceinline__ bf16_t* WoutT() const { return (bf16_t*)(ap->ws + WS_WOUT); }
    __device__ __forceinline__ bf16_t* xg() const { return (bf16_t*)(ap->ws + WS_XG); }
    __device__ __forceinline__ bf16_t* mixbf() const { return (bf16_t*)(ap->ws + WS_MIXBF); }
    __device__ __forceinline__ bf16_t* eab() const { return (bf16_t*)(ap->ws + WS_EAB); }
    __device__ __forceinline__ bf16_t* ecb() const { return (bf16_t*)(ap->ws + WS_EC); }
    __device__ __forceinline__ bf16_t* lbuf() const { return (bf16_t*)(ap->ws + WS_L); }
    __device__ __forceinline__ bf16_t* lxbuf() const { return (bf16_t*)(ap->ws + WS_LX); }
    __device__ __forceinline__ bf16_t* qta() const { return (bf16_t*)(ap->ws + WS_QTA); }
    __device__ __forceinline__ bf16_t* kta() const { return (bf16_t*)(ap->ws + WS_KTA); }
    __device__ __forceinline__ bf16_t* vta() const { return (bf16_t*)(ap->ws + WS_VTA); }
    __device__ __forceinline__ float* da() const { return (float*)(ap->ws + WS_DA); }
    __device__ __forceinline__ bf16_t* qtb() const { return (bf16_t*)(ap->ws + WS_QTB); }
    __device__ __forceinline__ bf16_t* ktb() const { return (bf16_t*)(ap->ws + WS_KTB); }
    __device__ __forceinline__ bf16_t* vtb() const { return (bf16_t*)(ap->ws + WS_VTB); }
    __device__ __forceinline__ bf16_t* obuf() const { return (bf16_t*)(ap->ws + WS_OBUF); }
    __device__ __forceinline__ float* sloc() const { return (float*)(ap->ws + WS_SLOC); }
    __device__ __forceinline__ float* dseg() const { return (float*)(ap->ws + WS_DSEG); }
    __device__ __forceinline__ float* cseg() const { return (float*)(ap->ws + WS_CSEG); }
    __device__ __forceinline__ bf16_t* cmseg() const { return (bf16_t*)(ap->ws + WS_CMSEG); }
    __device__ __forceinline__ bf16_t* codeb() const { return (bf16_t*)(ap->ws + WS_CODE); }
    __device__ __forceinline__ bf16_t* pia() const { return (bf16_t*)(ap->ws + WS_PIA); }
    __device__ __forceinline__ bf16_t* pib() const { return (bf16_t*)(ap->ws + WS_PIB); }
    __device__ __forceinline__ bf16_t* rhi() const { return (bf16_t*)(ap->ws + WS_RH); }
    __device__ __forceinline__ bf16_t* mi() const { return (bf16_t*)(ap->ws + WS_MI); }
    __device__ __forceinline__ bf16_t* ni() const { return (bf16_t*)(ap->ws + WS_NI); }
    __device__ __forceinline__ bf16_t* svb() const { return (bf16_t*)(ap->ws + WS_SV); }
    __device__ __forceinline__ float* bons() const { return (float*)(ap->ws + WS_BONS); }
};
#define LDS_WAIT() asm volatile("s_waitcnt lgkmcnt(0)" ::: "memory")

__device__ __forceinline__ int win_row(int n) { return n < 4096 ? n : n < 5120 ? 11520 + (n - 4096) : n < 9216 ? 4096 + (n - 5120) : n < 11264 ? 11520 + 1024 + (n - 9216) : n < 14592 ? 8192 + (n - 11264) : n < 15616 ? 11520 + 3072 + (n - 14592) : 11520 + 4096 + (n - 15616); }
__device__ __forceinline__ void transpose_item(const float* W, int N, bf16_t* WT, int ldt, int koff, LAS float* scr, int item, int lane, bool permin = false) {
    const int nblk = N / 64, kb = item / nblk, nb = item % nblk, k0 = 64 * kb, n0 = 64 * nb; const int r0 = permin ? win_row(n0) : n0;
#pragma unroll
    for (int ih = 0; ih < 2; ++ih) {
        float wv[32];
#pragma unroll
        for (int i = 0; i < 32; ++i) wv[i] = W[(size_t)(k0 + 32 * ih + i) * N + n0 + lane];
#pragma unroll
        for (int i = 0; i < 32; ++i) scr[(32 * ih + i) * 65 + lane] = wv[i];
    }
    LDS_WAIT(); asm volatile("" ::: "memory");
    const int c = lane & 7;
#pragma unroll
    for (int j = 0; j < 8; ++j) { const int n = (lane >> 3) + 8 * j; const LAS float* s = scr + (8 * c) * 65 + n;
        u32x4 o; o.x = pk2(s[0 * 65], s[1 * 65]); o.y = pk2(s[2 * 65], s[3 * 65]); o.z = pk2(s[4 * 65], s[5 * 65]); o.w = pk2(s[6 * 65], s[7 * 65]);
        *(u32x4*)(WT + (size_t)(r0 + n) * ldt + koff + k0 + 8 * c) = o; }
    LDS_WAIT(); asm volatile("" ::: "memory");
}

__device__ __forceinline__ void prep_phase(const Ctx& F, int l) {
    const int gw = blockIdx.x * NWAVES + F.wave, NGW = F.G * NWAVES;
    if (l < 2) {
        LAS float* scr = (LAS float*)(F.lds + F.wave * 16640);
        const float* Win = F.in(2) + (size_t)l * DM * NIN;
        const float* Wa = F.in(17) + (size_t)l * 1024 * 1024; const float* Wb = F.in(18) + (size_t)l * 2048 * 1024; const float* Wc = F.in(19) + (size_t)l * 1024 * 1024; const float* Wo = F.in(20) + (size_t)l * 1024 * 1024;
        constexpr int I_IN = 16 * (NIN / 64), I_A = 16 * 16, I_B = 32 * 16, I_C = 16 * 16, I_O = 16 * 16, I_L = 4 * 16;
        for (int it = gw; it < I_IN + I_A + I_B + I_C + I_O + I_L; it += NGW) {
            int r = it;
            if (r < I_L) { const int gi = r >> 4, kind = gi >> 1, d = gi & 1;
                transpose_item((kind == 0 ? F.in(9) : F.in(11)) + (size_t)(l * 2 + d) * 65536, 1024, F.lwt() + (size_t)gi * 65536, 64, 0, scr, r & 15, F.lane); continue; } r -= I_L;
            if (r < I_IN) { transpose_item(Win, NIN, F.WinT(), 1024, 0, scr, r, F.lane, true); continue; } r -= I_IN;
            if (r < I_A) { transpose_item(Wa, 1024, F.WcatT(), 4096, 0, scr, r, F.lane); continue; } r -= I_A;
            if (r < I_B) { transpose_item(Wb, 1024, F.WcatT(), 4096, 1024, scr, r, F.lane); continue; } r -= I_B;
            if (r < I_C) { transpose_item(Wc, 1024, F.WcatT(), 4096, 3072, scr, r, F.lane); continue; } r -= I_C;
            transpose_item(Wo, 1024, F.WoutT(), 1024, 0, scr, r, F.lane);
        }
    }
    const float* xsrc = (l == 0) ? F.in(0) : F.out();
    const float* gsrc = (l < 2) ? F.in(1) + l * DM : F.in(21);
    f32x4 g4[4];
#pragma unroll
    for (int j = 0; j < 4; ++j) g4[j] = *((const f32x4*)gsrc + F.lane + 64 * j);
    f32x4 v[4];
#pragma unroll
    for (int j = 0; j < 4; ++j) v[j] = *((const f32x4*)(xsrc + (size_t)gw * DM) + F.lane + 64 * j);
    for (int m = gw; m < MTOK; m += NGW) {
        const int mn = m + NGW < MTOK ? m + NGW : m;
        f32x4 nv[4];
#pragma unroll
        for (int j = 0; j < 4; ++j) nv[j] = *((const f32x4*)(xsrc + (size_t)mn * DM) + F.lane + 64 * j);
        float s = 0.f;
#pragma unroll
        for (int j = 0; j < 4; ++j) s += (v[j].x * v[j].x + v[j].y * v[j].y) + (v[j].z * v[j].z + v[j].w * v[j].w);
        float eps_ = 1e-6f; asm volatile("" : "+s"(eps_));
        const float rs = rsqrtf(wave_sum(s) * (1.f / DM) + eps_);
        if (l < 2) {
            unsigned long long* o8 = (unsigned long long*)(F.xg() + (size_t)m * DM) + F.lane;
#pragma unroll
            for (int j = 0; j < 4; ++j) { const f32x4 gg = g4[j] * rs;
                o8[64 * j] = (unsigned long long)pk2(v[j].x * gg.x, v[j].y * gg.y) | ((unsigned long long)pk2(v[j].z * gg.z, v[j].w * gg.w) << 32); }
        } else {
            f32x4* orow = (f32x4*)(F.out() + (size_t)m * DM) + F.lane;
#pragma unroll
            for (int j = 0; j < 4; ++j) orow[64 * j] = v[j] * rs * g4[j];
        }
#pragma unroll
        for (int j = 0; j < 4; ++j) v[j] = nv[j];
    }
}

__device__ __forceinline__ void rope_table(const Ctx& F) {
    for (int idx = blockIdx.x * 512 + F.tid; idx < SEQ * 64; idx += F.G * 512) {
        const int t = idx >> 6, j = idx & 63;
        const float inv = (float)exp2(-(double)(2 * j) * (13.287712379549449 / 128.0));
        const float ang = (float)t * inv;
        const double rev = (double)ang * 0.15915494309189535; const double fr = rev - rint(rev);
        const float x = (float)(fr * 6.283185307179586);
        F.rope()[idx] = (f32x2){cosf(x), sinf(x)};
    }
}
constexpr size_t WS_MIXCNT = 32768;
struct EpiAny {
    int kind, l, b, s, gcol;
    __device__ __forceinline__ bool stores16() const { return kind <= 1; }
    __device__ __forceinline__ void operator()(const f32x4 (&acc)[2][2][4][2], const pg8::Unit& u, int wr, int wc, int fr, int fq) const {
        Ctx F; { KArgs* ap = (KArgs*)__builtin_amdgcn_kernarg_segment_ptr(); asm volatile("" : "+s"(ap)); F.ap = ap; }
        if (kind == 0) {
            if (u.pn < 32) { EpiProj e{F.eab(), LDEAB, 0, 4, 1 << 30}; e(acc, u, wr, wc, fr, fq); }
            else { EpiProj e{F.ecb() - 32 * 256, LDEC, 0, 0, 1 << 30}; e(acc, u, wr, wc, fr, fq); }
        }
        else if (kind == 1) { EpiProj e{F.lbuf(), LDL, 0, 0, 16};     e(acc, u, wr, wc, fr, fq); }
        else if (kind == 7) { EpiProj e{F.ecb() + (gcol - 32) * 256, LDEC, 0, 0, 1 << 30}; e(acc, u, wr, wc, fr, fq); }
        else if (kind == 6) { EpiProj e{F.lxbuf(), LDLX, 0, 0, 0}; e(acc, u, wr, wc, fr, fq); }
        else if (kind == 5) { EpiOut e{l == 0 ? F.in(0) : F.out(), F.out()}; e(acc, u, wr, wc, fr, fq); }
        else {
            const bool gx = gcol >= LDL;
            const bf16_t* gate = gx ? F.lxbuf() : F.lbuf() + gcol; const int ldg = gx ? LDLX : LDL; bf16_t* mine = (bf16_t*)F.part() + (size_t)s * SEQ * DM;
            const int row0 = u.pm * 256 + wr * 64 + fr, col0 = u.pn * 256 + wc * 32 + 8 * fq;
#pragma unroll
            for (int ai = 0; ai < 2; ++ai)
#pragma unroll
                for (int mp = 0; mp < 2; ++mp) {
                    u32x4 gwv[2][2], pwv[2][2];
#pragma unroll
                    for (int mi = 0; mi < 2; ++mi)
#pragma unroll
                        for (int bj = 0; bj < 2; ++bj) { const int row = row0 + ai * 128 + (2 * mp + mi) * 16, col = col0 + bj * 128;
                            gwv[mi][bj] = *(const u32x4*)(gate + (size_t)row * ldg + col);
                            if (kind == 3) pwv[mi][bj] = *(const u32x4*)(mine + (size_t)row * 1024 + col); else pwv[mi][bj] = (u32x4){0u, 0u, 0u, 0u}; }
#pragma unroll
                    for (int mi = 0; mi < 2; ++mi)
#pragma unroll
                        for (int bj = 0; bj < 2; ++bj) { const int m = 2 * mp + mi; const int row = row0 + ai * 128 + m * 16, col = col0 + bj * 128;
                            const u32x4 gw = gwv[mi][bj], pw = pwv[mi][bj];
                            const f32x4 g0 = (f32x4){__uint_as_float(gw.x << 16), __uint_as_float(gw.x & 0xffff0000u), __uint_as_float(gw.y << 16), __uint_as_float(gw.y & 0xffff0000u)};
                            const f32x4 g1 = (f32x4){__uint_as_float(gw.z << 16), __uint_as_float(gw.z & 0xffff0000u), __uint_as_float(gw.w << 16), __uint_as_float(gw.w & 0xffff0000u)};
                            f32x4 p0 = g0 * acc[ai][bj][m][0], p1 = g1 * acc[ai][bj][m][1];
                            p0 += (f32x4){__uint_as_float(pw.x << 16), __uint_as_float(pw.x & 0xffff0000u), __uint_as_float(pw.y << 16), __uint_as_float(pw.y & 0xffff0000u)};
                            p1 += (f32x4){__uint_as_float(pw.z << 16), __uint_as_float(pw.z & 0xffff0000u), __uint_as_float(pw.w << 16), __uint_as_float(pw.w & 0xffff0000u)};
                            u32x4 w; w.x = pg8::cvt_pk_bf16(p0[0], p0[1]); w.y = pg8::cvt_pk_bf16(p0[2], p0[3]); w.z = pg8::cvt_pk_bf16(p1[0], p1[1]); w.w = pg8::cvt_pk_bf16(p1[2], p1[3]);
                            *(u32x4*)(mine + (size_t)row * 1024 + col) = w; }
                }
            if (kind == 3) {
                extern __shared__ __attribute__((aligned(16))) unsigned char lds_dyn[];
                volatile LAS unsigned* flag = (volatile LAS unsigned*)((LAS unsigned char*)lds_dyn + LDS_BYTES - 32);
                asm volatile("s_waitcnt vmcnt(0)" ::: "memory");
                __syncthreads();
                if (threadIdx.x == 0) {
                    unsigned* cnt = (unsigned*)(F.ws() + WS_MIXCNT) + 64 * (u.pm * 4 + u.pn);
                    __builtin_amdgcn_fence(__ATOMIC_RELEASE, "agent");
                    asm volatile("s_waitcnt vmcnt(0)" ::: "memory");
                    const unsigned old = __hip_atomic_fetch_add(cnt, 1u, __ATOMIC_RELAXED, __HIP_MEMORY_SCOPE_AGENT);
                    if (old & 1u) { __builtin_amdgcn_fence(__ATOMIC_ACQUIRE, "agent"); asm volatile("s_waitcnt vmcnt(0)" ::: "memory"); }
                    flag[0] = old & 1u;
                }
                __syncthreads();
                if (flag[0]) {
                    const bf16_t* other = (const bf16_t*)F.part() + (size_t)(1 - s) * SEQ * DM; bf16_t* outbf = F.mixbf() + (size_t)b * SEQ * DM;
#pragma unroll
                    for (int ai = 0; ai < 2; ++ai)
#pragma unroll
                        for (int mp = 0; mp < 2; ++mp) {
                            u32x4 pwv[2][2], qwv[2][2];
#pragma unroll
                            for (int mi = 0; mi < 2; ++mi)
#pragma unroll
                                for (int bj = 0; bj < 2; ++bj) { const size_t off = (size_t)(row0 + ai * 128 + (2 * mp + mi) * 16) * 1024 + col0 + bj * 128; pwv[mi][bj] = *(const u32x4*)(other + off); qwv[mi][bj] = *(const u32x4*)(mine + off); }
#pragma unroll
                            for (int mi = 0; mi < 2; ++mi)
#pragma unroll
                                for (int bj = 0; bj < 2; ++bj) { const size_t off = (size_t)(row0 + ai * 128 + (2 * mp + mi) * 16) * 1024 + col0 + bj * 128; const u32x4 pw = pwv[mi][bj], qw = qwv[mi][bj];
                                    const f32x4 a0 = (f32x4){__uint_as_float(qw.x << 16), __uint_as_float(qw.x & 0xffff0000u), __uint_as_float(qw.y << 16), __uint_as_float(qw.y & 0xffff0000u)} + (f32x4){__uint_as_float(pw.x << 16), __uint_as_float(pw.x & 0xffff0000u), __uint_as_float(pw.y << 16), __uint_as_float(pw.y & 0xffff0000u)};
                                    const f32x4 a1 = (f32x4){__uint_as_float(qw.z << 16), __uint_as_float(qw.z & 0xffff0000u), __uint_as_float(qw.w << 16), __uint_as_float(qw.w & 0xffff0000u)} + (f32x4){__uint_as_float(pw.z << 16), __uint_as_float(pw.z & 0xffff0000u), __uint_as_float(pw.w << 16), __uint_as_float(pw.w & 0xffff0000u)};
                                    u32x4 w; w.x = pg8::cvt_pk_bf16(a0[0], a0[1]); w.y = pg8::cvt_pk_bf16(a0[2], a0[3]); w.z = pg8::cvt_pk_bf16(a1[0], a1[1]); w.w = pg8::cvt_pk_bf16(a1[2], a1[3]);
                                    *(u32x4*)(outbf + off) = w; }
                        }
                }
                __syncthreads();
            }
        }
    }
};
#define XB_TMO      128
#define XB_XCNT(j)  (256  + 64 * (j))
#define XB_XSUB(j)  (1280 + 64 * (j))
#define XB_XGEN(j)  (2304 + 64 * (j))
#define XB_TOP      3328
#define XB_TOPGEN   3392
#define XCD_BAR_WORDS 3456
#define XB_SPIN_CAP (1u << 18)

__device__ __forceinline__ unsigned xb_ld(unsigned* p)              { return __hip_atomic_load(p, __ATOMIC_RELAXED, __HIP_MEMORY_SCOPE_AGENT); }
__device__ __forceinline__ unsigned xb_add(unsigned* p, unsigned v) { return __hip_atomic_fetch_add(p, v, __ATOMIC_RELAXED, __HIP_MEMORY_SCOPE_AGENT); }
__device__ __forceinline__ unsigned xb_xcc_id() { return (unsigned)__builtin_amdgcn_s_getreg((3 << 11) | 20) & 0xFu; }
#define XB_SPIN(cond, bar) do { unsigned _sp = 0; while (cond) { __builtin_amdgcn_s_sleep(1); \
    if ((++_sp & 255u) == 0u) { if (xb_ld(&(bar)[XB_TMO])) break; if (_sp > XB_SPIN_CAP) { atomicAdd(&(bar)[XB_TMO], 1u); break; } } } } while (0)

struct XcdBarrier {
    unsigned* bar; unsigned x;
    volatile LAS unsigned* st;
};

__device__ __forceinline__ XcdBarrier xcd_barrier_post(unsigned* bar, volatile LAS unsigned* st) {
    XcdBarrier b; b.bar = bar; b.x = xb_xcc_id(); b.st = st;
    if (threadIdx.x == 0) (void)xb_add(&bar[XB_XCNT(b.x)], 1u);
    return b;
}
__device__ __forceinline__ void xcd_barrier_complete(unsigned* bar, unsigned x, unsigned& nloc, unsigned& nx) {
    const unsigned G = gridDim.x * gridDim.y * gridDim.z;
    unsigned sum, cnt, mine, sp = 0u;
    for (;;) {
        sum = 0u; cnt = 0u; mine = 0u;
#pragma unroll
        for (unsigned j = 0; j < 16; ++j) { const unsigned c = xb_ld(&bar[XB_XCNT(j)]); sum += c; cnt += (c > 0u) ? 1u : 0u; mine = (j == x) ? c : mine; }
        if (sum == G) break;
        __builtin_amdgcn_s_sleep(1);
        if ((++sp & 255u) == 0u) { if (xb_ld(&bar[XB_TMO])) break; if (sp > XB_SPIN_CAP) { atomicAdd(&bar[XB_TMO], 1u); break; } }
    }
    nloc = mine > 0u ? mine : 1u; nx = cnt > 0u ? cnt : 1u;
}

__device__ __forceinline__ void xcd_barrier(const XcdBarrier& b) {
    asm volatile("s_waitcnt vmcnt(0)" ::: "memory");
    __syncthreads();
    if (threadIdx.x == 0) {
        unsigned* bar = b.bar;
        __builtin_amdgcn_s_waitcnt(0);
        unsigned nloc = b.st[0], nx = b.st[1];
        if (nloc == 0u) { xcd_barrier_complete(bar, b.x, nloc, nx); b.st[0] = nloc; b.st[1] = nx; }
        const unsigned old = xb_add(&bar[XB_XSUB(b.x)], 1u);
        const unsigned gen = old / nloc;
        if (old + 1u == (gen + 1u) * nloc) {
            __builtin_amdgcn_fence(__ATOMIC_RELEASE, "agent");
            asm volatile("s_waitcnt vmcnt(0)" ::: "memory");
            const unsigned og = xb_add(&bar[XB_TOP], 1u);
            const unsigned tg = og / nx;
            if (og + 1u == (tg + 1u) * nx) xb_add(&bar[XB_TOPGEN], 1u);
            else XB_SPIN(xb_ld(&bar[XB_TOPGEN]) == tg, bar);
            __builtin_amdgcn_fence(__ATOMIC_ACQUIRE, "agent");
            xb_add(&bar[XB_XGEN(b.x)], 1u);
            asm volatile("s_waitcnt vmcnt(0)" ::: "memory");
        } else {
            XB_SPIN(xb_ld(&bar[XB_XGEN(b.x)]) == gen, bar);
            __builtin_amdgcn_fence(__ATOMIC_ACQUIRE, "agent");
            asm volatile("s_waitcnt vmcnt(0)" ::: "memory");
        }
    }
    __syncthreads();
}


constexpr int LQ = 136, LT = 72;
constexpr int NCH = SEQ / 64;
constexpr float LOG2E = 1.4426950408889634f;

__device__ __forceinline__ void hgrn_gate(float x, float lb, float& lf2, float& kv) {
    x = fminf(fmaxf(x, -30.f), 30.f);
    const float e = __builtin_amdgcn_exp2f(-LOG2E * x), r = __builtin_amdgcn_rcpf(1.f + e);
    const float f = fmaxf(lb + (1.f - lb) * r, 1e-6f);
    kv = (1.f - lb) * (e * r); lf2 = __builtin_amdgcn_logf(f);
}
__device__ __forceinline__ float ex2c(float x) { return __builtin_amdgcn_exp2f(fminf(x, 115.f)); }
__device__ __forceinline__ void hgrn_local_item(const Ctx& F, int l, int c, int h) {
    LAS bf16_t* QHF = (LAS bf16_t*)F.lds; LAS bf16_t* KHF = QHF + 64 * LQ; LAS bf16_t* QHB = KHF + 64 * LQ; LAS bf16_t* KHB = QHB + 64 * LQ;
    LAS bf16_t* VTL = KHB + 64 * LQ; LAS bf16_t* PL = VTL + 128 * LT; LAS float* TOT = (LAS float*)(PL + 64 * LT);
    const int lane = F.lane, g = F.wave, ch0 = 2 * lane, t0 = c * 64;
    const bf16_t* rp = F.eab() + (size_t)(t0 + 8 * g) * LDEAB + h * 128 + ch0;
    unsigned qw[8], iw[8]; float lff[8][2], lfb[8][2], kf[8][2], kb[8][2];
    float lbf[2] = {0.f, 0.f}, lbb[2] = {0.f, 0.f};
    {
        unsigned fw[8], bw[8];
#pragma unroll
        for (int jj = 0; jj < 8; ++jj) { const bf16_t* r = rp + (size_t)jj * LDEAB; qw[jj] = *(const unsigned*)(r); fw[jj] = *(const unsigned*)(r + 1024); bw[jj] = *(const unsigned*)(r + 2048); iw[jj] = *(const unsigned*)(r + 3072); }
        { const float* lg = F.in(3); const int c0 = h * 128 + ch0;
          const f32x2 g0 = *(const f32x2*)(lg + c0), g1 = *(const f32x2*)(lg + 1024 + c0), g2 = *(const f32x2*)(lg + 2048 + c0), g3 = *(const f32x2*)(lg + 3072 + c0);
          if (l == 1) { lbf[0] = sigmoidf_(g2.x - g0.x); lbf[1] = sigmoidf_(g2.y - g0.y); lbb[0] = sigmoidf_(g3.x - g1.x); lbb[1] = sigmoidf_(g3.y - g1.y); } }
#pragma unroll
        for (int jj = 0; jj < 8; ++jj) {
            hgrn_gate(__uint_as_float(fw[jj] << 16), lbf[0], lff[jj][0], kf[jj][0]); hgrn_gate(__uint_as_float(fw[jj] & 0xffff0000u), lbf[1], lff[jj][1], kf[jj][1]);
            hgrn_gate(__uint_as_float(bw[jj] << 16), lbb[0], lfb[jj][0], kb[jj][0]); hgrn_gate(__uint_as_float(bw[jj] & 0xffff0000u), lbb[1], lfb[jj][1], kb[jj][1]);
        }
    }
    {
        float sf0 = 0.f, sf1 = 0.f, sb0 = 0.f, sb1 = 0.f;
#pragma unroll
        for (int jj = 0; jj < 8; ++jj) { sf0 += lff[jj][0]; sf1 += lff[jj][1]; sb0 += lfb[jj][0]; sb1 += lfb[jj][1]; }
        *(LAS f32x2*)(TOT + g * 128 + ch0) = (f32x2){sf0, sf1}; *(LAS f32x2*)(TOT + 1024 + g * 128 + ch0) = (f32x2){sb0, sb1};
    }
    LDS_BARRIER();
    float offf[2] = {0.f, 0.f}, b31[2] = {0.f, 0.f}, b63[2] = {0.f, 0.f}, offb[2] = {0.f, 0.f}, pb32[2] = {0.f, 0.f}, totb[2] = {0.f, 0.f};
#pragma unroll
    for (int gg = 0; gg < 8; ++gg) {
        const f32x2 tf = *(const LAS f32x2*)(TOT + gg * 128 + ch0), tb = *(const LAS f32x2*)(TOT + 1024 + gg * 128 + ch0);
#pragma unroll
        for (int e = 0; e < 2; ++e) { const float a = e ? tf.y : tf.x, b = e ? tb.y : tb.x;
            offf[e] += gg < g ? a : 0.f; offb[e] += gg < g ? b : 0.f; if (gg < 4) { b31[e] += a; pb32[e] += b; } b63[e] += a; totb[e] += b; }
    }
    const size_t imgF = ((size_t)(0 * NCH + c) * 8 + h) * 8192, imgB = ((size_t)(1 * NCH + c) * 8 + h) * 8192;
    bf16_t* QTg = F.qta(); bf16_t* KTg = F.kta();
    float runf[2] = {offf[0], offf[1]}, runb[2] = {offb[0], offb[1]};
    unsigned ktf[2][4], ktb[2][4], vtw[2][4];
#pragma unroll
    for (int jj = 0; jj < 8; ++jj) {
        const int t = 8 * g + jj;
        const float q[2] = {__uint_as_float(qw[jj] << 16), __uint_as_float(qw[jj] & 0xffff0000u)};
        float qhf[2], khf[2], qtf[2], ktfv[2], qhb[2], khb[2], qtb[2], ktbv[2];
#pragma unroll
        for (int e = 0; e < 2; ++e) {
            runf[e] += lff[jj][e];
            const float bf = runf[e], xf = bf - b31[e];
            qhf[e] = q[e] * ex2c(xf); khf[e] = kf[jj][e] * ex2c(-xf); qtf[e] = q[e] * __builtin_amdgcn_exp2f(bf); ktfv[e] = kf[jj][e] * __builtin_amdgcn_exp2f(b63[e] - bf);
            const float sb = totb[e] - runb[e];
            runb[e] += lfb[jj][e];
            const float xb = sb - (totb[e] - pb32[e]);
            qhb[e] = q[e] * ex2c(xb); khb[e] = kb[jj][e] * ex2c(-xb); qtb[e] = q[e] * __builtin_amdgcn_exp2f(sb); ktbv[e] = kb[jj][e] * __builtin_amdgcn_exp2f(totb[e] - sb);
        }
        *(LAS unsigned*)(QHF + t * LQ + ch0) = pk2(qhf[0], qhf[1]); *(LAS unsigned*)(KHF + t * LQ + ch0) = pk2(khf[0], khf[1]);
        *(LAS unsigned*)(QHB + t * LQ + ch0) = pk2(qhb[0], qhb[1]); *(LAS unsigned*)(KHB + t * LQ + ch0) = pk2(khb[0], khb[1]);
        *(unsigned*)(QTg + imgF + t * 128 + ch0) = pk2(qtf[0], qtf[1]); *(unsigned*)(QTg + imgB + t * 128 + ch0) = pk2(qtb[0], qtb[1]);
#pragma unroll
        for (int e = 0; e < 2; ++e) {
            const unsigned kfb = f2bf(ktfv[e]), kbb = f2bf(ktbv[e]), vb = e ? (iw[jj] >> 16) : (iw[jj] & 0xffffu);
            if (jj & 1) { ktf[e][jj >> 1] |= kfb << 16; ktb[e][jj >> 1] |= kbb << 16; vtw[e][jj >> 1] |= vb << 16; }
            else { ktf[e][jj >> 1] = kfb; ktb[e][jj >> 1] = kbb; vtw[e][jj >> 1] = vb; }
        }
    }
#pragma unroll
    for (int e = 0; e < 2; ++e) {
        const int ch = ch0 + e;
        *(u32x4*)(KTg + imgF + ch * 64 + 8 * g) = (u32x4){ktf[e][0], ktf[e][1], ktf[e][2], ktf[e][3]};
        *(u32x4*)(KTg + imgB + ch * 64 + 8 * g) = (u32x4){ktb[e][0], ktb[e][1], ktb[e][2], ktb[e][3]};
        const u32x4 vv = (u32x4){vtw[e][0], vtw[e][1], vtw[e][2], vtw[e][3]};
        *(u32x4*)(F.vta() + ((size_t)(c * 8 + h) * 128 + ch) * 64 + 8 * g) = vv;
    }
    if (g == 0) {
        *(f32x2*)(F.da() + ((size_t)(0 * NCH + c) * 8 + h) * 128 + ch0) = (f32x2){__builtin_amdgcn_exp2f(b63[0]), __builtin_amdgcn_exp2f(b63[1])};
        *(f32x2*)(F.da() + ((size_t)(1 * NCH + c) * 8 + h) * 128 + ch0) = (f32x2){__builtin_amdgcn_exp2f(totb[0]), __builtin_amdgcn_exp2f(totb[1])};
    }
    LDS_BARRIER();
    {
        const int fr = lane & 15, fq = lane >> 4, jt = g >> 1, n0 = 2 * (g & 1), t = 16 * jt + fr;
        f32x4 af[2] = {(f32x4){0.f, 0.f, 0.f, 0.f}, (f32x4){0.f, 0.f, 0.f, 0.f}}, ab[2] = {af[0], af[0]};
#pragma unroll
        for (int kk = 0; kk < 4; ++kk) {
            const bf16x8 a_f = *(const LAS bf16x8*)(QHF + t * LQ + 32 * kk + 8 * fq), a_b = *(const LAS bf16x8*)(QHB + t * LQ + 32 * kk + 8 * fq);
#pragma unroll
            for (int n = 0; n < 2; ++n) {
                const bf16x8 b_f = *(const LAS bf16x8*)(KHF + (16 * (n0 + n) + fr) * LQ + 32 * kk + 8 * fq), b_b = *(const LAS bf16x8*)(KHB + (16 * (n0 + n) + fr) * LQ + 32 * kk + 8 * fq);
                af[n] = mfma16(b_f, a_f, af[n]); ab[n] = mfma16(b_b, a_b, ab[n]);
            }
        }
#pragma unroll
        for (int n = 0; n < 2; ++n) { const int t2b = 16 * (n0 + n) + 4 * fq; float p[4];
#pragma unroll
            for (int r = 0; r < 4; ++r) p[r] = (t2b + r <= t ? af[n][r] : 0.f) + (t2b + r >= t ? ab[n][r] : 0.f);
            u32x2 ow; ow.x = pk2(p[0], p[1]); ow.y = pk2(p[2], p[3]);
            *(LAS u32x2*)(PL + t * LT + t2b) = ow; }
    }
    LDS_BARRIER();
    *(u32x4*)(F.pia() + ((size_t)(c * 8 + h) * 64 + (F.tid >> 3)) * 64 + (F.tid & 7) * 8) = *(const LAS u32x4*)(PL + (F.tid >> 3) * LT + (F.tid & 7) * 8);
    LDS_BARRIER();
}

__device__ __forceinline__ void ret_local_item(const Ctx& F, int c, int h) {
    LAS bf16_t* QH = (LAS bf16_t*)F.lds; LAS bf16_t* KH = QH + 64 * LQ; LAS bf16_t* VTL = KH + 64 * LQ; LAS bf16_t* PL = VTL + 256 * LT;
    const int lane = F.lane, w = F.wave, t0 = c * 64;
    const float lg2 = __builtin_amdgcn_logf(1.f - __builtin_amdgcn_exp2f((float)(-5 - h)));
    const float scale = 0.08838834764831845f;
    const size_t imgF = ((size_t)(0 * NCH + c) * 8 + h) * 8192, imgB = ((size_t)(1 * NCH + c) * 8 + h) * 8192;
    u32x2 vw_[8];
    {
        const int cq = lane & 31, tg = w * 2 + (lane >> 5), c1 = 2 * cq;
        unsigned kf[4][2];
        unsigned qa_[4], qb_[4], ka_[4], kb_[4]; f32x4 cs_[4];
#pragma unroll
        for (int jj = 0; jj < 4; ++jj) { const int t = 4 * tg + jj; const bf16_t* row = F.eab() + (size_t)(t0 + t) * LDEAB + h * 128 + c1;
            qa_[jj] = *(const unsigned*)(row + E_BQ); qb_[jj] = *(const unsigned*)(row + E_BQ + 64); ka_[jj] = *(const unsigned*)(row + E_BK); kb_[jj] = *(const unsigned*)(row + E_BK + 64);
            cs_[jj] = *(const f32x4*)(F.rope() + (size_t)(t0 + t) * 64 + c1); }
#pragma unroll
        for (int jj = 0; jj < 8; ++jj) vw_[jj] = *(const u32x2*)(F.eab() + (size_t)(t0 + 8 * w + jj) * LDEAB + E_BV + h * 256 + 4 * lane);
#pragma unroll
        for (int jj = 0; jj < 4; ++jj) {
            const int t = 4 * tg + jj;
            const unsigned qa = qa_[jj], qb = qb_[jj], ka = ka_[jj], kbw = kb_[jj];
            const f32x4 cs = cs_[jj];
            const float q1[2] = {__uint_as_float(qa << 16), __uint_as_float(qa & 0xffff0000u)}, q2[2] = {__uint_as_float(qb << 16), __uint_as_float(qb & 0xffff0000u)};
            const float k1[2] = {__uint_as_float(ka << 16), __uint_as_float(ka & 0xffff0000u)}, k2[2] = {__uint_as_float(kbw << 16), __uint_as_float(kbw & 0xffff0000u)};
            const float co[2] = {cs.x, cs.z}, si[2] = {cs.y, cs.w};
            float qh[4], kh[4];
#pragma unroll
            for (int e = 0; e < 2; ++e) { qh[e] = q1[e] * co[e] - q2[e] * si[e]; qh[2 + e] = q2[e] * co[e] + q1[e] * si[e];
                kh[e] = (k1[e] * co[e] - k2[e] * si[e]) * scale; kh[2 + e] = (k2[e] * co[e] + k1[e] * si[e]) * scale; }
            *(LAS unsigned*)(QH + t * LQ + c1) = pk2(qh[0], qh[1]); *(LAS unsigned*)(QH + t * LQ + 64 + c1) = pk2(qh[2], qh[3]);
            *(LAS unsigned*)(KH + t * LQ + c1) = pk2(kh[0], kh[1]); *(LAS unsigned*)(KH + t * LQ + 64 + c1) = pk2(kh[2], kh[3]);
            bf16_t* qf = F.qtb() + imgF + t * 128 + c1;
            *(unsigned*)qf = pk2(qh[0], qh[1]); *(unsigned*)(qf + 64) = pk2(qh[2], qh[3]);
#pragma unroll
            for (int e = 0; e < 4; ++e) { const unsigned a = f2bf(kh[e]);
                if (jj & 1) kf[e][jj >> 1] |= a << 16; else kf[e][jj >> 1] = a; }
        }
#pragma unroll
        for (int e = 0; e < 4; ++e) { const int ch = c1 + (e & 1) + 64 * (e >> 1);
            *(u32x2*)(F.ktb() + imgF + ch * 64 + 4 * tg) = (u32x2){kf[e][0], kf[e][1]}; }
    }
    {
        const int g = w; unsigned vt[4][4];
#pragma unroll
        for (int jj = 0; jj < 8; ++jj) {
            const u32x2 vw = vw_[jj];
            const unsigned v4[4] = {vw.x & 0xffffu, vw.x >> 16, vw.y & 0xffffu, vw.y >> 16};
#pragma unroll
            for (int e = 0; e < 4; ++e) { if (jj & 1) vt[e][jj >> 1] |= v4[e] << 16; else vt[e][jj >> 1] = v4[e]; }
        }
#pragma unroll
        for (int e = 0; e < 4; ++e) { const int ch = 4 * lane + e; const u32x4 vv = (u32x4){vt[e][0], vt[e][1], vt[e][2], vt[e][3]};
            *(u32x4*)(F.vtb() + ((size_t)(c * 8 + h) * 256 + ch) * 64 + 8 * g) = vv; }
    }
    LDS_BARRIER();
    {
        const int fr = lane & 15, fq = lane >> 4, jt = w >> 1, n0 = 2 * (w & 1), t = 16 * jt + fr;
        f32x4 ac[2] = {(f32x4){0.f, 0.f, 0.f, 0.f}, (f32x4){0.f, 0.f, 0.f, 0.f}};
#pragma unroll
        for (int kk = 0; kk < 4; ++kk) {
            const bf16x8 a = *(const LAS bf16x8*)(QH + t * LQ + 32 * kk + 8 * fq);
#pragma unroll
            for (int n = 0; n < 2; ++n) ac[n] = mfma16(*(const LAS bf16x8*)(KH + (16 * (n0 + n) + fr) * LQ + 32 * kk + 8 * fq), a, ac[n]);
        }
#pragma unroll
        for (int n = 0; n < 2; ++n) { const int t2b = 16 * (n0 + n) + 4 * fq; float p[4];
#pragma unroll
            for (int r = 0; r < 4; ++r) { const int dd = t > t2b + r ? t - (t2b + r) : (t2b + r) - t; p[r] = ac[n][r] * __builtin_amdgcn_exp2f((float)dd * lg2); }
            u32x2 ow; ow.x = pk2(p[0], p[1]); ow.y = pk2(p[2], p[3]);
            *(LAS u32x2*)(PL + t * LT + t2b) = ow; }
    }
    LDS_BARRIER();
    *(u32x4*)(F.pib() + ((size_t)(c * 8 + h) * 64 + (F.tid >> 3)) * 64 + (F.tid & 7) * 8) = *(const LAS u32x4*)(PL + (F.tid >> 3) * LT + (F.tid & 7) * 8);
    LDS_BARRIER();
}

constexpr int NSEG = 8, CPS = NCH / NSEG;
template <int MIX, int MODE> __device__ __forceinline__ void chain_seg_item(const Ctx& F, int item, int seg) {
    LAS bf16_t* QL0 = (LAS bf16_t*)F.lds; LAS bf16_t* KL0 = QL0 + 64 * LQ; LAS bf16_t* QL1 = KL0 + 128 * LT; LAS bf16_t* KL1 = QL1 + 64 * LQ; LAS float* DL = (LAS float*)(KL1 + 128 * LT);
    LAS bf16_t* PL0 = (LAS bf16_t*)(DL + 256); LAS bf16_t* PL1 = PL0 + 64 * LT;
    const bf16_t* PI = MIX == 0 ? F.pia() : F.pib();
    const int lane = F.lane, w = F.wave, tid = F.tid, fr = lane & 15, fq = lane >> 4;
    const int h = MIX == 0 ? item : (item >> 1), vhalf = MIX == 0 ? 0 : (item & 1), sitem = MIX == 0 ? item : 8 + item;
    const int ocol = (MIX == 0 ? h * 128 : 1024 + h * 256 + vhalf * 128) + 16 * w + 4 * fq;
    const bf16_t* QT = MIX == 0 ? F.qta() : F.qtb(); const bf16_t* KT = MIX == 0 ? F.kta() : F.ktb(); const bf16_t* VT = MIX == 0 ? F.vta() : F.vtb();
    const int vrow = (MIX == 0 ? 0 : vhalf * 128) + 16 * w + fr, VW = MIX == 0 ? 128 : 256;
    const float g64 = MIX == 1 ? __builtin_amdgcn_exp2f(64.f * __builtin_amdgcn_logf(1.f - __builtin_amdgcn_exp2f((float)(-5 - h)))) : 1.f;
    f32x4* SLOC = (f32x4*)F.sloc(); float* DSEG = F.dseg();
#define SLOC_AT(d_, s_, a_) SLOC[((((size_t)(sitem * 2 + (d_)) * NSEG + (s_)) * 8 + (a_)) * 8 + w) * 64 + lane]
    const float lg2g = MIX == 1 ? __builtin_amdgcn_logf(1.f - __builtin_amdgcn_exp2f((float)(-5 - h))) : 0.f;
    const float gam = 1.f - __builtin_amdgcn_exp2f((float)(-5 - h)), gami = __builtin_amdgcn_rcpf(gam); (void)gam; (void)gami;
    f32x4 S0[8], S1[8];
#pragma unroll
    for (int a = 0; a < 8; ++a) { S0[a] = (f32x4){0.f, 0.f, 0.f, 0.f}; S1[a] = S0[a]; }
    if (MODE == 1) {
        const float gseg = MIX == 1 ? __builtin_amdgcn_exp2f((float)(64 * CPS) * __builtin_amdgcn_logf(1.f - __builtin_amdgcn_exp2f((float)(-5 - h)))) : 1.f;
#pragma unroll 1
        for (int i = 0; i < NSEG - 1; ++i) {
            const bool fw = i < seg; const int s = fw ? i : NSEG - 1 - (i - seg), dI = fw ? 0 : 1;
            f32x4 ld[8], dvv[8];
#pragma unroll
            for (int a = 0; a < 8; ++a) { ld[a] = SLOC_AT(dI, s, a);
                dvv[a] = MIX == 0 ? *(const f32x4*)(DSEG + ((size_t)(h * 2 + dI) * NSEG + s) * 128 + 16 * a + 4 * fq) : (f32x4){gseg, gseg, gseg, gseg}; }
            __builtin_amdgcn_sched_barrier(0);
            if (fw) {
#pragma unroll
                for (int a = 0; a < 8; ++a) S0[a] = S0[a] * dvv[a] + ld[a];
            } else {
#pragma unroll
                for (int a = 0; a < 8; ++a) S1[a] = S1[a] * dvv[a] + ld[a];
            }
        }
    }
    float one_ = 1.f; asm volatile("" : "+v"(one_));
    u32x4 qreg[2][2], kreg[2][2], preg[2]; bf16x8 vreg[2][2]; f32x4 dreg = (f32x4){one_, one_, one_, one_}, dprod = dreg;
#define CS_ISSUE(i_) do { _Pragma("unroll") for (int d = 0; d < 2; ++d) { const int c__ = d ? seg * CPS + CPS - 1 - (i_) : seg * CPS + (i_); const size_t img = ((size_t)((MIX == 1 ? 0 : d) * NCH + c__) * 8 + h) * 8192; \
            _Pragma("unroll") for (int i = 0; i < 2; ++i) { if (MODE == 1) qreg[d][i] = *(const u32x4*)(QT + img + (size_t)(tid + 512 * i) * 8); kreg[d][i] = *(const u32x4*)(KT + img + (size_t)(tid + 512 * i) * 8); } \
            _Pragma("unroll") for (int ks = 0; ks < 2; ++ks) vreg[d][ks] = *(const bf16x8*)(VT + ((size_t)(c__ * 8 + h) * VW + vrow) * 64 + 32 * ks + 8 * fq); \
            if (MODE == 1 && (i_) < CPS / 2) preg[d] = *(const u32x4*)(PI + (size_t)(c__ * 8 + h) * 4096 + (size_t)tid * 8); } \
            if (MIX == 0 && tid < 64) { const int d = tid >> 5; const int c__ = d ? seg * CPS + CPS - 1 - (i_) : seg * CPS + (i_); dreg = *(const f32x4*)(F.da() + ((size_t)(d * NCH + c__) * 8 + h) * 128 + 4 * (tid & 31)); } } while (0)
#define CS_ISSUE_QK(i_, i) do { _Pragma("unroll") for (int d = 0; d < 2; ++d) { const int c__ = d ? seg * CPS + CPS - 1 - (i_) : seg * CPS + (i_); const size_t img = ((size_t)((MIX == 1 ? 0 : d) * NCH + c__) * 8 + h) * 8192; \
            if (MODE == 1) qreg[d][i] = *(const u32x4*)(QT + img + (size_t)(tid + 512 * (i)) * 8); kreg[d][i] = *(const u32x4*)(KT + img + (size_t)(tid + 512 * (i)) * 8); } } while (0)
#define CS_ISSUE_REST(i_) do { _Pragma("unroll") for (int d = 0; d < 2; ++d) { const int c__ = d ? seg * CPS + CPS - 1 - (i_) : seg * CPS + (i_); \
            _Pragma("unroll") for (int ks = 0; ks < 2; ++ks) vreg[d][ks] = *(const bf16x8*)(VT + ((size_t)(c__ * 8 + h) * VW + vrow) * 64 + 32 * ks + 8 * fq); \
            if (MODE == 1 && (i_) < CPS / 2) preg[d] = *(const u32x4*)(PI + (size_t)(c__ * 8 + h) * 4096 + (size_t)tid * 8); } \
            if (MIX == 0 && tid < 64) { const int d = tid >> 5; const int c__ = d ? seg * CPS + CPS - 1 - (i_) : seg * CPS + (i_); dreg = *(const f32x4*)(F.da() + ((size_t)(d * NCH + c__) * 8 + h) * 128 + 4 * (tid & 31)); } } while (0)
    CS_ISSUE(0);
    u32x2 oreg[2][4];
#define CS_OLOAD(i_) do { if (MODE == 1) { const int cf_ = seg * CPS + (i_), cb_ = seg * CPS + CPS - 1 - (i_); _Pragma("unroll") for (int tt = 0; tt < 4; ++tt) { \
            oreg[0][tt] = *(const u32x2*)(F.obuf() + (size_t)(cf_ * 64 + 16 * tt + (F.lane & 15)) * YW + ocol); oreg[1][tt] = *(const u32x2*)(F.obuf() + (size_t)(cb_ * 64 + 16 * tt + (F.lane & 15)) * YW + ocol); } } } while (0)
#pragma unroll 1
    for (int it = 0; it < CPS; ++it) {
        const int cf = seg * CPS + it, cb = seg * CPS + CPS - 1 - it;
        int tid_l = F.tid; asm volatile("" : "+v"(tid_l)); const int tid = tid_l, lane = tid_l & 63, fr = lane & 15, fq = lane >> 4; (void)lane;
#pragma unroll
        for (int i = 0; i < 2; ++i) { const int p = tid + 512 * i;
            if (MODE == 1 && MIX == 1) {
                const int tq = p >> 4;
#pragma unroll
                for (int d2 = 0; d2 < 2; ++d2) { u32x4 qw = qreg[d2][i]; const float sc = __builtin_amdgcn_exp2f((float)(d2 ? 64 - tq : tq + 1) * lg2g);
#pragma unroll
                    for (int e2 = 0; e2 < 4; ++e2) qw[e2] = pk2(__uint_as_float(qw[e2] << 16) * sc, __uint_as_float(qw[e2] & 0xffff0000u) * sc);
                    qreg[d2][i] = qw; }
            }
            if (MODE == 1) { *(LAS u32x4*)(QL0 + (p >> 4) * LQ + (p & 15) * 8) = qreg[0][i]; *(LAS u32x4*)(QL1 + (p >> 4) * LQ + (p & 15) * 8) = qreg[1][i]; }
            if (MIX == 1) {
                const int tq0 = (p & 7) * 8;
#pragma unroll
                for (int d2 = 0; d2 < 2; ++d2) { u32x4 kw = kreg[d2][i];
                    float sc = __builtin_amdgcn_exp2f((float)(d2 ? tq0 : 63 - tq0) * lg2g); const float st = d2 ? gam : gami;
#pragma unroll
                    for (int e2 = 0; e2 < 4; ++e2) { const float s0 = sc, s1 = sc * st; sc = s1 * st;
                        kw[e2] = pk2(__uint_as_float(kw[e2] << 16) * s0, __uint_as_float(kw[e2] & 0xffff0000u) * s1); }
                    kreg[d2][i] = kw; __builtin_amdgcn_sched_barrier(0); }
            }
            *(LAS u32x4*)(KL0 + (p >> 3) * LT + (p & 7) * 8) = kreg[0][i]; *(LAS u32x4*)(KL1 + (p >> 3) * LT + (p & 7) * 8) = kreg[1][i];
            if (it + 1 < CPS) CS_ISSUE_QK(it + 1, i); }
        if (MIX == 0 && tid < 64) { *(LAS f32x4*)(DL + 4 * tid) = dreg; dprod = dprod * dreg; }
        const bool first = MODE == 1 && it < CPS / 2;
        if (first) { *(LAS u32x4*)(PL0 + (tid >> 3) * LT + (tid & 7) * 8) = preg[0]; *(LAS u32x4*)(PL1 + (tid >> 3) * LT + (tid & 7) * 8) = preg[1]; }
        const bf16x8 vf00 = vreg[0][0], vf01 = vreg[0][1], vf10 = vreg[1][0], vf11 = vreg[1][1];
        if (it + 1 < CPS) CS_ISSUE_REST(it + 1);
        LDS_BARRIER();
#pragma unroll
        for (int d = 0; d < 2; ++d) {
            f32x4 (&S)[8] = d ? S1 : S0; const LAS bf16_t* QL = d ? QL1 : QL0; const LAS bf16_t* KL = d ? KL1 : KL0; const int t0 = (d ? cb : cf) * 64;
            if (MODE == 1) {
                bf16x8 sf[4];
#pragma unroll
                for (int kk = 0; kk < 4; ++kk) { u32x4 pw; pw.x = pk2(S[2 * kk][0], S[2 * kk][1]); pw.y = pk2(S[2 * kk][2], S[2 * kk][3]); pw.z = pk2(S[2 * kk + 1][0], S[2 * kk + 1][1]); pw.w = pk2(S[2 * kk + 1][2], S[2 * kk + 1][3]);
                    sf[kk] = __builtin_bit_cast(bf16x8, pw); }
                const LAS bf16_t* PLd = d ? PL1 : PL0; const bf16x8 va0 = d ? vf10 : vf00, va1 = d ? vf11 : vf01;
#pragma unroll
                for (int tt = 0; tt < 4; ++tt) {
                    f32x4 acc = (f32x4){0.f, 0.f, 0.f, 0.f};
                    if (first) {
                        acc = mfma16(va0, *(const LAS bf16x8*)(PLd + (16 * tt + fr) * LT + 8 * fq), acc);
                        acc = mfma16(va1, *(const LAS bf16x8*)(PLd + (16 * tt + fr) * LT + 32 + 8 * fq), acc);
                    }
#pragma unroll
                    for (int kk = 0; kk < 4; ++kk) {
                        const LAS bf16_t* qp = QL + (16 * tt + fr) * LQ + 32 * kk + 4 * fq;
                        const u32x2 lo = *(const LAS u32x2*)qp, hi = *(const LAS u32x2*)(qp + 16);
                        const u32x4 bw = (u32x4){lo.x, lo.y, hi.x, hi.y};
                        acc = mfma16(sf[kk], __builtin_bit_cast(bf16x8, bw), acc);
                    }
                    const u32x2 ow = first ? (u32x2){0u, 0u} : (d ? oreg[1][tt] : oreg[0][tt]);
                    u32x2 nw; nw.x = pk2(__uint_as_float(ow.x << 16) + acc[0], __uint_as_float(ow.x & 0xffff0000u) + acc[1]); nw.y = pk2(__uint_as_float(ow.y << 16) + acc[2], __uint_as_float(ow.y & 0xffff0000u) + acc[3]);
                    *(u32x2*)(F.obuf() + (size_t)(t0 + 16 * tt + fr) * YW + ocol) = nw;
                }
            }
            const bf16x8 vf0 = d ? vf10 : vf00, vf1 = d ? vf11 : vf01;
#pragma unroll
            for (int a = 0; a < 8; ++a) {
                if (MIX == 0) S[a] = S[a] * *(const LAS f32x4*)(DL + d * 128 + 16 * a + 4 * fq); else S[a] = S[a] * g64;
                S[a] = mfma16(*(const LAS bf16x8*)(KL + (16 * a + fr) * LT + 8 * fq), vf0, S[a]);
                S[a] = mfma16(*(const LAS bf16x8*)(KL + (16 * a + fr) * LT + 32 + 8 * fq), vf1, S[a]);
            }
        }
        if (it + 1 < CPS && it + 1 >= CPS / 2) CS_OLOAD(it + 1);
        LDS_BARRIER();
    }
#undef CS_OLOAD
    if (MODE == 0) {
#pragma unroll
        for (int a = 0; a < 8; ++a) { SLOC_AT(0, seg, a) = S0[a]; SLOC_AT(1, seg, a) = S1[a]; }
        if (MIX == 0 && tid < 64) *(f32x4*)(DSEG + ((size_t)(h * 2 + (tid >> 5)) * NSEG + seg) * 128 + 4 * (tid & 31)) = dprod;
    }
#undef CS_ISSUE
#undef CS_ISSUE_QK
#undef CS_ISSUE_REST
#undef SLOC_AT
}
__device__ __forceinline__ void rwkv_code_pass(const Ctx& F, int l, int part, int nparts) {
    const float* mu = F.in(7) + (size_t)l * 2 * CSHIFT + 3072;
    for (int idx = part * 512 + F.tid; idx < SEQ * 32; idx += nparts * 512) {
        const int t = idx >> 5, pc = idx & 31;
        const int tm = t > 0 ? t - 1 : t, tn = t < SEQ - 1 ? t + 1 : t;
        const bf16_t* cb0 = F.ecb() + 3072 + 8 * pc;
        const u32x4 pw = *(const u32x4*)(cb0 + (size_t)t * LDEC);
        const u32x4 mw = *(const u32x4*)(cb0 + (size_t)tm * LDEC) & (t > 0 ? 0xffffffffu : 0u);
        const u32x4 nw = *(const u32x4*)(cb0 + (size_t)tn * LDEC) & (t < SEQ - 1 ? 0xffffffffu : 0u);
        const f32x4 m0a = *(const f32x4*)(mu + 8 * pc), m0b = *(const f32x4*)(mu + 8 * pc + 4), m1a = *(const f32x4*)(mu + CSHIFT + 8 * pc), m1b = *(const f32x4*)(mu + CSHIFT + 8 * pc + 4);
        float o[8];
#pragma unroll
        for (int e2 = 0; e2 < 4; ++e2) {
#pragma unroll
            for (int hl = 0; hl < 2; ++hl) { const int e = 2 * e2 + hl;
                const float p = hl ? __uint_as_float(pw[e2] & 0xffff0000u) : __uint_as_float(pw[e2] << 16), pm = hl ? __uint_as_float(mw[e2] & 0xffff0000u) : __uint_as_float(mw[e2] << 16), pn = hl ? __uint_as_float(nw[e2] & 0xffff0000u) : __uint_as_float(nw[e2] << 16);
                const float m0 = e < 4 ? m0a[e & 3] : m0b[e & 3], m1 = e < 4 ? m1a[e & 3] : m1b[e & 3];
                float s = p + m0 * (pm - p) + m1 * (pn - p);
                if (pc < 16) s = 1.f - 2.f * __builtin_amdgcn_rcpf(1.f + __builtin_amdgcn_exp2f(2.8853900817779268f * s));
                o[e] = s; } }
        u32x4 ow; ow.x = pk2(o[0], o[1]); ow.y = pk2(o[2], o[3]); ow.z = pk2(o[4], o[5]); ow.w = pk2(o[6], o[7]);
        *(u32x4*)(F.codeb() + (size_t)t * 256 + 8 * pc) = ow;
    }
}
__device__ __forceinline__ void rwkv_local_item(const Ctx& F, int l, int c, int h) {
    LAS bf16_t* AL = (LAS bf16_t*)F.lds; LAS bf16_t* BE = AL + 64 * LT; LAS bf16_t* KTL = BE + 64 * LT; LAS bf16_t* RT = KTL + 64 * LT; LAS bf16_t* VT = RT + 64 * LT;
    LAS bf16_t* BBT = VT + 64 * LT; LAS bf16_t* KBT = BBT + 64 * LT; LAS bf16_t* AAB = KBT + 64 * LT; LAS bf16_t* AAK = AAB + 64 * LT; LAS bf16_t* ARB = AAK + 64 * LT; LAS bf16_t* ARK = ARB + 64 * LT;
    LAS bf16_t* XT = ARK + 64 * LT;
    LAS float* DG = (LAS float*)(XT + 128 * LT);
    LAS bf16_t* TB = (LAS bf16_t*)(DG + 1024);
    LAS bf16_t* RKVS = (LAS bf16_t*)(F.lds + 103424);
    LAS float* TOT = (LAS float*)(F.lds + 129024);
    LAS float* PCV = TOT + 1024;
#define RW_FRESH() int tid_l = F.tid; asm volatile("" : "+v"(tid_l)); const int tid = tid_l, lane = tid_l & 63, fr = lane & 15, fq = lane >> 4; (void)tid; (void)fr; (void)fq
    const int w = F.wave, t0 = c * 64; const int lane = F.lane, col = h * 64 + lane;
    const float* mu = F.in(7) + (size_t)l * 2 * CSHIFT;
    const float mr0 = mu[col], mr1 = mu[CSHIFT + col], mk0 = mu[1024 + col], mk1 = mu[CSHIFT + 1024 + col], mv0 = mu[2048 + col], mv1 = mu[CSHIFT + 2048 + col];
    const float kkw = F.in(12)[l * 1024 + col], kaw = F.in(13)[l * 1024 + col], rkw = F.in(14)[l * 1024 + col];
    float sr[8], sk[8], sv[8], kkn[8];
    float lw2r[2][8], ar[2][8];
    bf16_t pr[10], pk[10], pv[10];
    {
        constexpr int LC = 264, LO = 68;
        LAS bf16_t* CODE = (LAS bf16_t*)F.lds; LAS float* LOUT = (LAS float*)(F.lds + 64 * LC * 2);
        bf16x8 la[2][2]; f32x4 lb[2];
        {
            const int gi = w >> 1, kind = gi >> 1, dd = gi & 1, fr0 = lane & 15, fq0 = lane >> 4;
            const bf16_t* A = F.lwt() + ((size_t)gi * 1024 + h * 64) * 64;
            const float* bias = (kind == 0 ? F.in(8) : F.in(10)) + (l * 2 + dd) * 1024 + h * 64;
#pragma unroll
            for (int ci = 0; ci < 2; ++ci) { const int ct = 2 * (w & 1) + ci;
                la[ci][0] = *(const bf16x8*)(A + (size_t)(16 * ct + fr0) * 64 + 8 * fq0); la[ci][1] = *(const bf16x8*)(A + (size_t)(16 * ct + fr0) * 64 + 32 + 8 * fq0);
                lb[ci] = *(const f32x4*)(bias + 16 * ct + 4 * fq0); }
        }
        u32x4 rkvw[4];
#pragma unroll
        for (int i = 0; i < 4; ++i) { int pp = F.tid + 512 * i; pp = pp < 1584 ? pp : 1583; const int kind = pp >= 1056 ? 2 : (pp >= 528 ? 1 : 0), rem = pp - 528 * kind; int t = t0 - 1 + (rem >> 3); t = t < 0 ? 0 : (t >= SEQ ? SEQ - 1 : t);
            rkvw[i] = *(const u32x4*)(F.ecb() + (size_t)t * LDEC + kind * 1024 + h * 64 + (rem & 7) * 8); }
        u32x4 cpw[4];
#pragma unroll
        for (int hh = 0; hh < 4; ++hh) cpw[hh] = *(const u32x4*)(F.codeb() + (size_t)(t0 + (F.tid >> 3)) * 256 + 32 * (F.tid & 7) + 8 * hh);
        {
            RW_FRESH();
            const int tok = tid >> 3, cg = tid & 7;
#pragma unroll
            for (int hh = 0; hh < 4; ++hh) *(LAS u32x4*)(CODE + tok * LC + 32 * cg + 8 * hh) = cpw[hh];
#pragma unroll
            for (int i = 0; i < 4; ++i) { const int pp = tid + 512 * i; const int kind = pp >= 1056 ? 2 : (pp >= 528 ? 1 : 0), rem = pp - 528 * kind; const int tt = t0 - 1 + (rem >> 3);
                const unsigned okm = (tt >= 0 && tt < SEQ) ? 0xffffffffu : 0u;
                if (pp < 1584) *(LAS u32x4*)(RKVS + (kind * 66 + (rem >> 3)) * 64 + (rem & 7) * 8) = rkvw[i] & okm; }
        }
        LDS_BARRIER();
        {
            RW_FRESH();
            const int gi = w >> 1, kind = gi >> 1;
#pragma unroll
            for (int ci = 0; ci < 2; ++ci) {
                const int ct = 2 * (w & 1) + ci;
                const bf16x8 a0 = la[ci][0], a1 = la[ci][1];
                const f32x4 bv = lb[ci];
#pragma unroll
                for (int tt = 0; tt < 4; ++tt) {
                    f32x4 acc = bv;
                    acc = mfma16(a0, *(const LAS bf16x8*)(CODE + (16 * tt + fr) * LC + gi * 64 + 8 * fq), acc);
                    acc = mfma16(a1, *(const LAS bf16x8*)(CODE + (16 * tt + fr) * LC + gi * 64 + 32 + 8 * fq), acc);
                    f32x4 y;
#pragma unroll
                    for (int r = 0; r < 4; ++r) { const float sg = sigmoidf_(acc[r]); y[r] = kind == 0 ? (-0.6065306597126334f * LOG2E) * sg : sg; }
                    *(LAS f32x4*)(LOUT + (gi * 64 + 16 * tt + fr) * LO + 16 * ct + 4 * fq) = y;
                }
            }
        }
        LDS_BARRIER();
#pragma unroll
        for (int dd = 0; dd < 2; ++dd)
#pragma unroll
            for (int jj = 0; jj < 8; ++jj) { lw2r[dd][jj] = LOUT[(dd * 64 + 8 * w + jj) * LO + lane]; ar[dd][jj] = LOUT[((2 + dd) * 64 + 8 * w + jj) * LO + lane]; }
        LDS_BARRIER();
    }
    {
#pragma unroll
        for (int i = 0; i < 10; ++i) { pr[i] = RKVS[(8 * w + i) * 64 + lane]; pk[i] = RKVS[(66 + 8 * w + i) * 64 + lane]; pv[i] = RKVS[(132 + 8 * w + i) * 64 + lane]; }
#pragma unroll
        for (int jj = 0; jj < 8; ++jj) {
            sr[jj] = bf2f(pr[jj + 1]) + mr0 * (bf2f(pr[jj]) - bf2f(pr[jj + 1])) + mr1 * (bf2f(pr[jj + 2]) - bf2f(pr[jj + 1]));
            sk[jj] = bf2f(pk[jj + 1]) + mk0 * (bf2f(pk[jj]) - bf2f(pk[jj + 1])) + mk1 * (bf2f(pk[jj + 2]) - bf2f(pk[jj + 1]));
            sv[jj] = bf2f(pv[jj + 1]) + mv0 * (bf2f(pv[jj]) - bf2f(pv[jj + 1])) + mv1 * (bf2f(pv[jj + 2]) - bf2f(pv[jj + 1]));
            F.svb()[(size_t)(t0 + 8 * w + jj) * 1024 + col] = (bf16_t)f2bf(sv[jj]);
        }
        float kq[8];
#pragma unroll
        for (int jj = 0; jj < 8; ++jj) { const float kkr = sk[jj] * kkw; kq[jj] = kkr * kkr; }
        const float ksum = multi_sum8(kq, lane);
#pragma unroll
        for (int jj = 0; jj < 8; ++jj) kkn[jj] = sk[jj] * kkw * __builtin_amdgcn_rsqf(rlf(ksum, ms8_lane(jj)) + 1e-12f);
    }
    {
        float t0s = 0.f, t1s = 0.f;
#pragma unroll
        for (int jj = 0; jj < 8; ++jj) { t0s += lw2r[0][jj]; t1s += lw2r[1][jj]; }
        TOT[w * 64 + lane] = t0s; TOT[512 + w * 64 + lane] = t1s;
    }
    LDS_BARRIER();
    f32x4 oacc[2] = {(f32x4){0.f, 0.f, 0.f, 0.f}, (f32x4){0.f, 0.f, 0.f, 0.f}};
#pragma unroll 1
    for (int d = 0; d < 2; ++d) {
        {
            float lw2[8], av[8], kd[8];
            float bq[8];
#pragma unroll
            for (int jj = 0; jj < 8; ++jj) { lw2[jj] = d ? lw2r[1][jj] : lw2r[0][jj]; av[jj] = d ? ar[1][jj] : ar[0][jj]; kd[jj] = sk[jj] * (1.f + (av[jj] - 1.f) * kaw);
                bq[jj] = sr[jj] * kd[jj] * rkw; }
            const float bonl = multi_sum8(bq, lane);
            if (lane < 8) F.bons()[((size_t)d * SEQ + t0 + 8 * w + ms8_index(lane)) * 16 + h] = bonl;
            unsigned bbp[4] = {0u, 0u, 0u, 0u}, kbp[4] = {0u, 0u, 0u, 0u}, vtp[4] = {0u, 0u, 0u, 0u};
            const int j0 = d ? 63 - (8 * w + 7) : 8 * w;
            float off = 0.f, l63 = 0.f;
#pragma unroll
            for (int gg = 0; gg < 8; ++gg) { const float tg = TOT[d * 512 + gg * 64 + lane]; l63 += tg; const bool bef = d == 0 ? gg < w : gg > w; off += bef ? tg : 0.f; }
            if (w == 0) PCV[lane] = __builtin_amdgcn_exp2f(l63);
            float lam[8];
            if (d == 0) { float run = off;
#pragma unroll
                for (int jj = 0; jj < 8; ++jj) { run += lw2[jj]; lam[jj] = run; } }
            else { float run = off;
#pragma unroll
                for (int jj = 7; jj >= 0; --jj) { run += lw2[jj]; lam[jj] = run; } }
#pragma unroll
            for (int jj = 0; jj < 8; ++jj) {
                const int tl = 8 * w + jj, j = d ? 63 - tl : tl;
                const float ep = __builtin_amdgcn_exp2f(lam[jj]), en = __builtin_amdgcn_exp2f(-lam[jj]), eb = __builtin_amdgcn_exp2f(l63 - lam[jj]);
                const float bet = kkn[jj] * av[jj];
                AL[j * LT + lane] = (bf16_t)f2bf(-kkn[jj] * __builtin_amdgcn_exp2f(lam[jj] - lw2[jj]));
                BE[j * LT + lane] = (bf16_t)f2bf(bet * en); KTL[j * LT + lane] = (bf16_t)f2bf(kd[jj] * en); RT[j * LT + lane] = (bf16_t)f2bf(sr[jj] * ep);
                const unsigned bb = f2bf(bet * eb), kb = f2bf(kd[jj] * eb), vb = f2bf(sv[jj]);
                bbp[jj >> 1] |= bb << (16 * (jj & 1)); kbp[jj >> 1] |= kb << (16 * (jj & 1)); vtp[jj >> 1] |= vb << (16 * (jj & 1));
                if ((jj & 3) == 3) __builtin_amdgcn_sched_barrier(0);
            }
            if (d) {
#pragma unroll
                for (int q = 0; q < 2; ++q) { unsigned a, b;
                    a = bbp[q]; b = bbp[3 - q]; bbp[q] = (b >> 16) | (b << 16); bbp[3 - q] = (a >> 16) | (a << 16);
                    a = kbp[q]; b = kbp[3 - q]; kbp[q] = (b >> 16) | (b << 16); kbp[3 - q] = (a >> 16) | (a << 16);
                    a = vtp[q]; b = vtp[3 - q]; vtp[q] = (b >> 16) | (b << 16); vtp[3 - q] = (a >> 16) | (a << 16); }
            }
            *(LAS u32x4*)(VT + lane * LT + j0) = (u32x4){vtp[0], vtp[1], vtp[2], vtp[3]};
            *(LAS u32x4*)(BBT + lane * LT + j0) = (u32x4){bbp[0], bbp[1], bbp[2], bbp[3]};
            *(LAS u32x4*)(KBT + lane * LT + j0) = (u32x4){kbp[0], kbp[1], kbp[2], kbp[3]};
        }
        LDS_BARRIER();
        {
            RW_FRESH(); const int blk = w >> 1;
            const LAS bf16_t* Am = blk < 2 ? AL : RT; const LAS bf16_t* Bm = (blk & 1) ? KTL : BE;
            LAS bf16_t* Om = blk == 0 ? AAB : (blk == 1 ? AAK : (blk == 2 ? ARB : ARK));
            const int incl = blk >> 1;
#pragma unroll
            for (int ri = 0; ri < 2; ++ri) {
                const int jt = 2 * (w & 1) + ri, j = 16 * jt + fr;
                const bf16x8 a0 = *(const LAS bf16x8*)(Am + j * LT + 8 * fq), a1 = *(const LAS bf16x8*)(Am + j * LT + 32 + 8 * fq);
#pragma unroll
                for (int ct = 0; ct < 4; ++ct) {
                    f32x4 acc = (f32x4){0.f, 0.f, 0.f, 0.f};
                    acc = mfma16(*(const LAS bf16x8*)(Bm + (16 * ct + fr) * LT + 8 * fq), a0, acc);
                    acc = mfma16(*(const LAS bf16x8*)(Bm + (16 * ct + fr) * LT + 32 + 8 * fq), a1, acc);
                    const int j2b = 16 * ct + 4 * fq;
                    float v[4];
#pragma unroll
                    for (int r = 0; r < 4; ++r) v[r] = (j2b + r < j + incl) ? acc[r] : 0.f;
                    if (blk == 0 && ct == jt) *(LAS f32x4*)(DG + jt * 256 + fr * 16 + 4 * fq) = (f32x4){v[0], v[1], v[2], v[3]};
                    u32x2 ow; ow.x = pk2(v[0], v[1]); ow.y = pk2(v[2], v[3]);
                    *(LAS u32x2*)(Om + j * LT + j2b) = ow;
                }
            }
        }
        LDS_BARRIER();
        f32x4 rhs[4];
        {
            RW_FRESH();
            if (w >= 4) {
#pragma unroll
                for (int bi = 0; bi < 4; ++bi) { f32x4 acc = (f32x4){0.f, 0.f, 0.f, 0.f};
#pragma unroll
                    for (int ks = 0; ks < 2; ++ks) acc = mfma16(*(const LAS bf16x8*)(AAK + (16 * bi + fr) * LT + 32 * ks + 8 * fq), *(const LAS bf16x8*)(VT + (16 * (w - 4) + fr) * LT + 32 * ks + 8 * fq), acc);
                    rhs[bi] = acc; }
            } else {
#pragma unroll
                for (int bi = 0; bi < 4; ++bi)
#pragma unroll
                    for (int r = 0; r < 4; ++r) rhs[bi][r] = bf2f(AL[(16 * bi + 4 * fq + r) * LT + 16 * w + fr]);
            }
            if (w == 0) {
                const int blk = lane >> 4, cc = lane & 15; float x[16];
#pragma unroll
                for (int jl = 0; jl < 16; ++jl) {
                    float s = (jl == cc) ? 1.f : 0.f;
#pragma unroll
                    for (int j2 = 0; j2 < jl; ++j2) s += DG[blk * 256 + jl * 16 + j2] * x[j2];
                    x[jl] = s;
                    TB[blk * 384 + jl * 24 + cc] = (bf16_t)f2bf(s);
                }
            }
        }
        LDS_BARRIER();
        {
            RW_FRESH();
            f32x4 X[4]; const u32x2 z2 = (u32x2){0u, 0u};
#pragma unroll
            for (int bi = 0; bi < 4; ++bi) {
                f32x4 s = rhs[bi];
                if (bi >= 1) {
                    u32x4 bw; bw.x = pk2(X[0][0], X[0][1]); bw.y = pk2(X[0][2], X[0][3]);
                    if (bi >= 2) { bw.z = pk2(X[1][0], X[1][1]); bw.w = pk2(X[1][2], X[1][3]); } else { bw.z = 0u; bw.w = 0u; }
                    const LAS bf16_t* ap = AAB + (16 * bi + fr) * LT + 4 * fq; const u32x2 lo = *(const LAS u32x2*)ap, hi = *(const LAS u32x2*)(ap + 16);
                    const u32x4 aw = (u32x4){lo.x, lo.y, hi.x, hi.y};
                    s = mfma16(__builtin_bit_cast(bf16x8, aw), __builtin_bit_cast(bf16x8, bw), s);
                }
                if (bi == 3) {
                    u32x4 bw; bw.x = pk2(X[2][0], X[2][1]); bw.y = pk2(X[2][2], X[2][3]); bw.z = 0u; bw.w = 0u;
                    const LAS bf16_t* ap = AAB + (48 + fr) * LT + 32 + 4 * fq; const u32x2 lo = *(const LAS u32x2*)ap;
                    const u32x4 aw = (u32x4){lo.x, lo.y, z2.x, z2.y};
                    s = mfma16(__builtin_bit_cast(bf16x8, aw), __builtin_bit_cast(bf16x8, bw), s);
                }
                {
                    u32x4 bw; bw.x = pk2(s[0], s[1]); bw.y = pk2(s[2], s[3]); bw.z = 0u; bw.w = 0u;
                    const u32x2 lo = *(const LAS u32x2*)(TB + bi * 384 + fr * 24 + 4 * fq);
                    const u32x4 aw = (u32x4){lo.x, lo.y, z2.x, z2.y};
                    X[bi] = mfma16(__builtin_bit_cast(bf16x8, aw), __builtin_bit_cast(bf16x8, bw), (f32x4){0.f, 0.f, 0.f, 0.f});
                }
                u32x2 ow; ow.x = pk2(X[bi][0], X[bi][1]); ow.y = pk2(X[bi][2], X[bi][3]);
                *(LAS u32x2*)(XT + (16 * w + fr) * LT + 16 * bi + 4 * fq) = ow;
            }
        }
        LDS_BARRIER();
        {
            RW_FRESH();
            const size_t img = ((size_t)(d * NCH + c) * 16 + h) * 4096;
#pragma unroll
            for (int ti = 0; ti < 2; ++ti) {
                const int tile = 2 * w + ti, rt = tile >> 2, ct = tile & 3;
                {
                    f32x4 acc = (f32x4){0.f, 0.f, 0.f, 0.f};
#pragma unroll
                    for (int ks = 0; ks < 2; ++ks) acc = mfma16(*(const LAS bf16x8*)(XT + (16 * rt + fr) * LT + 32 * ks + 8 * fq), *(const LAS bf16x8*)(ARB + (16 * ct + fr) * LT + 32 * ks + 8 * fq), acc);
                    const int j = 16 * ct + fr, k0 = 16 * rt + 4 * fq;
                    const u32x2 rw = *(const LAS u32x2*)(RT + j * LT + k0);
                    u32x2 ow; ow.x = pk2(acc[0] + __uint_as_float(rw.x << 16), acc[1] + __uint_as_float(rw.x & 0xffff0000u)); ow.y = pk2(acc[2] + __uint_as_float(rw.y << 16), acc[3] + __uint_as_float(rw.y & 0xffff0000u));
                    *(u32x2*)(F.rhi() + img + j * 64 + k0) = ow;
                }
                {
                    f32x4 acc = (f32x4){0.f, 0.f, 0.f, 0.f};
#pragma unroll
                    for (int ks = 0; ks < 2; ++ks) acc = mfma16(*(const LAS bf16x8*)(XT + (16 * rt + fr) * LT + 32 * ks + 8 * fq), *(const LAS bf16x8*)(BBT + (16 * ct + fr) * LT + 32 * ks + 8 * fq), acc);
                    const int k = 16 * ct + fr, kp0 = 16 * rt + 4 * fq; const float pc = PCV[k];
#pragma unroll
                    for (int r = 0; r < 4; ++r) acc[r] += (kp0 + r == k) ? pc : 0.f;
                    u32x2 ow; ow.x = pk2(acc[0], acc[1]); ow.y = pk2(acc[2], acc[3]);
                    *(u32x2*)(F.mi() + img + k * 64 + kp0) = ow;
                }
                {
                    f32x4 acc = (f32x4){0.f, 0.f, 0.f, 0.f};
#pragma unroll
                    for (int ks = 0; ks < 2; ++ks) {
                        acc = mfma16(*(const LAS bf16x8*)(BBT + (16 * rt + fr) * LT + 32 * ks + 8 * fq), *(const LAS bf16x8*)(XT + (64 + 16 * ct + fr) * LT + 32 * ks + 8 * fq), acc);
                        acc = mfma16(*(const LAS bf16x8*)(KBT + (16 * rt + fr) * LT + 32 * ks + 8 * fq), *(const LAS bf16x8*)(VT + (16 * ct + fr) * LT + 32 * ks + 8 * fq), acc);
                    }
                    const int v = 16 * ct + fr, k0 = 16 * rt + 4 * fq;
                    u32x2 ow; ow.x = pk2(acc[0], acc[1]); ow.y = pk2(acc[2], acc[3]);
                    *(u32x2*)(F.ni() + img + v * 64 + k0) = ow;
                }
                {
                    const int tl = 16 * ct + fr, j = d ? 63 - tl : tl;
                    f32x4 acc = (f32x4){0.f, 0.f, 0.f, 0.f};
#pragma unroll
                    for (int ks = 0; ks < 2; ++ks) {
                        acc = mfma16(*(const LAS bf16x8*)(XT + (64 + 16 * rt + fr) * LT + 32 * ks + 8 * fq), *(const LAS bf16x8*)(ARB + j * LT + 32 * ks + 8 * fq), acc);
                        acc = mfma16(*(const LAS bf16x8*)(VT + (16 * rt + fr) * LT + 32 * ks + 8 * fq), *(const LAS bf16x8*)(ARK + j * LT + 32 * ks + 8 * fq), acc);
                    }
                    if (d) { acc = acc + oacc[ti]; u32x2 ow; ow.x = pk2(acc[0], acc[1]); ow.y = pk2(acc[2], acc[3]);
                        *(u32x2*)(F.obuf() + (size_t)(t0 + tl) * YW + 3072 + h * 64 + 16 * rt + 4 * fq) = ow; }
                    else oacc[ti] = acc;
                }
            }
        }
        LDS_BARRIER();
    }
}
#undef RW_FRESH
constexpr int NSEGC = 16, CPSC = NCH / NSEGC;
constexpr int GSEG = 4;
template <int MODE> __device__ __forceinline__ void rwkv_seg_item(const Ctx& F, int h, int seg) {
    LAS bf16_t* ML0 = (LAS bf16_t*)F.lds; LAS bf16_t* ML1 = ML0 + 64 * LT; LAS bf16_t* RL0 = ML1 + 64 * LT; LAS bf16_t* RL1 = RL0 + 64 * LT;
    const int lane = F.lane, w = F.wave, tid = F.tid, fr = lane & 15, fq = lane >> 4;
    f32x4* NSG = (f32x4*)F.cseg(); bf16_t* MSG = F.cmseg();
#define NSG_AT(d_, s_, a_) NSG[((((size_t)(h * 2 + (d_)) * NSEGC + (s_)) * 4 + (a_)) * 4 + (w & 3)) * 64 + lane]
#define MSG_AT(d_, s_) (MSG + ((size_t)(h * 2 + (d_)) * NSEGC + (s_)) * 4096)
    f32x4 X0[4], X1[4];
#pragma unroll
    for (int a = 0; a < 4; ++a) {
        X0[a] = (f32x4){0.f, 0.f, 0.f, 0.f};
        if (MODE == 0 && w >= 4) {
#pragma unroll
            for (int r = 0; r < 4; ++r) X0[a][r] = (16 * a + 4 * fq + r == 16 * (w - 4) + fr) ? 1.f : 0.f;
        }
        X1[a] = X0[a];
    }
#define RW_SF(X, sf) do { _Pragma("unroll") for (int kk = 0; kk < 2; ++kk) { u32x4 pw; pw.x = pk2(X[2 * kk][0], X[2 * kk][1]); pw.y = pk2(X[2 * kk][2], X[2 * kk][3]); pw.z = pk2(X[2 * kk + 1][0], X[2 * kk + 1][1]); pw.w = pk2(X[2 * kk + 1][2], X[2 * kk + 1][3]); sf[kk] = __builtin_bit_cast(bf16x8, pw); } } while (0)
#define RW_UPD(X, ML, init, sf) do { _Pragma("unroll") for (int a = 0; a < 4; ++a) { f32x4 acc = init[a]; _Pragma("unroll") for (int kk = 0; kk < 2; ++kk) { const LAS bf16_t* mp = ML + (16 * a + fr) * LT + 32 * kk + 4 * fq; \
            const u32x2 lo = *(const LAS u32x2*)mp, hi = *(const LAS u32x2*)(mp + 16); const u32x4 aw = (u32x4){lo.x, lo.y, hi.x, hi.y}; acc = mfma16(__builtin_bit_cast(bf16x8, aw), sf[kk], acc); } init[a] = acc; } \
            _Pragma("unroll") for (int a = 0; a < 4; ++a) X[a] = init[a]; } while (0)
    if (MODE == 1) {
        const int g = seg / GSEG, kq = seg % GSEG, NG = NSEGC / GSEG;
        const int nf = g + (kq > 0 ? 1 : 0), nb = (NG - 1 - g) + (kq < GSEG - 1 ? 1 : 0), ns = nf > nb ? nf : nb;
#pragma unroll 1
        for (int i = 0; i < ns; ++i) {
            const bool df = i < nf, db = i < nb;
            const int sf_ = i < g ? GSEG * i + GSEG - 1 : seg - 1, sb_ = i < NG - 1 - g ? GSEG * (NG - 1 - i) : seg + 1;
            if (df) *(LAS u32x4*)(ML0 + (tid >> 3) * LT + (tid & 7) * 8) = *(const u32x4*)(MSG_AT(0, sf_) + (size_t)tid * 8);
            if (db) *(LAS u32x4*)(ML1 + (tid >> 3) * LT + (tid & 7) * 8) = *(const u32x4*)(MSG_AT(1, sb_) + (size_t)tid * 8);
            LDS_BARRIER();
            if (w < 4) {
                if (df) { bf16x8 sf[2]; RW_SF(X0, sf); f32x4 init[4];
#pragma unroll
                    for (int a = 0; a < 4; ++a) init[a] = NSG_AT(0, sf_, a);
                    RW_UPD(X0, ML0, init, sf); }
                if (db) { bf16x8 sf[2]; RW_SF(X1, sf); f32x4 init[4];
#pragma unroll
                    for (int a = 0; a < 4; ++a) init[a] = NSG_AT(1, sb_, a);
                    RW_UPD(X1, ML1, init, sf); }
            }
            LDS_BARRIER();
        }
    }
    u32x4 mreg[2], rreg[2]; u32x2 nreg[2][4];
    constexpr int NIT = MODE == 0 ? GSEG * CPSC : CPSC;
#define RS_ISSUE(i_) do { _Pragma("unroll") for (int d = 0; d < 2; ++d) { const int c__ = d ? seg * CPSC + NIT - 1 - (i_) : seg * CPSC + (i_); const size_t img = ((size_t)(d * NCH + c__) * 16 + h) * 4096; \
            mreg[d] = *(const u32x4*)(F.mi() + img + (size_t)tid * 8); if (MODE == 1) rreg[d] = *(const u32x4*)(F.rhi() + img + (size_t)tid * 8); \
            if (w < 4) { _Pragma("unroll") for (int a = 0; a < 4; ++a) nreg[d][a] = *(const u32x2*)(F.ni() + img + (16 * w + fr) * 64 + 16 * a + 4 * fq); } } } while (0)
    RS_ISSUE(0);
    u32x2 oreg[2][4];
#define RS_OLOAD(i_) do { if (MODE == 1 && w < 4) { const int cf_ = seg * CPSC + (i_), cb_ = seg * CPSC + NIT - 1 - (i_); _Pragma("unroll") for (int tt = 0; tt < 4; ++tt) { \
            oreg[0][tt] = *(const u32x2*)(F.obuf() + (size_t)(cf_ * 64 + 16 * tt + (F.lane & 15)) * YW + 3072 + h * 64 + 16 * w + 4 * (F.lane >> 4)); \
            oreg[1][tt] = *(const u32x2*)(F.obuf() + (size_t)(cb_ * 64 + 16 * tt + (F.lane & 15)) * YW + 3072 + h * 64 + 16 * w + 4 * (F.lane >> 4)); } } } while (0)
    RS_OLOAD(0);
#pragma unroll 1
    for (int it = 0; it < NIT; ++it) {
        const int cf = seg * CPSC + it, cb = seg * CPSC + NIT - 1 - it;
        *(LAS u32x4*)(ML0 + (tid >> 3) * LT + (tid & 7) * 8) = mreg[0]; *(LAS u32x4*)(ML1 + (tid >> 3) * LT + (tid & 7) * 8) = mreg[1];
        if (MODE == 1) { *(LAS u32x4*)(RL0 + (tid >> 3) * LT + (tid & 7) * 8) = rreg[0]; *(LAS u32x4*)(RL1 + (tid >> 3) * LT + (tid & 7) * 8) = rreg[1]; }
        f32x4 nin[2][4];
#pragma unroll
        for (int d = 0; d < 2; ++d)
#pragma unroll
            for (int a = 0; a < 4; ++a) nin[d][a] = (w < 4) ? (f32x4){__uint_as_float(nreg[d][a].x << 16), __uint_as_float(nreg[d][a].x & 0xffff0000u), __uint_as_float(nreg[d][a].y << 16), __uint_as_float(nreg[d][a].y & 0xffff0000u)} : (f32x4){0.f, 0.f, 0.f, 0.f};
        if (it + 1 < NIT) RS_ISSUE(it + 1);
        LDS_BARRIER();
        if (MODE == 0 || w < 4) {
#pragma unroll
            for (int d = 0; d < 2; ++d) {
                f32x4 (&X)[4] = d ? X1 : X0; const LAS bf16_t* ML = d ? ML1 : ML0; const LAS bf16_t* RL = d ? RL1 : RL0; const int t0 = (d ? cb : cf) * 64;
                bf16x8 sf[2]; RW_SF(X, sf);
                if (MODE == 1) {
#pragma unroll
                    for (int tt = 0; tt < 4; ++tt) {
                        const int tl = 16 * tt + fr, j = d ? 63 - tl : tl;
                        f32x4 acc = (f32x4){0.f, 0.f, 0.f, 0.f};
#pragma unroll
                        for (int kk = 0; kk < 2; ++kk) { const LAS bf16_t* qp = RL + j * LT + 32 * kk + 4 * fq; const u32x2 lo = *(const LAS u32x2*)qp, hi = *(const LAS u32x2*)(qp + 16);
                            const u32x4 bw = (u32x4){lo.x, lo.y, hi.x, hi.y}; acc = mfma16(sf[kk], __builtin_bit_cast(bf16x8, bw), acc); }
                        const u32x2 ow = d ? oreg[1][tt] : oreg[0][tt];
                        u32x2 nw; nw.x = pk2(__uint_as_float(ow.x << 16) + acc[0], __uint_as_float(ow.x & 0xffff0000u) + acc[1]); nw.y = pk2(__uint_as_float(ow.y << 16) + acc[2], __uint_as_float(ow.y & 0xffff0000u) + acc[3]);
                        *(u32x2*)(F.obuf() + (size_t)(t0 + tl) * YW + 3072 + h * 64 + 16 * w + 4 * fq) = nw;
                    }
                }
                RW_UPD(X, ML, nin[d], sf);
            }
        }
        if (it + 1 < NIT) RS_OLOAD(it + 1);
        if (MODE == 0 && (it % CPSC) == CPSC - 1) {
            const int sf_ = seg + it / CPSC, sb_ = seg + GSEG - 1 - it / CPSC;
            if (w < 4) {
#pragma unroll
                for (int a = 0; a < 4; ++a) { NSG_AT(0, sf_, a) = X0[a]; NSG_AT(1, sb_, a) = X1[a]; }
            } else {
#pragma unroll
                for (int a = 0; a < 4; ++a)
#pragma unroll
                    for (int r = 0; r < 4; ++r) { const int k = 16 * a + 4 * fq + r, kp = 16 * (w - 4) + fr;
                        MSG_AT(0, sf_)[k * 64 + kp] = (bf16_t)f2bf(X0[a][r]); MSG_AT(1, sb_)[k * 64 + kp] = (bf16_t)f2bf(X1[a][r]); }
            }
        }
        LDS_BARRIER();
    }
#undef RS_OLOAD
#undef RS_ISSUE
#undef RW_SF
#undef RW_UPD
#undef NSG_AT
#undef MSG_AT
}
__device__ __forceinline__ void unpack8(const u32x4 w, float (&v)[8]) {
    v[0] = __uint_as_float(w.x << 16); v[1] = __uint_as_float(w.x & 0xffff0000u); v[2] = __uint_as_float(w.y << 16); v[3] = __uint_as_float(w.y & 0xffff0000u);
    v[4] = __uint_as_float(w.z << 16); v[5] = __uint_as_float(w.z & 0xffff0000u); v[6] = __uint_as_float(w.w << 16); v[7] = __uint_as_float(w.w & 0xffff0000u);
}
__device__ __forceinline__ u32x4 pack8(const float (&v)[8]) { u32x4 w; w.x = pk2(v[0], v[1]); w.y = pk2(v[2], v[3]); w.z = pk2(v[4], v[5]); w.w = pk2(v[6], v[7]); return w; }
template <int NL> __device__ __forceinline__ float group_sum(float v) {
    if (NL == 8) return row_sum8(v);
    v = row_sum16(v);
    if (NL == 32) { const auto r = __builtin_amdgcn_permlane16_swap(__float_as_uint(v), __float_as_uint(v), false, false); v = __uint_as_float(r[0]) + __uint_as_float(r[1]); }
    return v;
}
__device__ __forceinline__ void norm_phase(const Ctx& F, int l) {
    const int gw = blockIdx.x * NWAVES + F.wave, NGW = F.G * NWAVES, lane = F.lane;
    const float* ga = F.in(4) + l * 1024; const float* gb = F.in(5) + l * 2048; const float* bb = F.in(6) + l * 2048; const float* gc = F.in(15) + l * 1024; const float* bc = F.in(16) + l * 1024;
#pragma unroll 1
    for (int t = gw; t < SEQ; t += NGW) {
        bf16_t* orow = F.obuf() + (size_t)t * YW; const bf16_t* prow = F.lbuf() + (size_t)t * LDL;
        float epsA = 1e-6f, epsB = 1e-5f, epsC = 64e-5f; asm volatile("" : "+s"(epsA), "+s"(epsB), "+s"(epsC));
        u32x4 ow[8], gt[8], svw[2]; float bn[2];
#pragma unroll
        for (int j = 0; j < 8; ++j) { ow[j] = *(const u32x4*)(orow + 8 * (64 * j + lane)); gt[j] = *(const u32x4*)(prow + 8 * (64 * j + lane)); }
#pragma unroll
        for (int j = 0; j < 2; ++j) { const int q = 64 * j + lane, hd = q >> 3;
            svw[j] = *(const u32x4*)(F.svb() + (size_t)t * 1024 + 8 * q); bn[j] = F.bons()[(size_t)t * 16 + hd] + F.bons()[((size_t)SEQ + t) * 16 + hd]; }
#pragma unroll
        for (int j = 0; j < 8; ++j) {
            float o[8], g[8], y[8], pg[8], pb[8]; unpack8(ow[j], o); unpack8(gt[j], g);
#pragma unroll
            for (int e = 0; e < 8; ++e) g[e] = siluf_(g[e]);
            {
                const int ch = 8 * (64 * (j < 2 ? j : j < 6 ? j - 2 : j - 6) + lane);
                const float* gsrc = (j < 2 ? ga : j < 6 ? gb : gc) + ch;
                const f32x4 g0 = *(const f32x4*)gsrc, g1 = *(const f32x4*)(gsrc + 4);
                pg[0] = g0.x; pg[1] = g0.y; pg[2] = g0.z; pg[3] = g0.w; pg[4] = g1.x; pg[5] = g1.y; pg[6] = g1.z; pg[7] = g1.w;
                if (j >= 2) { const float* bsrc = (j < 6 ? bb : bc) + ch; const f32x4 b0 = *(const f32x4*)bsrc, b1 = *(const f32x4*)(bsrc + 4);
                    pb[0] = b0.x; pb[1] = b0.y; pb[2] = b0.z; pb[3] = b0.w; pb[4] = b1.x; pb[5] = b1.y; pb[6] = b1.z; pb[7] = b1.w; }
            }
            if (j < 2) {
                float s = 0.f;
#pragma unroll
                for (int e = 0; e < 8; ++e) s += o[e] * o[e];
                const float r = rsqrtf(group_sum<16>(s) * (1.f / 128.f) + epsA);
#pragma unroll
                for (int e = 0; e < 8; ++e) y[e] = o[e] * r * pg[e] * g[e];
            } else if (j < 6) {
                float s = 0.f;
#pragma unroll
                for (int e = 0; e < 8; ++e) s += o[e];
                const float mean = group_sum<32>(s) * (1.f / 256.f); float q = 0.f;
#pragma unroll
                for (int e = 0; e < 8; ++e) { o[e] -= mean; q += o[e] * o[e]; }
                const float r = rsqrtf(group_sum<32>(q) * (1.f / 256.f) + epsB);
#pragma unroll
                for (int e = 0; e < 8; ++e) y[e] = (o[e] * r * pg[e] + pb[e]) * g[e];
            } else {
                float s = 0.f;
#pragma unroll
                for (int e = 0; e < 8; ++e) s += o[e];
                const float mean = group_sum<8>(s) * (1.f / 64.f); float q = 0.f;
#pragma unroll
                for (int e = 0; e < 8; ++e) { o[e] -= mean; q += o[e] * o[e]; }
                const float r = rsqrtf(group_sum<8>(q) * (1.f / 64.f) + epsC);
                float sv[8]; unpack8(svw[j - 6], sv);
#pragma unroll
                for (int e = 0; e < 8; ++e) y[e] = (o[e] * r * pg[e] + pb[e] + bn[j - 6] * sv[e]) * g[e];
            }
            *(u32x4*)(orow + 8 * (64 * j + lane)) = pack8(y);
            if (j & 1) __builtin_amdgcn_sched_barrier(0);
        }
    }
}
constexpr int PB = 9, PH_PER_LAYER = 2 * PB + 2, NPHASE = 1 + 2 * PH_PER_LAYER;

__global__ void __launch_bounds__(NWAVES * 64, 2) fwd_kernel(Args args) {
    extern __shared__ __attribute__((aligned(16))) unsigned char lds_raw[];
    Ctx F;
    F.lds = (LAS unsigned char*)lds_raw;
    const int ph_lo = args.ph_lo, ph_hi = args.ph_hi;
    if (ph_hi < 0) cg::this_grid().sync();
    volatile LAS unsigned* bst = (volatile LAS unsigned*)(F.lds + LDS_BYTES - 64);
    if (threadIdx.x < 16) bst[threadIdx.x] = 0u;
    __syncthreads();
    XcdBarrier gbar = xcd_barrier_post((unsigned*)(args.ws + WS_BAR), bst);
    if (ph_lo == 0) { KArgs* ap = (KArgs*)__builtin_amdgcn_kernarg_segment_ptr(); asm volatile("" : "+s"(ap)); F.ap = ap; F.tid = threadIdx.x; F.G = gridDim.x; rope_table(F); }
#pragma unroll 1
    for (int ph = ph_lo; ph < ph_hi; ++ph) {
        if (ph > ph_lo) { XcdBarrier gb = gbar; asm volatile("" : "+s"(gb.bar), "+s"(gb.x)); xcd_barrier(gb); }
        { KArgs* ap = (KArgs*)__builtin_amdgcn_kernarg_segment_ptr(); asm volatile("" : "+s"(ap)); F.ap = ap;
          int tid = threadIdx.x; asm volatile("" : "+v"(tid)); F.tid = tid; F.lane = tid & 63; F.wave = __builtin_amdgcn_readfirstlane(tid >> 6);
          int G = gridDim.x; asm volatile("" : "+s"(G)); F.G = G; }
        int bid = blockIdx.x; asm volatile("" : "+s"(bid));
        if (ph == 0) { prep_phase(F, 0); continue; }
        const int l = (ph - 1) / PH_PER_LAYER, r = (ph - 1) % PH_PER_LAYER;
        if (r == 2 * PB + 1) { prep_phase(F, l + 1); continue; }
        const int b = r / PB, k = r % PB;
        const bool is_out = (r == 2 * PB);
        if (!is_out) {
            if (k == 1) {
                for (int it = bid; it < NCH * 8; it += F.G) hgrn_local_item(F, l, it >> 3, it & 7);
                { int tid = threadIdx.x; asm volatile("" : "+v"(tid)); F.tid = tid; F.lane = tid & 63; F.wave = __builtin_amdgcn_readfirstlane(tid >> 6); }
                for (int it = bid; it < NCH * 8; it += F.G) ret_local_item(F, it >> 3, it & 7);
            } else if (k == 2) {
                if (bid < 64) chain_seg_item<0, 0>(F, bid >> 3, bid & 7); else if (bid < 192) chain_seg_item<1, 0>(F, (bid - 64) >> 3, (bid - 64) & 7);
                else rwkv_code_pass(F, l, bid - 192, 64);
            } else if (k == 3) {
                for (int it = bid; it < NCH * 16; it += F.G) rwkv_local_item(F, l, it >> 4, it & 15);
            } else if (k == 4) {
                if (bid < 64) chain_seg_item<0, 1>(F, bid >> 3, bid & 7); else if (bid < 192) chain_seg_item<1, 1>(F, (bid - 64) >> 3, (bid - 64) & 7);
                else { rwkv_seg_item<0>(F, (bid - 192) >> 2, GSEG * ((bid - 192) & 3)); __syncthreads(); }
            } else if (k == 5) { if (bid < 16 * NSEGC) rwkv_seg_item<1>(F, bid >> 4, bid & 15); }
            else if (k == 7) norm_phase(F, l);
        }
        const bool xg4 = !is_out && k == 4 && bid >= 192, xg2 = !is_out && k == 2 && bid >= 192 && b == 1;
        const bool is_gemm = is_out || k == 0 || k == 6 || k == 8 || xg4 || xg2;
        if (is_gemm) {
            if (xg2) __syncthreads();
            const int nsub = (!is_out && (k == 8 || (xg4 && b == 0))) ? 2 : 1;
#pragma unroll 1
            for (int sub = 0; sub < nsub; ++sub) {
                pg8::Gemm g; pg8::StaticOrder S; EpiAny E; E.l = l; E.b = b; E.s = 0; E.gcol = 0;
                if (is_out) {
                    g = pg8::Gemm{F.mixbf(), F.WoutT(), 1024, 1024, 1024}; S.init(MTOK, DM, F.G, bid); E.kind = 5;
                } else if (k == 0) {
                    g = pg8::Gemm{F.xg() + (size_t)b * SEQ * DM, F.WinT(), 1024, 1024, 1024}; S.init(SEQ, b == 1 ? 40 * 256 : LDE, F.G, bid); E.kind = 0;
                } else if (k == 6) {
                    g = pg8::Gemm{F.xg() + (size_t)b * SEQ * DM, F.WinT() + (size_t)LDE * DM, 1024, 1024, 1024}; S.init(SEQ, LDL, F.G, bid); E.kind = 1;
                } else if (k == 4 && sub == 0) {
                    g = pg8::Gemm{F.xg() + (size_t)b * SEQ * DM, F.WinT() + (size_t)(LDE + LDL) * DM, 1024, 1024, 1024}; S.init(SEQ, LDLX, 64, bid - 192); E.kind = 6;
                } else if (k == 4) {
                    g = pg8::Gemm{F.xg() + (size_t)(b + 1) * SEQ * DM, F.WinT() + (size_t)(42 * 256) * DM, 1024, 1024, 1024}; S.init(SEQ, 3 * 256, 64, bid - 192); E.kind = 7; E.gcol = 42;
                } else if (k == 2) {
                    g = pg8::Gemm{F.xg() + (size_t)b * SEQ * DM, F.WinT() + (size_t)(40 * 256) * DM, 1024, 1024, 1024}; S.init(SEQ, 2 * 256, 64, bid - 192); E.kind = 7; E.gcol = 40;
                } else {
                    const int sp = bid & 1, seg4 = 2 * sp + sub, koff = 1024 * seg4;
                    g = pg8::Gemm{F.obuf() + koff, F.WcatT() + koff, YW, YW, 1024}; S.init(SEQ, DM, F.G >> 1, bid >> 1); E.kind = 2 + sub; E.s = sp;
                    E.gcol = L_MG + 1024 * (seg4 == 0 ? 0 : (seg4 == 3 ? 2 : 1));
                }
                pg8::gemm_phase<EpiAny, pg8::StaticOrder>(F.lds, g, S, E);
            }
        }
    }
}

extern "C" void kernel_launch(void* const* d_in, const int* in_sizes, int n_in, void* d_out, int out_size, void* d_ws, size_t ws_size, hipStream_t stream) {
    static int grid = 0;
    if (grid == 0) {
        if (n_in != 22 || in_sizes[0] != MTOK * DM || out_size != MTOK * DM || ws_size < WS_END) { fprintf(stderr, "kernel_launch: unexpected problem (n_in %d, in0 %d, out %d, ws %zu)\n", n_in, n_in > 0 ? in_sizes[0] : -1, out_size, ws_size); grid = -1; return; }
        int dev = 0, cus = 0, per_cu = 0;
        if (hipGetDevice(&dev) != hipSuccess || hipDeviceGetAttribute(&cus, hipDeviceAttributeMultiprocessorCount, dev) != hipSuccess) { grid = -1; return; }
        if (hipFuncSetAttribute((const void*)fwd_kernel, hipFuncAttributeMaxDynamicSharedMemorySize, LDS_BYTES) != hipSuccess) { fprintf(stderr, "kernel_launch: hipFuncSetAttribute failed\n"); grid = -1; return; }
        if (hipOccupancyMaxActiveBlocksPerMultiprocessor(&per_cu, (const void*)fwd_kernel, NWAVES * 64, LDS_BYTES) != hipSuccess || per_cu < 1) { fprintf(stderr, "kernel_launch: occupancy query says %d blocks per CU\n", per_cu); (void)hipGetLastError(); grid = -1; return; }
        if (cus < 256) { fprintf(stderr, "kernel_launch: this build deals the segment items one per workgroup and needs 256 CUs (found %d)\n", cus); grid = -1; return; }
        grid = 256;
    }
    if (grid < 0) return;
    if (hipMemsetAsync((char*)d_ws + WS_CTL, 0, CTL_ZERO_BYTES, stream) != hipSuccess) { fprintf(stderr, "kernel_launch: hipMemsetAsync failed\n"); return; }
    Args a{};
    for (int i = 0; i < 22; ++i) a.in[i] = (const float*)d_in[i];
    a.out = (float*)d_out; a.ws = (unsigned char*)d_ws;
    a.ph_lo = 0; a.ph_hi = NPHASE;
    void* kargs[] = {&a};
    hipError_t e = hipLaunchCooperativeKernel((const void*)fwd_kernel, dim3(grid), dim3(NWAVES * 64), kargs, LDS_BYTES, stream);
    if (e != hipSuccess) fprintf(stderr, "kernel_launch: cooperative launch failed: %s (grid %d)\n", hipGetErrorString(e), grid);
}
```
